# Optimizing an MI355X kernel written in HIP

```python
import math
import jax, jax.numpy as jnp
from jax import lax
import numpy as np

D_MODEL = 1024
BATCH = 2
SEQ = 16384
DEPTH = 2
DEC_BATCH = 16
DEC_SEQ = 64
PAST_LEN = 4096

CHUNK = 64
CONV_W = 4
D_FF = 2816
EPS = 1e-6
A_HEADS = 6
A_DK = 64
A_DV = 64
A_WIDTH = A_HEADS * A_DV
A_CONV_CH = 2 * A_HEADS * A_DK + A_WIDTH
B_HEADS = 6
B_HEADDIM = 64
B_WIDTH = B_HEADS * B_HEADDIM
B_GROUPS = 2
B_STATE = 64
B_CONV_CH = B_WIDTH + 2 * B_GROUPS * B_STATE
C_WIDTH = 256
C_BLOCKS = 8
C_BLOCK = C_WIDTH // C_BLOCKS
LRU_C = 8.0
D_MIX = A_WIDTH + B_WIDTH + C_WIDTH
D_IN = A_CONV_CH + A_WIDTH + 2 * A_HEADS + B_WIDTH + B_CONV_CH + B_HEADS + 2 * C_WIDTH

kernel_name = 'hybrid_streaming_encoder_step'


def rmsnorm(x, w):
    xf = x.astype(jnp.float32)
    y = xf * lax.rsqrt(jnp.mean(xf * xf, axis=-1, keepdims=True) + EPS)
    return (y * w.astype(jnp.float32)).astype(x.dtype)


def l2norm(x):
    return x * lax.rsqrt(jnp.sum(x * x, axis=-1, keepdims=True) + EPS)


def swiglu(x, w_gate, w_up, w_down):
    return (jax.nn.silu(x @ w_gate) * (x @ w_up)) @ w_down


def causal_conv(x, buf, w):
    l = x.shape[1]
    xp = jnp.concatenate([buf.astype(x.dtype), x], axis=1)
    y = xp[:, 0:l] * w[0]
    for k in range(1, CONV_W):
        y = y + xp[:, k:k + l] * w[k]
    return y, xp[:, l:]


def to_chunks(t, n_chunks):
    bsz, l = t.shape[:2]
    t = jnp.pad(t.astype(jnp.float32), [(0, 0), (0, n_chunks * CHUNK - l)] + [(0, 0)] * (t.ndim - 2))
    t = t.reshape((bsz, n_chunks, CHUNK) + t.shape[2:])
    return jnp.moveaxis(jnp.moveaxis(t, 3, 2), 1, 0)


def from_chunks(o, l):
    n, bsz, h, c, e = o.shape
    return jnp.transpose(o, (1, 0, 3, 2, 4)).reshape(bsz, n * c, h, e)[:, :l]


def chunk_masks():
    causal = jnp.tril(jnp.ones((CHUNK, CHUNK), dtype=bool))
    strict = jnp.tril(jnp.ones((CHUNK, CHUNK), dtype=bool), -1)
    return causal, strict


def decay_matrix(g, mask):
    return jnp.exp(jnp.where(mask, g[..., :, None] - g[..., None, :], -jnp.inf))


def gated_delta_rule(q, k, v, log_alpha, beta, s0):
    l = q.shape[1]
    n = -(-l // CHUNK)
    qc, kc, vc = to_chunks(q, n), to_chunks(k, n), to_chunks(v, n)
    la, bc = to_chunks(log_alpha, n), to_chunks(beta, n)
    causal, strict = chunk_masks()
    g = jnp.cumsum(la, axis=-1)
    gam = decay_matrix(g, causal)
    kk = jnp.einsum('nbhid,nbhjd->nbhij', kc, kc)
    a_mat = jnp.eye(CHUNK, dtype=jnp.float32) + jnp.where(strict, bc[..., :, None] * kk * gam, 0.0)
    u = lax.linalg.triangular_solve(a_mat, bc[..., None] * vc, left_side=True, lower=True, unit_diagonal=True)
    w = lax.linalg.triangular_solve(a_mat, (bc * jnp.exp(g))[..., None] * kc, left_side=True, lower=True, unit_diagonal=True)
    qk = jnp.where(causal, jnp.einsum('nbhid,nbhjd->nbhij', qc, kc) * gam, 0.0)
    q_dec = qc * jnp.exp(g)[..., None]
    k_dec = kc * jnp.exp(g[..., -1:] - g)[..., None]
    g_tot = jnp.exp(g[..., -1])

    def step(s, inp):
        u_c, w_c, qk_c, q_c, k_c, gt = inp
        delta = u_c - jnp.einsum('bhik,bhkv->bhiv', w_c, s)
        o = jnp.einsum('bhik,bhkv->bhiv', q_c, s) + jnp.einsum('bhij,bhjv->bhiv', qk_c, delta)
        s = gt[..., None, None] * s + jnp.einsum('bhik,bhiv->bhkv', k_c, delta)
        return s, o

    s_fin, o = lax.scan(step, s0, (u, w, qk, q_dec, k_dec, g_tot))
    return from_chunks(o, l), s_fin


def ssd_scan(x, dt, a, bm, cm, h0):
    l = x.shape[1]
    n = -(-l // CHUNK)
    xdt = to_chunks(x * dt[..., None], n)
    la = to_chunks(dt * a, n)
    bc, cc = to_chunks(bm, n), to_chunks(cm, n)
    causal, _ = chunk_masks()
    g = jnp.cumsum(la, axis=-1)
    scores = jnp.einsum('nbhis,nbhjs->nbhij', cc, bc) * decay_matrix(g, causal)
    y_intra = jnp.einsum('nbhij,nbhjp->nbhip', scores, xdt)
    c_dec = cc * jnp.exp(g)[..., None]
    b_dec = bc * jnp.exp(g[..., -1:] - g)[..., None]
    g_tot = jnp.exp(g[..., -1])

    def step(h, inp):
        yi, c_c, b_c, x_c, gt = inp
        y = yi + jnp.einsum('bhis,bhsp->bhip', c_c, h)
        h = gt[..., None, None] * h + jnp.einsum('bhjs,bhjp->bhsp', b_c, x_c)
        return h, y

    h_fin, y = lax.scan(step, h0, (y_intra, c_dec, b_dec, xdt, g_tot))
    return from_chunks(y, l), h_fin


def block_diag_linear(x, w, b):
    xb = x.reshape(x.shape[:-1] + (C_BLOCKS, C_BLOCK))
    return jnp.einsum('blnc,ncd->blnd', xb, w).reshape(x.shape) + b


def rglru(x, r_logit, i_logit, lam, h0):
    log_a = -LRU_C * jax.nn.sigmoid(r_logit) * jax.nn.softplus(-lam)
    a = jnp.exp(log_a)
    b = jnp.sqrt(-jnp.expm1(2.0 * log_a)) * (jax.nn.sigmoid(i_logit) * x)
    b = b.at[:, 0].add(a[:, 0] * h0)

    def combine(left, right):
        a_l, b_l = left
        a_r, b_r = right
        return a_l * a_r, a_r * b_l + b_r

    _, h = lax.associative_scan(combine, (a, b), axis=1)
    return h, h[:, -1]


def split_cols(proj):
    sizes = (A_CONV_CH, A_WIDTH, A_HEADS, A_HEADS, B_WIDTH, B_CONV_CH, B_HEADS, C_WIDTH, C_WIDTH)
    idx = np.cumsum(np.array(sizes))[:-1].tolist()
    return jnp.split(proj, idx, axis=-1)


def mixer(h, st, lp):
    delta_s, delta_conv, ssd_h, ssd_conv, lru_h, lru_conv = st
    f32 = jnp.float32
    bsz, l, _ = h.shape
    proj = h @ lp['w_in']
    qkv_raw, z_a, b_a, a_a, z_b, xbc_raw, dt_raw, gate_c, x_c_raw = split_cols(proj)

    qkv, delta_conv_new = causal_conv(qkv_raw, delta_conv, lp['conv_a_w'])
    qkv = jax.nn.silu(qkv.astype(f32))
    q, k, v = jnp.split(qkv, [A_HEADS * A_DK, 2 * A_HEADS * A_DK], axis=-1)
    q = l2norm(q.reshape(bsz, l, A_HEADS, A_DK)) * (A_DK ** -0.5)
    k = l2norm(k.reshape(bsz, l, A_HEADS, A_DK))
    v = v.reshape(bsz, l, A_HEADS, A_DV)
    beta = jax.nn.sigmoid(b_a.astype(f32))
    log_alpha = -jnp.exp(lp['a_log_a'].astype(f32)) * jax.nn.softplus(a_a.astype(f32) + lp['dt_bias_a'])
    o_a, delta_s_new = gated_delta_rule(q, k, v, log_alpha, beta, delta_s.astype(f32))
    o_a = rmsnorm(o_a, lp['norm_a_w']) * jax.nn.silu(z_a.astype(f32).reshape(bsz, l, A_HEADS, A_DV))
    o_a = o_a.reshape(bsz, l, A_WIDTH)

    xbc, ssd_conv_new = causal_conv(xbc_raw, ssd_conv, lp['conv_b_w'])
    xbc = jax.nn.silu((xbc + lp['conv_b_b']).astype(f32))
    xs, bm, cm = jnp.split(xbc, [B_WIDTH, B_WIDTH + B_GROUPS * B_STATE], axis=-1)
    xs = xs.reshape(bsz, l, B_HEADS, B_HEADDIM)
    rep = B_HEADS // B_GROUPS
    bm = jnp.repeat(bm.reshape(bsz, l, B_GROUPS, B_STATE), rep, axis=2)
    cm = jnp.repeat(cm.reshape(bsz, l, B_GROUPS, B_STATE), rep, axis=2)
    dt = jax.nn.softplus(dt_raw.astype(f32) + lp['dt_bias_b'])
    y_b, ssd_h_new = ssd_scan(xs, dt, -jnp.exp(lp['a_log_b'].astype(f32)), bm, cm, ssd_h.astype(f32))
    y_b = y_b + lp['d_skip_b'][:, None] * xs
    y_b = y_b * jax.nn.silu(z_b.astype(f32).reshape(bsz, l, B_HEADS, B_HEADDIM))
    y_b = y_b.reshape(bsz, l, B_GROUPS, B_WIDTH // B_GROUPS)
    o_b = rmsnorm(y_b, lp['norm_b_w'].reshape(B_GROUPS, B_WIDTH // B_GROUPS)).reshape(bsz, l, B_WIDTH)

    xc, lru_conv_new = causal_conv(x_c_raw, lru_conv, lp['conv_c_w'])
    xc = (xc + lp['conv_c_b']).astype(f32)
    r_logit = block_diag_linear(xc, lp['w_rgate'], lp['b_rgate'])
    i_logit = block_diag_linear(xc, lp['w_igate'], lp['b_igate'])
    hc, lru_h_new = rglru(xc, r_logit, i_logit, lp['lru_lambda'].astype(f32), lru_h.astype(f32))
    o_c = hc * jax.nn.gelu(gate_c.astype(f32))

    mix = jnp.concatenate([o_a, o_b, o_c], axis=-1).astype(h.dtype) @ lp['w_out']
    return mix, (delta_s_new, delta_conv_new, ssd_h_new, ssd_conv_new, lru_h_new, lru_conv_new)


def run_trunk(x, states, params, norm_final):
    new_states = [[], [], [], [], [], []]
    for layer in range(DEPTH):
        lp = {name: arr[layer] for name, arr in params.items()}
        st = tuple(s[layer] for s in states)
        x = x + 0.5 * swiglu(rmsnorm(x, lp['norm_ffn1']), lp['ffn1_w_gate'], lp['ffn1_w_up'], lp['ffn1_w_down'])
        m, st_new = mixer(rmsnorm(x, lp['norm_mix']), st, lp)
        x = x + m
        x = x + 0.5 * swiglu(rmsnorm(x, lp['norm_ffn2']), lp['ffn2_w_gate'], lp['ffn2_w_up'], lp['ffn2_w_down'])
        for lst, s in zip(new_states, st_new):
            lst.append(s)
    return rmsnorm(x, norm_final), tuple(jnp.stack(lst) for lst in new_states)


def setup_inputs(seed: int = 0) -> dict:
    key = jax.random.key(seed)
    ks = iter(jax.random.split(key, 48))
    f32 = jnp.float32

    def nrm(shape, scale):
        return jax.random.normal(next(ks), shape, f32) * scale

    def unif(shape, lo, hi):
        return jax.random.uniform(next(ks), shape, f32, lo, hi)

    def gain(shape):
        return 1.0 + nrm(shape, 0.01)

    def dt_bias(shape):
        dt = jnp.exp(unif(shape, math.log(1e-3), math.log(1e-1)))
        return dt + jnp.log(-jnp.expm1(-dt))

    def lru_lambda(shape):
        p = unif(shape, 0.9, 0.999) ** (1.0 / LRU_C)
        return jnp.log(p) - jnp.log1p(-p)

    return {
        'x_prompt': nrm((BATCH, SEQ, D_MODEL), 1.0),
        'x_sample': nrm((DEC_BATCH, DEC_SEQ, D_MODEL), 1.0),
        'state_delta_s': nrm((DEPTH, DEC_BATCH, A_HEADS, A_DK, A_DV), 0.1),
        'state_delta_conv': nrm((DEPTH, DEC_BATCH, CONV_W - 1, A_CONV_CH), 1.0),
        'state_ssd_h': nrm((DEPTH, DEC_BATCH, B_HEADS, B_STATE, B_HEADDIM), 0.1),
        'state_ssd_conv': nrm((DEPTH, DEC_BATCH, CONV_W - 1, B_CONV_CH), 1.0),
        'state_lru_h': nrm((DEPTH, DEC_BATCH, C_WIDTH), 0.5),
        'state_lru_conv': nrm((DEPTH, DEC_BATCH, CONV_W - 1, C_WIDTH), 1.0),
        'norm_ffn1': gain((DEPTH, D_MODEL)),
        'ffn1_w_gate': nrm((DEPTH, D_MODEL, D_FF), D_MODEL ** -0.5),
        'ffn1_w_up': nrm((DEPTH, D_MODEL, D_FF), D_MODEL ** -0.5),
        'ffn1_w_down': nrm((DEPTH, D_FF, D_MODEL), D_FF ** -0.5),
        'norm_mix': gain((DEPTH, D_MODEL)),
        'w_in': nrm((DEPTH, D_MODEL, D_IN), D_MODEL ** -0.5),
        'conv_a_w': nrm((DEPTH, CONV_W, A_CONV_CH), 0.5),
        'a_log_a': jnp.log(unif((DEPTH, A_HEADS), 1.0, 16.0)),
        'dt_bias_a': dt_bias((DEPTH, A_HEADS)),
        'norm_a_w': gain((DEPTH, A_DV)),
        'conv_b_w': nrm((DEPTH, CONV_W, B_CONV_CH), 0.5),
        'conv_b_b': nrm((DEPTH, B_CONV_CH), 0.01),
        'a_log_b': jnp.log(unif((DEPTH, B_HEADS), 1.0, 16.0)),
        'dt_bias_b': dt_bias((DEPTH, B_HEADS)),
        'd_skip_b': 1.0 + nrm((DEPTH, B_HEADS), 0.1),
        'norm_b_w': gain((DEPTH, B_WIDTH)),
        'conv_c_w': nrm((DEPTH, CONV_W, C_WIDTH), 0.5),
        'conv_c_b': nrm((DEPTH, C_WIDTH), 0.01),
        'w_rgate': nrm((DEPTH, C_BLOCKS, C_BLOCK, C_BLOCK), C_BLOCK ** -0.5),
        'b_rgate': nrm((DEPTH, C_WIDTH), 0.01),
        'w_igate': nrm((DEPTH, C_BLOCKS, C_BLOCK, C_BLOCK), C_BLOCK ** -0.5),
        'b_igate': nrm((DEPTH, C_WIDTH), 0.01),
        'lru_lambda': lru_lambda((DEPTH, C_WIDTH)),
        'w_out': nrm((DEPTH, D_MIX, D_MODEL), D_MIX ** -0.5),
        'norm_ffn2': gain((DEPTH, D_MODEL)),
        'ffn2_w_gate': nrm((DEPTH, D_MODEL, D_FF), D_MODEL ** -0.5),
        'ffn2_w_up': nrm((DEPTH, D_MODEL, D_FF), D_MODEL ** -0.5),
        'ffn2_w_down': nrm((DEPTH, D_FF, D_MODEL), D_FF ** -0.5),
        'norm_final': gain((D_MODEL,)),
    }


def reference(x_prompt, x_sample, state_delta_s, state_delta_conv, state_ssd_h, state_ssd_conv,
              state_lru_h, state_lru_conv, norm_ffn1, ffn1_w_gate, ffn1_w_up, ffn1_w_down, norm_mix,
              w_in, conv_a_w, a_log_a, dt_bias_a, norm_a_w, conv_b_w, conv_b_b, a_log_b, dt_bias_b,
              d_skip_b, norm_b_w, conv_c_w, conv_c_b, w_rgate, b_rgate, w_igate, b_igate, lru_lambda,
              w_out, norm_ffn2, ffn2_w_gate, ffn2_w_up, ffn2_w_down, norm_final):
    params = {
        'norm_ffn1': norm_ffn1, 'ffn1_w_gate': ffn1_w_gate, 'ffn1_w_up': ffn1_w_up, 'ffn1_w_down': ffn1_w_down,
        'norm_mix': norm_mix, 'w_in': w_in,
        'conv_a_w': conv_a_w, 'a_log_a': a_log_a, 'dt_bias_a': dt_bias_a, 'norm_a_w': norm_a_w,
        'conv_b_w': conv_b_w, 'conv_b_b': conv_b_b, 'a_log_b': a_log_b, 'dt_bias_b': dt_bias_b,
        'd_skip_b': d_skip_b, 'norm_b_w': norm_b_w,
        'conv_c_w': conv_c_w, 'conv_c_b': conv_c_b, 'w_rgate': w_rgate, 'b_rgate': b_rgate,
        'w_igate': w_igate, 'b_igate': b_igate, 'lru_lambda': lru_lambda,
        'w_out': w_out,
        'norm_ffn2': norm_ffn2, 'ffn2_w_gate': ffn2_w_gate, 'ffn2_w_up': ffn2_w_up, 'ffn2_w_down': ffn2_w_down,
    }
    f32 = jnp.float32
    bp = x_prompt.shape[0]
    zero_states = (
        jnp.zeros((DEPTH, bp, A_HEADS, A_DK, A_DV), f32),
        jnp.zeros((DEPTH, bp, CONV_W - 1, A_CONV_CH), x_prompt.dtype),
        jnp.zeros((DEPTH, bp, B_HEADS, B_STATE, B_HEADDIM), f32),
        jnp.zeros((DEPTH, bp, CONV_W - 1, B_CONV_CH), x_prompt.dtype),
        jnp.zeros((DEPTH, bp, C_WIDTH), f32),
        jnp.zeros((DEPTH, bp, CONV_W - 1, C_WIDTH), x_prompt.dtype),
    )
    y_prompt, p_states = run_trunk(x_prompt, zero_states, params, norm_final)
    p_delta_s, p_delta_conv, p_ssd_h, p_ssd_conv, p_lru_h, p_lru_conv = p_states
    sample_states = (state_delta_s, state_delta_conv, state_ssd_h, state_ssd_conv, state_lru_h, state_lru_conv)
    y_sample, s_states = run_trunk(x_sample, sample_states, params, norm_final)
    s_delta_s, s_delta_conv, s_ssd_h, s_ssd_conv, s_lru_h, s_lru_conv = s_states
    return (y_prompt, y_sample, p_delta_s, p_delta_conv, p_ssd_h, p_ssd_conv, p_lru_h, p_lru_conv,
            s_delta_s, s_delta_conv, s_ssd_h, s_ssd_conv, s_lru_h, s_lru_conv)
```

```cpp
#include <hip/hip_runtime.h>
#include <hip/hip_cooperative_groups.h>
#include <cstdio>
#include <cstdint>
#define MK_ONE_LAUNCH 1
namespace pg8 {
#define PG8_LAS __attribute__((address_space(3)))
typedef unsigned short bf16_t;
typedef short bf16x8 __attribute__((ext_vector_type(8)));
typedef float f32x4 __attribute__((ext_vector_type(4)));
typedef unsigned u32x4 __attribute__((ext_vector_type(4)));
constexpr int BM = 256, BK = 64, HALF = 128, HTB = HALF * BK * 2  , STAGE_BYTES = 8 * HTB, NXCD = 8, WGM = 8;

__host__ __device__ __forceinline__ int lds_byte(int r, int c) { const int st = (r >> 4) * 2 + (c >> 5), rr = r & 15, cc = c & 31, ob = rr * 64 + cc * 2; return st * 1024 + (ob ^ (((ob >> 9) & 1) << 5)); }
__host__ __device__ __forceinline__ void stage_rc(int b, int& R, int& C) { const int st = b / 1024, sb = b % 1024, swz = sb ^ (((sb >> 9) & 1) << 5); R = (st >> 1) * 16 + swz / 64; C = (st & 1) * 32 + (swz % 64) / 2; }
__host__ __device__ __forceinline__ int perm32(int rho) { const int n = rho >> 4, i = rho & 15; return 8 * (i >> 2) + 4 * n + (i & 3); }

struct Unit { int pm, pn, seq, k0; };
struct Gemm { const bf16_t* A; const bf16_t* Bt; int M, N, K, ld; };

struct StaticOrder {
    int nM, nN, nwg, G, c;
    __host__ __device__ void init(int M, int N, int G_, int c_) { nM = M / BM; nN = N / BM; nwg = nM * nN; G = G_; c = c_; }
    __host__ __device__ bool next(int i, Unit& u) const {
        const long L = (long)i * G + c; if (L >= nwg) return false;
        int wgid = (int)L; { const int q = nwg / NXCD, r = nwg % NXCD, xcd = wgid % NXCD, off = wgid / NXCD; wgid = (xcd < r ? xcd * (q + 1) : r * (q + 1) + (xcd - r) * q) + off; }
        const int nig = WGM * nN, gid = wgid / nig, fm = gid * WGM, gsz = (nM - fm) < WGM ? (nM - fm) : WGM;
        u.pm = fm + ((wgid % nig) % gsz); u.pn = (wgid % nig) / gsz; u.seq = i; u.k0 = 0; return true;
    }
    __device__ __forceinline__ void a_ready(const Unit&) const {}
    __device__ __forceinline__ void done(const Unit&) const {}
};

__device__ __forceinline__ unsigned cvt_pk_bf16(float lo, float hi) { unsigned r; asm volatile("v_cvt_pk_bf16_f32 %0, %1, %2" : "=v"(r) : "v"(lo), "v"(hi)); return r; }
typedef unsigned u32x2v __attribute__((ext_vector_type(2)));
__device__ __forceinline__ float silu_f(float g) { return g * __builtin_amdgcn_rcpf(1.0f + __expf(-g)); }
constexpr int RSLD = 33792;
constexpr int RSL_OFF = 128 * 1024;
template <class Sched> __device__ __forceinline__ void rs_prepare(PG8_LAS unsigned char* lds, const Sched& S, const float* RS, int tid) {
    PG8_LAS float* rsl = (PG8_LAS float*)(lds + RSL_OFF); Unit u; int nU = 0;
    while (S.next(nU, u)) ++nU;
#pragma unroll 2
    for (int idx = tid; idx < nU * 256; idx += 512) { const int i = idx >> 8, r = idx & 255; S.next(i, u); const float* p = RS + (size_t)u.pm * BM + r;
        float q[16];
#pragma unroll
        for (int k = 0; k < 16; ++k) q[k] = p[(size_t)k * RSLD];
        const float s = (((q[0] + q[1]) + (q[2] + q[3])) + ((q[4] + q[5]) + (q[6] + q[7]))) + (((q[8] + q[9]) + (q[10] + q[11])) + ((q[12] + q[13]) + (q[14] + q[15])));
        rsl[i * 256 + r] = rsqrtf(s * (1.0f / 1024.f) + 1e-6f); }
    __syncthreads();
}
__device__ __forceinline__ float row_rs(PG8_LAS unsigned char* lds, const Unit& u, int rloc) { return ((const PG8_LAS float*)(lds + RSL_OFF))[u.seq * 256 + rloc]; }
typedef unsigned u32x4v __attribute__((ext_vector_type(4)));
struct EpiGU {
    static constexpr bool PERM = true, AFTER_DRAIN = false;
    bf16_t* O; int ldo; PG8_LAS unsigned char* lds;
    __device__ __forceinline__ void operator()(const f32x4 (&acc)[2][2][4][2], const Unit& u, int wr, int wc, int fr, int fq) const {
        const int row0 = u.pm * BM + wr * 64 + fr, col0 = u.pn * HALF + wc * 32 + 8 * fq;
#pragma unroll
        for (int ai = 0; ai < 2; ++ai)
#pragma unroll
            for (int m = 0; m < 4; ++m) { const int row = row0 + ai * HALF + m * 16; const float rs = row_rs(lds, u, wr * 64 + ai * HALF + m * 16 + fr);
                const f32x4 g0 = acc[ai][0][m][0] * rs, g1 = acc[ai][0][m][1] * rs, v0 = acc[ai][1][m][0] * rs, v1 = acc[ai][1][m][1] * rs;
                u32x4v w; w.x = cvt_pk_bf16(silu_f(g0[0]) * v0[0], silu_f(g0[1]) * v0[1]); w.y = cvt_pk_bf16(silu_f(g0[2]) * v0[2], silu_f(g0[3]) * v0[3]);
                w.z = cvt_pk_bf16(silu_f(g1[0]) * v1[0], silu_f(g1[1]) * v1[1]); w.w = cvt_pk_bf16(silu_f(g1[2]) * v1[2], silu_f(g1[3]) * v1[3]);
                *(u32x4v*)(O + (size_t)row * ldo + col0) = w; }
    }
};
struct EpiRes {
    static constexpr bool PERM = true, AFTER_DRAIN = false;
    static constexpr int ldc = 1024;
    bf16_t* XB; bf16_t* XO; float scale; float* RS;
    __device__ __forceinline__ void operator()(const f32x4 (&acc)[2][2][4][2], const Unit& u, int wr, int wc, int fr, int fq) const {
        const int row0 = u.pm * BM + wr * 64 + fr, col0 = u.pn * BM + wc * 32 + 8 * fq;
#pragma unroll
        for (int ai = 0; ai < 2; ++ai) {
            u32x4v xi[4][2];
#pragma unroll
            for (int m = 0; m < 4; ++m)
#pragma unroll
                for (int bj = 0; bj < 2; ++bj) xi[m][bj] = *(const u32x4v*)(XB + (size_t)(row0 + ai * HALF + m * 16) * ldc + col0 + bj * HALF);
#pragma unroll
            for (int m = 0; m < 4; ++m) { const int row = row0 + ai * HALF + m * 16; float ss = 0.f;
#pragma unroll
                for (int bj = 0; bj < 2; ++bj) { const u32x4v x = xi[m][bj];
                    f32x4 o0 = {__uint_as_float(x.x << 16), __uint_as_float(x.x & 0xffff0000u), __uint_as_float(x.y << 16), __uint_as_float(x.y & 0xffff0000u)};
                    f32x4 o1 = {__uint_as_float(x.z << 16), __uint_as_float(x.z & 0xffff0000u), __uint_as_float(x.w << 16), __uint_as_float(x.w & 0xffff0000u)};
                    o0 += scale * acc[ai][bj][m][0]; o1 += scale * acc[ai][bj][m][1];
                    { u32x4v w; w.x = cvt_pk_bf16(o0[0], o0[1]); w.y = cvt_pk_bf16(o0[2], o0[3]); w.z = cvt_pk_bf16(o1[0], o1[1]); w.w = cvt_pk_bf16(o1[2], o1[3]);
                        *(u32x4v*)(XO + (size_t)row * ldc + col0 + bj * HALF) = w;
                        const float r0 = __uint_as_float(w.x << 16), r1 = __uint_as_float(w.x & 0xffff0000u), r2 = __uint_as_float(w.y << 16), r3 = __uint_as_float(w.y & 0xffff0000u),
                                    r4 = __uint_as_float(w.z << 16), r5 = __uint_as_float(w.z & 0xffff0000u), r6 = __uint_as_float(w.w << 16), r7 = __uint_as_float(w.w & 0xffff0000u);
                        ss += (r0 * r0 + r1 * r1 + r2 * r2 + r3 * r3) + (r4 * r4 + r5 * r5 + r6 * r6 + r7 * r7); } }
                { ss += __shfl_xor(ss, 16); ss += __shfl_xor(ss, 32); if (fq == 0) RS[(size_t)(u.pn * 4 + wc) * RSLD + row] = ss; } }
        }
    }
};
struct EpiP {
    static constexpr bool PERM = true, AFTER_DRAIN = false;
    bf16_t* O; int ldo; int ncols; PG8_LAS unsigned char* lds;
    __device__ __forceinline__ void operator()(const f32x4 (&acc)[2][2][4][2], const Unit& u, int wr, int wc, int fr, int fq) const {
        const int row0 = u.pm * BM + wr * 64 + fr, col0 = u.pn * BM + wc * 32 + 8 * fq;
#pragma unroll
        for (int ai = 0; ai < 2; ++ai)
#pragma unroll
            for (int m = 0; m < 4; ++m) { const int row = row0 + ai * HALF + m * 16; bf16_t* rowp = O + (size_t)row * ldo; const float rs = row_rs(lds, u, wr * 64 + ai * HALF + m * 16 + fr);
#pragma unroll
                for (int bj = 0; bj < 2; ++bj) { const int c = col0 + bj * HALF; const f32x4 v0 = acc[ai][bj][m][0] * rs, v1 = acc[ai][bj][m][1] * rs;
                    if (c < ncols) { u32x4v w; w.x = cvt_pk_bf16(v0[0], v0[1]); w.y = cvt_pk_bf16(v0[2], v0[3]); w.z = cvt_pk_bf16(v1[0], v1[1]); w.w = cvt_pk_bf16(v1[2], v1[3]); *(u32x4v*)(rowp + c) = w; } } }
    }
};

struct SplitKOrder {
    int nM, nN, nK, kslice, G, c;
    __device__ bool next(int i, Unit& u) const { const int L = i * G + c; if (L >= nM * nN * nK) return false; u.pn = L % nN; u.pm = (L / nN) % nM; u.k0 = (L / (nN * nM)) * kslice; u.seq = i; return true; }
    __device__ __forceinline__ void a_ready(const Unit&) const {}
    __device__ __forceinline__ void done(const Unit&) const {}
};
struct EpiSlab {
    static constexpr bool PERM = false, AFTER_DRAIN = false;
    float* S; int ldc; int kslice; size_t slab;
    __device__ __forceinline__ void operator()(const f32x4 (&acc)[2][2][4][2], const Unit& u, int wr, int wc, int fr, int fq) const {
        const int row0 = u.pm * BM + wr * 64 + fr, col0 = u.pn * BM + wc * 32 + 4 * fq; float* base = S + (size_t)(u.k0 / kslice) * slab;
#pragma unroll
        for (int ai = 0; ai < 2; ++ai)
#pragma unroll
            for (int m = 0; m < 4; ++m) { float* rowp = base + (size_t)(row0 + ai * HALF + m * 16) * ldc + col0;
#pragma unroll
                for (int bj = 0; bj < 2; ++bj)
#pragma unroll
                    for (int n = 0; n < 2; ++n) *(f32x4*)(rowp + bj * HALF + n * 16) = acc[ai][bj][m][n]; }
    }
};
template <class Epi, class Sched, bool ALIGN_EPI = false, bool SP2 = false>
__device__ __forceinline__ void gemm_phase(PG8_LAS unsigned char* lds, const Gemm g, const Sched& S, const Epi& E) {
    int tid_ = threadIdx.x; asm volatile("" : "+v"(tid_));
    const int tid = tid_, wid = __builtin_amdgcn_readfirstlane(tid >> 6), lane = tid & 63, wr = wid >> 2, wc = wid & 3, fr = lane & 15, fq = lane >> 4;
    const int K = g.K, nt = K / BK, LD = g.ld ? g.ld : g.K;
    unsigned voffA[2], voffB[2];
#pragma unroll
    for (int i = 0; i < 2; ++i) { int R, C; stage_rc(tid * 16 + i * 8192, R, C); const int Rb = Epi::PERM ? ((R & ~31) + perm32(R & 31)) : R;
        voffA[i] = (unsigned)(R * LD + C) * 2u; voffB[i] = (unsigned)(Rb * LD + C) * 2u; }
    const size_t kstep = (size_t)(BK * 2);
    const size_t hstep = (size_t)HALF * LD * 2;
    const size_t tstep = 2 * hstep;
    const unsigned ldsw = (unsigned)wid * 1024u;
    const int aoff = lds_byte(wr * 64 + fr, fq * 8), boff = lds_byte(wc * 32 + fr, fq * 8);
#define PG8_SA(b, h) (((b) * 2 + (h)) * HTB)
#define PG8_SB(b, h) ((4 + (b) * 2 + (h)) * HTB)
#define PG8_STAGE(bufoff, gbase, voff) do { _Pragma("unroll") for (int _i = 0; _i < 2; ++_i) \
        __builtin_amdgcn_global_load_lds((const unsigned*)((const char*)(gbase) + (voff)[_i]), (PG8_LAS unsigned*)(lds + (bufoff) + ldsw + _i * 8192), 16, 0, 0); } while (0)
#define PG8_LDA(dst, b, h) do { _Pragma("unroll") for (int m = 0; m < 4; ++m) _Pragma("unroll") for (int k = 0; k < 2; ++k) dst[m][k] = *(const PG8_LAS bf16x8*)(lds + PG8_SA(b, h) + aoff + m * 2048 + k * 1024); } while (0)
#define PG8_LDB(dst, b, h) do { _Pragma("unroll") for (int n = 0; n < 2; ++n) _Pragma("unroll") for (int k = 0; k < 2; ++k) dst[n][k] = *(const PG8_LAS bf16x8*)(lds + PG8_SB(b, h) + boff + n * 2048 + k * 1024); } while (0)
#define PG8_MMA(ai, bj, At, Bt) do { __builtin_amdgcn_s_setprio(1); _Pragma("unroll") for (int m = 0; m < 4; ++m) _Pragma("unroll") for (int n = 0; n < 2; ++n) _Pragma("unroll") for (int k = 0; k < 2; ++k) \
        acc[ai][bj][m][n] = __builtin_amdgcn_mfma_f32_16x16x32_bf16(Bt[n][k], At[m][k], acc[ai][bj][m][n], 0, 0, 0); __builtin_amdgcn_s_setprio(0); } while (0)
#define PG8_WAIT_V(n) asm volatile("s_waitcnt vmcnt(" #n ")" ::: "memory")
#define PG8_WAIT_L(n) asm volatile("s_waitcnt lgkmcnt(" #n ")" ::: "memory")
#define PG8_BAR __builtin_amdgcn_s_barrier()
#define PG8_SCHED __builtin_amdgcn_sched_barrier(0)
    Unit cur, nxt; int ui = 0;
    if (!S.next(0, cur)) return;
    f32x4 acc[2][2][4][2];
#pragma unroll
    for (int a = 0; a < 2; ++a)
#pragma unroll
        for (int b = 0; b < 2; ++b)
#pragma unroll
            for (int m = 0; m < 4; ++m)
#pragma unroll
                for (int n = 0; n < 2; ++n) acc[a][b][m][n] = (f32x4){0.f, 0.f, 0.f, 0.f};
    bf16x8 At[4][2], B0[2][2], B1[2][2];
    const char* cA = (const char*)g.A + (size_t)cur.pm * tstep + (size_t)cur.k0 * 2; const char* cB = (const char*)g.Bt + (size_t)cur.pn * tstep + (size_t)cur.k0 * 2;
    S.a_ready(cur);
    if constexpr (SP2) {
        PG8_STAGE(PG8_SB(0, 0), cB, voffB); PG8_STAGE(PG8_SB(0, 1), cB + hstep, voffB); PG8_STAGE(PG8_SA(0, 0), cA, voffA); PG8_STAGE(PG8_SA(0, 1), cA + hstep, voffA);
        if (wr == 1) PG8_BAR;
        PG8_WAIT_V(2); PG8_BAR;
        PG8_STAGE(PG8_SB(1, 0), cB + kstep, voffB); PG8_STAGE(PG8_SA(1, 0), cA + kstep, voffA); PG8_STAGE(PG8_SB(1, 1), cB + hstep + kstep, voffB);
        PG8_WAIT_V(6); PG8_BAR;
    } else {
        PG8_STAGE(PG8_SB(0, 0), cB, voffB); PG8_STAGE(PG8_SA(0, 0), cA, voffA); PG8_STAGE(PG8_SB(0, 1), cB + hstep, voffB); PG8_STAGE(PG8_SA(0, 1), cA + hstep, voffA);
        if (wr == 1) PG8_BAR;
        PG8_WAIT_V(4); PG8_BAR;
        PG8_STAGE(PG8_SB(1, 0), cB + kstep, voffB); PG8_STAGE(PG8_SA(1, 0), cA + kstep, voffA); PG8_STAGE(PG8_SB(1, 1), cB + hstep + kstep, voffB);
        PG8_WAIT_V(6); PG8_BAR;
    }
    for (;;) {
        const bool has_next = S.next(ui + 1, nxt);
        const char* nA = has_next ? (const char*)g.A + (size_t)nxt.pm * tstep + (size_t)nxt.k0 * 2 : cA; const char* nB = has_next ? (const char*)g.Bt + (size_t)nxt.pn * tstep + (size_t)nxt.k0 * 2 : cB;
        for (int t = 0; t < nt; t += 2) {
            const bool last = (t == nt - 2);
            const char* a1 = cA + (size_t)(t + 1) * kstep;
            const char* a2 = last ? nA : cA + (size_t)(t + 2) * kstep; const char* b2 = last ? nB : cB + (size_t)(t + 2) * kstep;
            const char* a3 = a2 + kstep; const char* b3 = b2 + kstep;
            if (last && has_next) S.a_ready(nxt);
            if constexpr (SP2) {
            PG8_LDB(B0, 0, 0); PG8_LDB(B1, 0, 1); PG8_SCHED; PG8_LDA(At, 0, 0); PG8_STAGE(PG8_SA(1, 1), a1 + hstep, voffA);
            PG8_WAIT_V(8); PG8_WAIT_L(0); PG8_BAR; PG8_MMA(0, 0, At, B0); PG8_MMA(0, 1, At, B1); PG8_BAR; PG8_SCHED;
            PG8_LDA(At, 0, 1); PG8_STAGE(PG8_SB(0, 0), b2, voffB); PG8_STAGE(PG8_SB(0, 1), b2 + hstep, voffB); PG8_STAGE(PG8_SA(0, 0), a2, voffA);
            PG8_WAIT_V(8); PG8_WAIT_L(0); PG8_BAR; PG8_MMA(1, 0, At, B0); PG8_MMA(1, 1, At, B1); PG8_BAR; PG8_SCHED;
            PG8_LDB(B0, 1, 0); PG8_LDB(B1, 1, 1); PG8_SCHED; PG8_LDA(At, 1, 0); PG8_STAGE(PG8_SA(0, 1), a2 + hstep, voffA);
            PG8_WAIT_V(8); PG8_WAIT_L(0); PG8_BAR; PG8_MMA(0, 0, At, B0); PG8_MMA(0, 1, At, B1); PG8_BAR; PG8_SCHED;
            PG8_LDA(At, 1, 1); PG8_STAGE(PG8_SB(1, 0), b3, voffB); PG8_STAGE(PG8_SB(1, 1), b3 + hstep, voffB); PG8_STAGE(PG8_SA(1, 0), a3, voffA);
            PG8_WAIT_V(8); PG8_WAIT_L(0); PG8_BAR; PG8_MMA(1, 0, At, B0); PG8_MMA(1, 1, At, B1); PG8_BAR; PG8_SCHED;
            } else {
            PG8_LDB(B0, 0, 0); PG8_SCHED; PG8_LDA(At, 0, 0); PG8_STAGE(PG8_SA(1, 1), a1 + hstep, voffA);
            PG8_WAIT_L(8); PG8_BAR; PG8_WAIT_L(0); PG8_MMA(0, 0, At, B0); PG8_BAR; PG8_SCHED;
            PG8_LDB(B1, 0, 1); PG8_STAGE(PG8_SB(0, 0), b2, voffB);
            PG8_BAR; PG8_WAIT_L(0); PG8_MMA(0, 1, At, B1); PG8_BAR;
            PG8_LDA(At, 0, 1); PG8_STAGE(PG8_SA(0, 0), a2, voffA);
            PG8_BAR; PG8_WAIT_L(0); PG8_MMA(1, 0, At, B0); PG8_BAR; PG8_SCHED;
            PG8_STAGE(PG8_SB(0, 1), b2 + hstep, voffB);
            PG8_WAIT_V(6); PG8_BAR; PG8_MMA(1, 1, At, B1); PG8_BAR;
            PG8_LDB(B0, 1, 0); PG8_SCHED; PG8_LDA(At, 1, 0); PG8_STAGE(PG8_SA(0, 1), a2 + hstep, voffA);
            PG8_WAIT_L(8); PG8_BAR; PG8_WAIT_L(0); PG8_MMA(0, 0, At, B0); PG8_BAR; PG8_SCHED;
            PG8_LDB(B1, 1, 1); PG8_STAGE(PG8_SB(1, 0), b3, voffB);
            PG8_BAR; PG8_WAIT_L(0); PG8_MMA(0, 1, At, B1); PG8_BAR;
            PG8_LDA(At, 1, 1); PG8_STAGE(PG8_SA(1, 0), a3, voffA);
            PG8_BAR; PG8_WAIT_L(0); PG8_MMA(1, 0, At, B0); PG8_BAR; PG8_SCHED;
            PG8_STAGE(PG8_SB(1, 1), b3 + hstep, voffB);
            PG8_WAIT_V(6); PG8_BAR; PG8_MMA(1, 1, At, B1); PG8_BAR;
            }
        }
        if constexpr (ALIGN_EPI) { if (wr == 0) PG8_BAR; }
        if constexpr (!Epi::AFTER_DRAIN) { E(acc, cur, wr, wc, fr, fq); S.done(cur); }
        if (!has_next) break;
#pragma unroll
        for (int a = 0; a < 2; ++a)
#pragma unroll
            for (int b = 0; b < 2; ++b)
#pragma unroll
                for (int m = 0; m < 4; ++m)
#pragma unroll
                    for (int n = 0; n < 2; ++n) acc[a][b][m][n] = (f32x4){0.f, 0.f, 0.f, 0.f};
        cur = nxt; cA = nA; cB = nB; ++ui;
        if constexpr (ALIGN_EPI) { if (wr == 1) PG8_BAR; }
    }
    PG8_WAIT_V(0);
    if constexpr (!ALIGN_EPI) { if (wr == 0) PG8_BAR; }
    PG8_BAR;
    if constexpr (Epi::AFTER_DRAIN) { E.fused(acc, cur, wr, wc, fr, fq, lds, wid, lane); S.done(cur); }
#undef PG8_SA
#undef PG8_SB
#undef PG8_STAGE
#undef PG8_LDA
#undef PG8_LDB
#undef PG8_MMA
#undef PG8_WAIT_V
#undef PG8_WAIT_L
#undef PG8_BAR
#undef PG8_SCHED
}
}
#define XB_TMO      128
#define XB_XCNT(j)  (256  + 64 * (j))
#define XB_XSUB(j)  (1280 + 64 * (j))
#define XB_XGEN(j)  (2304 + 64 * (j))
#define XB_TOP      3328
#define XB_TOPGEN   3392
#define XCD_BAR_WORDS 3456
#define XB_SPIN_CAP (1u << 24)
#define LAS __attribute__((address_space(3)))

__device__ __forceinline__ unsigned xb_ld(unsigned* p)              { return __hip_atomic_load(p, __ATOMIC_RELAXED, __HIP_MEMORY_SCOPE_AGENT); }
__device__ __forceinline__ unsigned xb_add(unsigned* p, unsigned v) { return __hip_atomic_fetch_add(p, v, __ATOMIC_RELAXED, __HIP_MEMORY_SCOPE_AGENT); }
__device__ __forceinline__ unsigned xb_xcc_id() { return (unsigned)__builtin_amdgcn_s_getreg((3 << 11) | 20) & 0xFu; }
#define XB_SPIN(cond, bar) do { unsigned _sp = 0; while (cond) { __builtin_amdgcn_s_sleep(1); \
    if ((++_sp & 255u) == 0u) { if (xb_ld(&(bar)[XB_TMO])) break; if (_sp > XB_SPIN_CAP) { atomicAdd(&(bar)[XB_TMO], 1u); break; } } } } while (0)

struct XcdBarrier {
    unsigned* bar; unsigned x;
    volatile LAS unsigned* st;
};

__device__ __forceinline__ XcdBarrier xcd_barrier_post(unsigned* bar, volatile LAS unsigned* st) {
    XcdBarrier b; b.bar = bar; b.x = xb_xcc_id(); b.st = st;
    if (threadIdx.x == 0) (void)xb_add(&bar[XB_XCNT(b.x)], 1u);
    return b;
}
__device__ __forceinline__ void xcd_barrier_complete(unsigned* bar, unsigned x, unsigned& nloc, unsigned& nx) {
    const unsigned G = gridDim.x * gridDim.y * gridDim.z;
    unsigned sum, cnt, mine, sp = 0u;
    for (;;) {
        sum = 0u; cnt = 0u; mine = 0u;
#pragma unroll
        for (unsigned j = 0; j < 16; ++j) { const unsigned c = xb_ld(&bar[XB_XCNT(j)]); sum += c; cnt += (c > 0u) ? 1u : 0u; mine = (j == x) ? c : mine; }
        if (sum == G) break;
        __builtin_amdgcn_s_sleep(1);
        if ((++sp & 255u) == 0u) { if (xb_ld(&bar[XB_TMO])) break; if (sp > XB_SPIN_CAP) { atomicAdd(&bar[XB_TMO], 1u); break; } }
    }
    nloc = mine > 0u ? mine : 1u; nx = cnt > 0u ? cnt : 1u;
}

__device__ __forceinline__ void xcd_barrier(const XcdBarrier& b) {
    asm volatile("s_waitcnt vmcnt(0)" ::: "memory");
    __syncthreads();
    if (threadIdx.x == 0) {
        unsigned* bar = b.bar;
        __builtin_amdgcn_s_waitcnt(0);
        unsigned nloc = b.st[0], nx = b.st[1];
        if (nloc == 0u) { xcd_barrier_complete(bar, b.x, nloc, nx); b.st[0] = nloc; b.st[1] = nx; }
        const unsigned old = xb_add(&bar[XB_XSUB(b.x)], 1u);
        const unsigned gen = old / nloc;
        if (old + 1u == (gen + 1u) * nloc) {
            __builtin_amdgcn_fence(__ATOMIC_RELEASE, "agent");
            asm volatile("s_waitcnt vmcnt(0)" ::: "memory");
            const unsigned og = xb_add(&bar[XB_TOP], 1u);
            const unsigned tg = og / nx;
            if (og + 1u == (tg + 1u) * nx) xb_add(&bar[XB_TOPGEN], 1u);
            else XB_SPIN(xb_ld(&bar[XB_TOPGEN]) == tg, bar);
            __builtin_amdgcn_fence(__ATOMIC_ACQUIRE, "agent");
            xb_add(&bar[XB_XGEN(b.x)], 1u);
            asm volatile("s_waitcnt vmcnt(0)" ::: "memory");
        } else {
            XB_SPIN(xb_ld(&bar[XB_XGEN(b.x)]) == gen, bar);
            __builtin_amdgcn_fence(__ATOMIC_ACQUIRE, "agent");
            asm volatile("s_waitcnt vmcnt(0)" ::: "memory");
        }
    }
    __syncthreads();
}


typedef unsigned short bf16_t;
typedef float f32x4 __attribute__((ext_vector_type(4)));
typedef unsigned u32x2 __attribute__((ext_vector_type(2)));
typedef unsigned u32x4 __attribute__((ext_vector_type(4)));
constexpr int TP = 32768, TS = 1024, T = 33792, D = 1024, FF = 2816, NGU = 5632, PSTR = 3104, NPIN = 3328;
constexpr int PQ = 0, PK = 384, PV = 768, PZA = 1152, PZB = 1536, PXBC = 1920, PGC = 2560, PXC = 2816, PBA = 3072, PAA = 3078, PDT = 3084;
constexpr size_t SZ_WGU = (size_t)NGU * D * 2, SZ_WDN = (size_t)D * FF * 2, SZ_WIN = (size_t)NPIN * D * 2, SZ_WOUT = (size_t)D * D * 2;
constexpr size_t WS_CTL = 0, WS_WGU = 65536, WS_WDN = WS_WGU + 4 * SZ_WGU, WS_WIN = WS_WDN + 4 * SZ_WDN, WS_WOUT = WS_WIN + 2 * SZ_WIN,
                 WS_H = WS_WOUT + 2 * SZ_WOUT, WS_P = WS_H + (size_t)T * D * 2, WS_M = WS_P + (size_t)T * PSTR * 2;
constexpr size_t WS_END = WS_M + (size_t)160 * 1024 * 1024;
constexpr size_t O_PDS = (size_t)T * D, O_PDC = O_PDS + 2 * 2 * 6 * 4096, O_PSH = O_PDC + 2 * 2 * 3 * 1152, O_PSC = O_PSH + 2 * 2 * 6 * 4096, O_PLH = O_PSC + 2 * 2 * 3 * 640,
                 O_PLC = O_PLH + 2 * 2 * 256, O_SDS = O_PLC + 2 * 2 * 3 * 256, O_SDC = O_SDS + 2 * 16 * 6 * 4096, O_SSH = O_SDC + 2 * 16 * 3 * 1152, O_SSC = O_SSH + 2 * 16 * 6 * 4096,
                 O_SLH = O_SSC + 2 * 16 * 3 * 640, O_SLC = O_SLH + 2 * 16 * 256, O_END = O_SLC + 2 * 16 * 3 * 256;
constexpr int LDS_BYTES = 148 * 1024;
constexpr int MISC_OFF = 144 * 1024;

__device__ __forceinline__ int tidx() { int t = threadIdx.x; asm volatile("" : "+v"(t)); return t; }
struct Args { const float* in[37]; float* out; unsigned char* ws; int ph_lo, ph_hi; };
typedef __attribute__((address_space(4))) Args CArgs;
#define INP(a, k) ((a).in[k])
#define OUTP(a) ((a).out)
#define WSP(a) ((a).ws)

__device__ __forceinline__ float bf2f(bf16_t b) { return __uint_as_float(((unsigned)b) << 16); }
__device__ __forceinline__ bf16_t f2bf(float f) { unsigned u = __float_as_uint(f); u += 0x7FFFu + ((u >> 16) & 1u); return (bf16_t)(u >> 16); }
__device__ __forceinline__ unsigned pk_bf16(float lo, float hi) { return (unsigned)f2bf(lo) | ((unsigned)f2bf(hi) << 16); }
__device__ __forceinline__ float sigmoid_f(float x) { return __builtin_amdgcn_rcpf(1.0f + __expf(-x)); }
__device__ __forceinline__ float softplus_f(float x) { return fmaxf(x, 0.f) + log1pf(__expf(-fabsf(x))); }
__device__ __forceinline__ float siluf(float x) { return x * __builtin_amdgcn_rcpf(1.0f + __expf(-x)); }
__device__ __forceinline__ float gelu_tanh(float x) { const float u = 0.7978845608028654f * (x + 0.044715f * x * x * x); return 0.5f * x * (1.0f + tanhf(u)); }
__device__ __forceinline__ float one_minus_exp(float t) { const float p = -t * (1.0f + t * (0.5f + t * (0.16666667f + t * 0.041666668f))); return t > -0.03125f ? p : 1.0f - __expf(t); }
__device__ __forceinline__ float wave_sum(float v) {
#pragma unroll
    for (int o = 32; o >= 1; o >>= 1) v += __shfl_xor(v, o);
    return v; }
__device__ __forceinline__ float rdlane(float v, int l) { return __int_as_float(__builtin_amdgcn_readlane(__float_as_int(v), l)); }
__device__ __forceinline__ float* state_out(float* out, size_t base_p, size_t base_s, int l, int s, size_t sz) { return s < 2 ? out + base_p + ((size_t)l * 2 + s) * sz : out + base_s + ((size_t)l * 16 + (s - 2)) * sz; }
__device__ __forceinline__ int seq_len(int s) { return s < 2 ? 16384 : 64; }
__device__ __forceinline__ size_t seq_row0(int s) { return s < 2 ? (size_t)s * 16384 : (size_t)TP + (size_t)(s - 2) * 64; }

__device__ __forceinline__ int win_refcol(int c) {
    if (c < 1536) return c;
    if (c < 1920) return 1548 + (c - 1536);
    if (c < 2560) return 1932 + (c - 1920);
    if (c < 2816) return 2578 + (c - 2560);
    if (c < 3072) return 2834 + (c - 2816);
    if (c < 3078) return 1536 + (c - 3072);
    if (c < 3084) return 1542 + (c - 3078);
    if (c < 3090) return 2572 + (c - 3084);
    return -1; }
struct WTile { const float* src; const float* gain; bf16_t* dst; int K, ldw, rho0, k0, col; };
__device__ __forceinline__ void wprep_decode(const CArgs& a, int id, int tid, WTile& t) {
    constexpr int PER_LAYER = 1408 * 2 + 704 * 2 + 832 + 256;
    const int l = id / PER_LAYER; int r = id % PER_LAYER; int kind; const float* w0; const float* w1 = nullptr; t.gain = nullptr;
    if (r < 2816) { const int f = r / 1408; r %= 1408; kind = 0; t.K = D; t.ldw = FF; w0 = INP(a, f ? 33 : 9) + (size_t)l * D * FF; w1 = INP(a, f ? 34 : 10) + (size_t)l * D * FF; t.gain = INP(a, f ? 32 : 8) + (size_t)l * D; t.dst = (bf16_t*)(WSP(a) + WS_WGU + (size_t)(l * 2 + f) * SZ_WGU); }
    else if (r < 4224) { r -= 2816; const int f = r / 704; r %= 704; kind = 1; t.K = FF; t.ldw = D; w0 = INP(a, f ? 35 : 11) + (size_t)l * FF * D; t.dst = (bf16_t*)(WSP(a) + WS_WDN + (size_t)(l * 2 + f) * SZ_WDN); }
    else if (r < 5056) { r -= 4224; kind = 2; t.K = D; t.ldw = 3090; w0 = INP(a, 13) + (size_t)l * D * 3090; t.gain = INP(a, 12) + (size_t)l * D; t.dst = (bf16_t*)(WSP(a) + WS_WIN + (size_t)l * SZ_WIN); }
    else { r -= 5056; kind = 1; t.K = D; t.ldw = D; w0 = INP(a, 31) + (size_t)l * D * D; t.dst = (bf16_t*)(WSP(a) + WS_WOUT + (size_t)l * SZ_WOUT); }
    const int ktiles = t.K / 64; t.rho0 = (r / ktiles) * 64; t.k0 = (r % ktiles) * 64;
    const int rho = t.rho0 + (tid & 63); t.src = w0; t.col = rho;
    if (kind == 0) { const int U = rho >> 8, uu = (rho >> 7) & 1, i = rho & 127; t.src = uu ? w1 : w0; t.col = 128 * U + i; }
    else if (kind == 2) t.col = win_refcol(rho);
}
__device__ __forceinline__ void wprep_load(const WTile& t, int tid, float (&v)[8]) {
    const int kk0 = tid >> 6;
#pragma unroll
    for (int j = 0; j < 8; ++j) { const int kk = kk0 + 8 * j; v[j] = t.col >= 0 ? __builtin_nontemporal_load(t.src + (size_t)(t.k0 + kk) * t.ldw + t.col) * (t.gain ? t.gain[t.k0 + kk] : 1.0f) : 0.f; }
}
__device__ void wprep_phase(const CArgs& a, LAS unsigned char* lds) {
    LAS float* tile = (LAS float*)lds;
    const int tid = tidx(); constexpr int NT = 2 * (1408 * 2 + 704 * 2 + 832 + 256);
    int id = blockIdx.x; if (id >= NT) return;
    WTile cur, nxt; float v[8];
    wprep_decode(a, id, tid, cur); wprep_load(cur, tid, v);
    for (; id < NT; id += gridDim.x) {
        {   const int rr = tid & 63, kk0 = tid >> 6;
#pragma unroll
            for (int j = 0; j < 8; ++j) tile[(kk0 + 8 * j) * 65 + rr] = v[j]; }
        __syncthreads();
        const bool more = id + (int)gridDim.x < NT;
        if (more) { wprep_decode(a, id + gridDim.x, tid, nxt); wprep_load(nxt, tid, v); }
        {   const int rr = tid >> 3, ks = tid & 7; float o[8];
#pragma unroll
            for (int e = 0; e < 8; ++e) o[e] = tile[(ks * 8 + e) * 65 + rr];
            u32x4 w; w.x = pk_bf16(o[0], o[1]); w.y = pk_bf16(o[2], o[3]); w.z = pk_bf16(o[4], o[5]); w.w = pk_bf16(o[6], o[7]);
            *(u32x4*)(cur.dst + (size_t)(cur.rho0 + rr) * cur.K + cur.k0 + ks * 8) = w; }
        __syncthreads();
        cur = nxt;
    }
}

constexpr int XSPLIT = T / 2;
constexpr size_t WS_RS = WS_M + (size_t)70 * 1024 * 1024;
__device__ void norm_phase(const CArgs& a, const float* gain, int mode) {
    float* Y = OUTP(a); bf16_t* XB = (bf16_t*)OUTP(a); float* RS = (float*)(WSP(a) + WS_RS); const bf16_t* XF = (const bf16_t*)(WSP(a) + WS_H);
    const int lane = tidx() & 63, gw = blockIdx.x * 8 + (tidx() >> 6), nw = gridDim.x * 8;
    f32x4 g[4];
#pragma unroll
    for (int j = 0; j < 4; ++j) g[j] = mode == 2 ? *(const f32x4*)(gain + j * 256 + lane * 4) : (f32x4){1.f, 1.f, 1.f, 1.f};
    for (int row0 = gw; row0 < T; row0 += 2 * nw) {
        f32x4 v[2][4]; float ss[2] = {0.f, 0.f};
#pragma unroll
        for (int q = 0; q < 2; ++q) { const int row = row0 + q * nw; if (row < T) {
            if (mode == 0) { const float* src = row < TP ? INP(a, 0) + (size_t)row * D : INP(a, 1) + (size_t)(row - TP) * D;
#pragma unroll
                for (int j = 0; j < 4; ++j) v[q][j] = __builtin_nontemporal_load((const f32x4*)(src + j * 256 + lane * 4)); }
            else {
#pragma unroll
                for (int j = 0; j < 4; ++j) { const u32x2 x = *(const u32x2*)(XF + (size_t)row * D + j * 256 + lane * 4);
                    v[q][j] = (f32x4){__uint_as_float(x.x << 16), __uint_as_float(x.x & 0xffff0000u), __uint_as_float(x.y << 16), __uint_as_float(x.y & 0xffff0000u)}; } } } }
#pragma unroll
        for (int q = 0; q < 2; ++q) { const int row = row0 + q * nw; if (row < T) {
#pragma unroll
            for (int j = 0; j < 4; ++j) ss[q] += v[q][j][0] * v[q][j][0] + v[q][j][1] * v[q][j][1] + v[q][j][2] * v[q][j][2] + v[q][j][3] * v[q][j][3];
            ss[q] = wave_sum(ss[q]);
            if (mode == 0) { if (lane < 16) RS[(size_t)lane * T + row] = lane == 0 ? ss[q] : 0.f; }
            const float r = rsqrtf(ss[q] * (1.0f / D) + 1e-6f);
#pragma unroll
            for (int j = 0; j < 4; ++j) {
                if (mode == 0) { u32x2 w; w.x = pk_bf16(v[q][j][0], v[q][j][1]); w.y = pk_bf16(v[q][j][2], v[q][j][3]); *(u32x2*)(XB + (size_t)row * D + j * 256 + lane * 4) = w; }
                else *(f32x4*)(Y + (size_t)row * D + j * 256 + lane * 4) = v[q][j] * r * g[j];
            } } }
    }
}

constexpr size_t WS_SLAB = WS_M + (size_t)80 * 1024 * 1024;
template <int NSL> __device__ __forceinline__ void sample_reduce_phase(const CArgs& a, float scale, bool last, float* RS) {
    bf16_t* XB = (bf16_t*)OUTP(a); bf16_t* XO = last ? (bf16_t*)(WSP(a) + WS_H) : XB; const float* SL = (const float*)(WSP(a) + WS_SLAB);
    const int lane = tidx() & 63, gw = blockIdx.x * 8 + (tidx() >> 6);
    if (gw >= TS) return;
    const size_t row = (size_t)TP + gw; float ss = 0.f;
#pragma unroll
    for (int jh = 0; jh < 2; ++jh) { f32x4 v[2][NSL]; u32x2 xb[2];
#pragma unroll
        for (int jj = 0; jj < 2; ++jj) { const int c = (2 * jh + jj) * 256 + lane * 4; xb[jj] = *(const u32x2*)(XB + row * D + c);
#pragma unroll
            for (int k = 0; k < NSL; ++k) v[jj][k] = *(const f32x4*)(SL + ((size_t)k * TS + gw) * D + c); }
#pragma unroll
        for (int jj = 0; jj < 2; ++jj) { const int c = (2 * jh + jj) * 256 + lane * 4; f32x4 s = v[jj][0];
#pragma unroll
            for (int k = 1; k < NSL; ++k) s += v[jj][k];
            const f32x4 x = {__uint_as_float(xb[jj].x << 16), __uint_as_float(xb[jj].x & 0xffff0000u), __uint_as_float(xb[jj].y << 16), __uint_as_float(xb[jj].y & 0xffff0000u)};
            const f32x4 o = x + scale * s;
            { u32x2 w; w.x = pk_bf16(o[0], o[1]); w.y = pk_bf16(o[2], o[3]); *(u32x2*)(XO + row * D + c) = w;
                const float r0 = __uint_as_float(w.x << 16), r1 = __uint_as_float(w.x & 0xffff0000u), r2 = __uint_as_float(w.y << 16), r3 = __uint_as_float(w.y & 0xffff0000u);
                ss += r0 * r0 + r1 * r1 + r2 * r2 + r3 * r3; } } }
    ss = wave_sum(ss);
    if (lane < 16) RS[(size_t)lane * T + row] = lane == 0 ? ss : 0.f;
}

__device__ __forceinline__ float ldp(const bf16_t* P, size_t row, int col) { return bf2f(P[row * PSTR + col]); }

__device__ void naive_delta_chain(const CArgs& a, int l, int s, int h, int lane) {
    const bf16_t* P = (const bf16_t*)(WSP(a) + WS_P); bf16_t* MIX = (bf16_t*)(WSP(a) + WS_H);
    const int L = seq_len(s); const size_t row0 = seq_row0(s);
    float S[64]; float hq[3], hk[3], hv[3];
    if (s < 2) {
#pragma unroll
        for (int i = 0; i < 64; ++i) S[i] = 0.f;
#pragma unroll
        for (int j = 0; j < 3; ++j) { hq[j] = 0.f; hk[j] = 0.f; hv[j] = 0.f; }
    } else {
        const int sb = s - 2; const float* s0 = INP(a, 2) + (((size_t)l * 16 + sb) * 6 + h) * 4096;
#pragma unroll
        for (int i = 0; i < 64; ++i) S[i] = s0[i * 64 + lane];
        const float* cb = INP(a, 3) + ((size_t)l * 16 + sb) * 3 * 1152;
#pragma unroll
        for (int j = 0; j < 3; ++j) { hq[j] = cb[j * 1152 + PQ + h * 64 + lane]; hk[j] = cb[j * 1152 + PK + h * 64 + lane]; hv[j] = cb[j * 1152 + PV + h * 64 + lane]; }
    }
    const float* cw = INP(a, 14) + (size_t)l * 4 * 1152;
    float wq[4], wk[4], wv[4];
#pragma unroll
    for (int k = 0; k < 4; ++k) { wq[k] = cw[k * 1152 + PQ + h * 64 + lane]; wk[k] = cw[k * 1152 + PK + h * 64 + lane]; wv[k] = cw[k * 1152 + PV + h * 64 + lane]; }
    const float Aexp = __expf(INP(a, 15)[l * 6 + h]), dtb = INP(a, 16)[l * 6 + h], nw = INP(a, 17)[l * 64 + lane];
    float nq = ldp(P, row0, PQ + h * 64 + lane), nk = ldp(P, row0, PK + h * 64 + lane), nv = ldp(P, row0, PV + h * 64 + lane);
    float nb = ldp(P, row0, PBA + h), na = ldp(P, row0, PAA + h), nz = ldp(P, row0, PZA + h * 64 + lane);
    for (int t = 0; t < L; ++t) {
        const size_t row = row0 + t;
        const float xq = nq, xk = nk, xv = nv, xb = nb, xa = na, xz = nz;
        { const size_t rn = row0 + (t + 1 < L ? t + 1 : t);
          nq = ldp(P, rn, PQ + h * 64 + lane); nk = ldp(P, rn, PK + h * 64 + lane); nv = ldp(P, rn, PV + h * 64 + lane);
          nb = ldp(P, rn, PBA + h); na = ldp(P, rn, PAA + h); nz = ldp(P, rn, PZA + h * 64 + lane); }
        float q = siluf(wq[0] * hq[0] + wq[1] * hq[1] + wq[2] * hq[2] + wq[3] * xq);
        float k = siluf(wk[0] * hk[0] + wk[1] * hk[1] + wk[2] * hk[2] + wk[3] * xk);
        const float v = siluf(wv[0] * hv[0] + wv[1] * hv[1] + wv[2] * hv[2] + wv[3] * xv);
        hq[0] = hq[1]; hq[1] = hq[2]; hq[2] = xq; hk[0] = hk[1]; hk[1] = hk[2]; hk[2] = xk; hv[0] = hv[1]; hv[1] = hv[2]; hv[2] = xv;
        q *= rsqrtf(wave_sum(q * q) + 1e-6f) * 0.125f;
        k *= rsqrtf(wave_sum(k * k) + 1e-6f);
        const float beta = sigmoid_f(xb), alpha = __expf(-Aexp * softplus_f(xa + dtb));
        float kS = 0.f;
#pragma unroll
        for (int i = 0; i < 64; ++i) kS += rdlane(k, i) * S[i];
        const float dl = beta * (v - alpha * kS);
        float o = 0.f;
#pragma unroll
        for (int i = 0; i < 64; ++i) { S[i] = alpha * S[i] + rdlane(k, i) * dl; o += rdlane(q, i) * S[i]; }
        const float ms = wave_sum(o * o) * (1.0f / 64.f);
        MIX[row * D + h * 64 + lane] = f2bf(o * rsqrtf(ms + 1e-6f) * nw * siluf(xz));
    }
    float* so = state_out(OUTP(a), O_PDS, O_SDS, l, s, 6 * 4096) + (size_t)h * 4096;
#pragma unroll
    for (int i = 0; i < 64; ++i) so[i * 64 + lane] = S[i];
    float* co = state_out(OUTP(a), O_PDC, O_SDC, l, s, 3 * 1152);
#pragma unroll
    for (int j = 0; j < 3; ++j) { co[j * 1152 + PQ + h * 64 + lane] = hq[j]; co[j * 1152 + PK + h * 64 + lane] = hk[j]; co[j * 1152 + PV + h * 64 + lane] = hv[j]; }
}

__device__ void naive_ssd_block(const CArgs& a, int l, int s, int g, LAS float* red) {
    const bf16_t* P = (const bf16_t*)(WSP(a) + WS_P); bf16_t* MIX = (bf16_t*)(WSP(a) + WS_H);
    const int tid = tidx(), hh = tid >> 6, p = tid & 63, head = g * 3 + (hh < 3 ? hh : 0); const bool act = tid < 192;
    const int L = seq_len(s); const size_t row0 = seq_row0(s);
    const int cx = head * 64 + p, cB = 384 + g * 64 + p, cC = 512 + g * 64 + p;
    float hst[64]; float hx[3], hB[3], hC[3];
    if (s < 2 || !act) {
#pragma unroll
        for (int i = 0; i < 64; ++i) hst[i] = 0.f;
#pragma unroll
        for (int j = 0; j < 3; ++j) { hx[j] = 0.f; hB[j] = 0.f; hC[j] = 0.f; }
    } else {
        const int sb = s - 2; const float* s0 = INP(a, 4) + (((size_t)l * 16 + sb) * 6 + head) * 4096;
#pragma unroll
        for (int i = 0; i < 64; ++i) hst[i] = s0[i * 64 + p];
        const float* cb = INP(a, 5) + ((size_t)l * 16 + sb) * 3 * 640;
#pragma unroll
        for (int j = 0; j < 3; ++j) { hx[j] = cb[j * 640 + cx]; hB[j] = cb[j * 640 + cB]; hC[j] = cb[j * 640 + cC]; }
    }
    const float* cw = INP(a, 18) + (size_t)l * 4 * 640; const float* cbias = INP(a, 19) + (size_t)l * 640;
    float wx[4], wB[4], wC[4];
#pragma unroll
    for (int k = 0; k < 4; ++k) { wx[k] = cw[k * 640 + cx]; wB[k] = cw[k * 640 + cB]; wC[k] = cw[k * 640 + cC]; }
    const float bx = cbias[cx], bB = cbias[cB], bC = cbias[cC];
    const float Aneg = -__expf(INP(a, 20)[l * 6 + head]), dtb = INP(a, 21)[l * 6 + head], dsk = INP(a, 22)[l * 6 + head], nw = INP(a, 23)[l * 384 + g * 192 + (hh < 3 ? hh : 0) * 64 + p];
    for (int t = 0; t < L; ++t) {
        const size_t row = row0 + t;
        float y = 0.f, xs = 0.f;
        if (act) {
            const float rx = ldp(P, row, PXBC + cx), rB = ldp(P, row, PXBC + cB), rC = ldp(P, row, PXBC + cC);
            xs = siluf(wx[0] * hx[0] + wx[1] * hx[1] + wx[2] * hx[2] + wx[3] * rx + bx);
            const float Bn = siluf(wB[0] * hB[0] + wB[1] * hB[1] + wB[2] * hB[2] + wB[3] * rB + bB);
            const float Cn = siluf(wC[0] * hC[0] + wC[1] * hC[1] + wC[2] * hC[2] + wC[3] * rC + bC);
            hx[0] = hx[1]; hx[1] = hx[2]; hx[2] = rx; hB[0] = hB[1]; hB[1] = hB[2]; hB[2] = rB; hC[0] = hC[1]; hC[1] = hC[2]; hC[2] = rC;
            const float dt = softplus_f(ldp(P, row, PDT + head) + dtb), dA = __expf(dt * Aneg), dx = dt * xs;
#pragma unroll
            for (int i = 0; i < 64; ++i) { hst[i] = dA * hst[i] + rdlane(Bn, i) * dx; y += rdlane(Cn, i) * hst[i]; }
            y += dsk * xs;
            y *= siluf(ldp(P, row, PZB + head * 64 + p));
            const float sq = wave_sum(y * y);
            if (p == 0) red[hh] = sq;
        }
        __syncthreads();
        if (act) {
            const float ms = (red[0] + red[1] + red[2]) * (1.0f / 192.f);
            MIX[row * D + 384 + g * 192 + hh * 64 + p] = f2bf(y * rsqrtf(ms + 1e-6f) * nw);
        }
        __syncthreads();
    }
    if (act) {
        float* so = state_out(OUTP(a), O_PSH, O_SSH, l, s, 6 * 4096) + (size_t)head * 4096;
#pragma unroll
        for (int i = 0; i < 64; ++i) so[i * 64 + p] = hst[i];
        float* co = state_out(OUTP(a), O_PSC, O_SSC, l, s, 3 * 640);
#pragma unroll
        for (int j = 0; j < 3; ++j) { co[j * 640 + cx] = hx[j]; if (hh == 0) { co[j * 640 + cB] = hB[j]; co[j * 640 + cC] = hC[j]; } }
    }
}

__device__ void naive_lru_block(const CArgs& a, int l, int s, LAS float* xsh) {
    const bf16_t* P = (const bf16_t*)(WSP(a) + WS_P); bf16_t* MIX = (bf16_t*)(WSP(a) + WS_H);
    const int tid = tidx(), ch = tid & 255; const bool act = tid < 256;
    const int L = seq_len(s); const size_t row0 = seq_row0(s);
    float hx[3] = {0.f, 0.f, 0.f}, h = 0.f;
    if (s >= 2) { const int sb = s - 2; h = INP(a, 6)[((size_t)l * 16 + sb) * 256 + ch]; const float* cb = INP(a, 7) + ((size_t)l * 16 + sb) * 3 * 256;
#pragma unroll
        for (int j = 0; j < 3; ++j) hx[j] = cb[j * 256 + ch]; }
    const float* cw = INP(a, 24) + (size_t)l * 4 * 256; float w[4];
#pragma unroll
    for (int k = 0; k < 4; ++k) w[k] = cw[k * 256 + ch];
    const float cb0 = INP(a, 25)[l * 256 + ch], br = INP(a, 27)[l * 256 + ch], bi = INP(a, 29)[l * 256 + ch];
    const float spl = softplus_f(-INP(a, 30)[l * 256 + ch]);
    const int blk = ch >> 5, d = ch & 31;
    const float* wr = INP(a, 26) + ((size_t)l * 8 + blk) * 1024 + d; const float* wi = INP(a, 28) + ((size_t)l * 8 + blk) * 1024 + d;
    for (int t = 0; t < L; ++t) {
        const size_t row = row0 + t; float xc = 0.f;
        if (act) { const float rx = ldp(P, row, PXC + ch); xc = w[0] * hx[0] + w[1] * hx[1] + w[2] * hx[2] + w[3] * rx + cb0; hx[0] = hx[1]; hx[1] = hx[2]; hx[2] = rx; xsh[ch] = xc; }
        __syncthreads();
        if (act) {
            float r = br, ig = bi;
#pragma unroll 8
            for (int c = 0; c < 32; ++c) { const float xv = xsh[blk * 32 + c]; r += xv * wr[c * 32]; ig += xv * wi[c * 32]; }
            const float log_a = -8.0f * sigmoid_f(r) * spl, av = __expf(log_a), bv = sqrtf(-expm1f(2.0f * log_a)) * (sigmoid_f(ig) * xc);
            h = av * h + bv;
            MIX[row * D + 768 + ch] = f2bf(h * gelu_tanh(ldp(P, row, PGC + ch)));
        }
        __syncthreads();
    }
    if (act) {
        state_out(OUTP(a), O_PLH, O_SLH, l, s, 256)[ch] = h;
        float* co = state_out(OUTP(a), O_PLC, O_SLC, l, s, 3 * 256);
#pragma unroll
        for (int j = 0; j < 3; ++j) co[j * 256 + ch] = hx[j];
    }
}

__device__ void naive_mixer_phase(const CArgs& a, int l, LAS unsigned char* lds) {
    const int b = blockIdx.x, tid = tidx();
    if (b < 108) { if (tid < 64) naive_delta_chain(a, l, b / 6, b % 6, tid); }
    else if (b < 144) { const int u = b - 108; naive_ssd_block(a, l, u / 2, u % 2, (LAS float*)lds); }
    else if (b < 162) naive_lru_block(a, l, b - 144, (LAS float*)lds);
}

typedef short bf16x8 __attribute__((ext_vector_type(8)));
constexpr int NCH = 528, NDU = NCH * 6, LDT = 72;
constexpr size_t WS_DW = WS_H, WS_DQK = WS_H + (size_t)NDU * 8192;
constexpr size_t WS_DQD = WS_M, WS_DKD = WS_DQD + (size_t)NDU * 8192, WS_DU = WS_DKD + (size_t)NDU * 8192, WS_SH = WS_DU + (size_t)NDU * 16384,
                 WS_GTD = WS_SH + (size_t)NDU * 16384, WS_GTS = WS_GTD + 16384, WS_LA = WS_GTS + 16384, WS_LB = WS_LA + (size_t)NCH * 1024, WS_LA0 = WS_LB + (size_t)NCH * 1024, WS_LB0 = WS_LA0 + (size_t)NCH * 1024, WS_GP = WS_LB0 + (size_t)NCH * 1024, WS_HH = WS_GP + (size_t)192 * 8192, WS_SST = WS_HH + (size_t)192 * 16384, WS_MEND = WS_SST + (size_t)192 * 16384;
static_assert(WS_MEND <= WS_END && WS_RS >= WS_DU && WS_RS + (size_t)16 * T * 4 <= WS_SH, "mixer workspace");
static_assert(WS_DQK + (size_t)NDU * 8192 <= WS_P, "DW/DQK must fit the H region");

__device__ __forceinline__ int kinv(int k) { return (k & 32) | ((k & 12) << 1) | ((k & 16) >> 2) | (k & 3); }
__device__ __forceinline__ unsigned cvtpk(float lo, float hi) { unsigned r; asm volatile("v_cvt_pk_bf16_f32 %0, %1, %2" : "=v"(r) : "v"(lo), "v"(hi)); return r; }
__device__ __forceinline__ bf16x8 pack8(const f32x4& x, const f32x4& y) { u32x4 w; w.x = cvtpk(x[0], x[1]); w.y = cvtpk(x[2], x[3]); w.z = cvtpk(y[0], y[1]); w.w = cvtpk(y[2], y[3]); return __builtin_bit_cast(bf16x8, w); }
__device__ __forceinline__ f32x4 mfma16(const bf16x8& a, const bf16x8& b, const f32x4& c) { return __builtin_amdgcn_mfma_f32_16x16x32_bf16(a, b, c, 0, 0, 0); }
__device__ __forceinline__ bf16x8 ldfrag(const LAS bf16_t* tile, int row, int s, int fq) { return *(const LAS bf16x8*)(tile + row * LDT + 32 * s + 8 * fq); }
__device__ __forceinline__ void chunk_seq(int c, int& s, bool& first) { if (c < 256) { s = 0; first = c == 0; } else if (c < 512) { s = 1; first = c == 256; } else { s = 2 + (c - 512); first = true; } }
__device__ __forceinline__ float wave_scan_incl(float v, int lane) {
#pragma unroll
    for (int o = 1; o < 64; o <<= 1) { const float t = __shfl_up(v, o); if (lane >= o) v += t; }
    return v; }
template <int NSEG> struct StageRegs { static constexpr int PPR = NSEG * 8, TOTAL = 67 * PPR, NP = (TOTAL + 511) / 512; u32x4 w[NP]; };
template <int NSEG> __device__ __forceinline__ void stage_load(StageRegs<NSEG>& R, const bf16_t* P, int c, int c0, int c1, int c2, int c3, const float* st, int CS, int stbase, bool first) {
    constexpr int PPR = StageRegs<NSEG>::PPR, TOTAL = StageRegs<NSEG>::TOTAL, NP = StageRegs<NSEG>::NP;
    const int tid = tidx();
#pragma unroll
    for (int k = 0; k < NP; ++k) { const int idx = tid + 512 * k < TOTAL ? tid + 512 * k : TOTAL - 1;
        const int r = idx / PPR, pc = idx - r * PPR, seg = pc >> 3, col = (seg == 0 ? c0 : (seg == 1 ? c1 : (seg == 2 ? c2 : c3))) + (pc & 7) * 8, rr = (r >= 3 || !first) ? r : 3;
        R.w[k] = *(const u32x4*)(P + ((size_t)c * 64 + rr - 3) * PSTR + col); }
    if (first) {
#pragma unroll
        for (int k = 0; k < NP; ++k) { const int idx = tid + 512 * k < TOTAL ? tid + 512 * k : TOTAL - 1;
            const int r = idx / PPR, pc = idx - r * PPR, seg = pc >> 3, col = (seg == 0 ? c0 : (seg == 1 ? c1 : (seg == 2 ? c2 : c3))) + (pc & 7) * 8;
            if (r < 3) {
                if (st) { const float* sp = st + r * CS + (col - stbase); R.w[k].x = pk_bf16(sp[0], sp[1]); R.w[k].y = pk_bf16(sp[2], sp[3]); R.w[k].z = pk_bf16(sp[4], sp[5]); R.w[k].w = pk_bf16(sp[6], sp[7]); }
                else { R.w[k].x = 0u; R.w[k].y = 0u; R.w[k].z = 0u; R.w[k].w = 0u; } } }
    }
}
template <int NSEG> __device__ __forceinline__ void stage_store(LAS bf16_t* dst, const StageRegs<NSEG>& R) {
    constexpr int PPR = StageRegs<NSEG>::PPR, TOTAL = StageRegs<NSEG>::TOTAL, NP = StageRegs<NSEG>::NP;
    const int tid = tidx();
#pragma unroll
    for (int k = 0; k < NP; ++k) { const int idx = tid + 512 * k;
        if (idx < TOTAL) { const int r = idx / PPR, pc = idx - r * PPR; *(LAS u32x4*)(dst + r * (NSEG * 64) + pc * 8) = R.w[k]; } }
}
template <int NSEG> __device__ __forceinline__ void stage_raw_n(LAS bf16_t* dst, const bf16_t* P, int c, int c0, int c1, int c2, int c3, const float* st, int CS, int stbase, bool first) {
    StageRegs<NSEG> R; stage_load<NSEG>(R, P, c, c0, c1, c2, c3, st, CS, stbase, first); stage_store<NSEG>(dst, R);
}
__device__ __forceinline__ f32x4 mfma4(float a, float b, const f32x4& c) { return __builtin_amdgcn_mfma_f32_16x16x4f32(a, b, c, 0, 0, 0); }

__device__ __forceinline__ void m1_delta_prefetch(const CArgs& a, int l, int c, int h, StageRegs<3>& R, float& xb_, float& xa_) {
    const bf16_t* P = (const bf16_t*)(WSP(a) + WS_P); int s; bool first; chunk_seq(c, s, first);
    if ((tidx() >> 6) == 0) { const size_t row = (size_t)c * 64 + (tidx() & 63); xb_ = ldp(P, row, PBA + h); xa_ = ldp(P, row, PAA + h); }
    stage_load<3>(R, P, c, PQ + h * 64, PK + h * 64, PV + h * 64, 0, (first && s >= 2) ? INP(a, 3) + ((size_t)l * 16 + (s - 2)) * 3 * 1152 : nullptr, 1152, 0, first);
}
__device__ __forceinline__ void m1_delta_unit(const CArgs& a, int l, int c, int h, LAS unsigned char* lds, StageRegs<3>& R, float& xb_, float& xa_, int cn, int hn, bool has_next) {
    const int tid = tidx(), lane = tid & 63, wid = __builtin_amdgcn_readfirstlane(tid >> 6), fr = lane & 15, fq = lane >> 4;
    const bf16_t* P = (const bf16_t*)(WSP(a) + WS_P);
    LAS bf16_t* RAW = (LAS bf16_t*)lds;
    LAS bf16_t* OUTT = (LAS bf16_t*)lds;
    LAS float* QF = (LAS float*)(lds + 36864);
    LAS float* AT = QF;
    LAS float* KF = (LAS float*)(lds + 36864 + 17408);
    LAS float* VF = KF + 4096;
    LAS bf16_t* KN = (LAS bf16_t*)(VF + 4096);
    LAS bf16_t* QN = KN + 64 * LDT;
    LAS float* SM = (LAS float*)(QN + 64 * LDT);
    int s; bool first; chunk_seq(c, s, first);
    const int u = c * 6 + h;
    stage_store<3>(RAW, R);
    if (wid == 0) {
        const float beta = sigmoid_f(xb_);
        const float la = -__expf(INP(a, 15)[l * 6 + h]) * softplus_f(xa_ + INP(a, 16)[l * 6 + h]);
        SM[lane] = wave_scan_incl(la, lane); SM[64 + lane] = beta;
    }
    float w0 = 0.f, w1 = 0.f, w2 = 0.f, w3 = 0.f;
    if (tid < 384) { const int ch = tid % 192, seg = ch >> 6, cc = ch & 63; const float* cw = INP(a, 14) + (size_t)l * 4 * 1152 + seg * 384 + h * 64 + cc; w0 = cw[0]; w1 = cw[1152]; w2 = cw[2304]; w3 = cw[3456]; }
    __syncthreads();
    if (has_next) m1_delta_prefetch(a, l, cn, hn, R, xb_, xa_);
    if (tid < 384) {
        const int ch = tid % 192, par = tid / 192, seg = ch >> 6, cc = ch & 63;
        LAS float* dst = seg == 0 ? QF : (seg == 1 ? KF : VF);
        float x0 = bf2f(RAW[(par * 32) * 192 + ch]), x1 = bf2f(RAW[(par * 32 + 1) * 192 + ch]), x2 = bf2f(RAW[(par * 32 + 2) * 192 + ch]);
#pragma unroll 8
        for (int j = 0; j < 32; ++j) { const int i = par * 32 + j; const float x3 = bf2f(RAW[(i + 3) * 192 + ch]);
            dst[i * 64 + cc] = siluf(w0 * x0 + w1 * x1 + w2 * x2 + w3 * x3); x0 = x1; x1 = x2; x2 = x3; }
    }
    __syncthreads();
    {   const int i = tid >> 3, part = tid & 7; float q[8], k[8], sq = 0.f, sk = 0.f;
        {   const f32x4 qa = *(const LAS f32x4*)(QF + i * 64 + part * 8), qb = *(const LAS f32x4*)(QF + i * 64 + part * 8 + 4), ka = *(const LAS f32x4*)(KF + i * 64 + part * 8), kb = *(const LAS f32x4*)(KF + i * 64 + part * 8 + 4);
#pragma unroll
            for (int e = 0; e < 4; ++e) { q[e] = qa[e]; q[4 + e] = qb[e]; k[e] = ka[e]; k[4 + e] = kb[e]; } }
#pragma unroll
        for (int e = 0; e < 8; ++e) { sq += q[e] * q[e]; sk += k[e] * k[e]; }
        sq += __shfl_xor(sq, 1); sq += __shfl_xor(sq, 2); sq += __shfl_xor(sq, 4);
        sk += __shfl_xor(sk, 1); sk += __shfl_xor(sk, 2); sk += __shfl_xor(sk, 4);
        const float rq = rsqrtf(sq + 1e-6f) * 0.125f, rk = rsqrtf(sk + 1e-6f);
#pragma unroll
        for (int e = 0; e < 8; ++e) { q[e] *= rq; k[e] *= rk; }
        *(LAS f32x4*)(KF + i * 64 + part * 8) = (f32x4){k[0], k[1], k[2], k[3]}; *(LAS f32x4*)(KF + i * 64 + part * 8 + 4) = (f32x4){k[4], k[5], k[6], k[7]};
        u32x4 wq, wk; wq.x = cvtpk(q[0], q[1]); wq.y = cvtpk(q[2], q[3]); wq.z = cvtpk(q[4], q[5]); wq.w = cvtpk(q[6], q[7]);
        wk.x = cvtpk(k[0], k[1]); wk.y = cvtpk(k[2], k[3]); wk.z = cvtpk(k[4], k[5]); wk.w = cvtpk(k[6], k[7]);
        *(LAS u32x4*)(QN + i * LDT + part * 8) = wq; *(LAS u32x4*)(KN + i * LDT + part * 8) = wk; }
    __syncthreads();
    {
        const int mb = wid & 3, which = wid >> 2; const LAS bf16_t* Asrc = which ? QN : KN;
        const bf16x8 a0 = ldfrag(Asrc, 16 * mb + fr, 0, fq), a1 = ldfrag(Asrc, 16 * mb + fr, 1, fq);
        float gi[4], bi[4];
#pragma unroll
        for (int r = 0; r < 4; ++r) { gi[r] = SM[16 * mb + 4 * fq + r]; bi[r] = SM[64 + 16 * mb + 4 * fq + r]; }
#pragma unroll
        for (int nb = 0; nb < 4; ++nb) {
            const bf16x8 b0 = ldfrag(KN, 16 * nb + fr, 0, fq), b1 = ldfrag(KN, 16 * nb + fr, 1, fq);
            f32x4 acc = {0.f, 0.f, 0.f, 0.f}; acc = mfma16(a0, b0, acc); acc = mfma16(a1, b1, acc);
            const int j = 16 * nb + fr; const float gj = SM[j];
            if (which == 0) { f32x4 o;
#pragma unroll
                for (int r = 0; r < 4; ++r) { const int i = 16 * mb + 4 * fq + r; o[r] = i > j ? bi[r] * acc[r] * __expf(gi[r] - gj) : 0.f; }
                *(LAS f32x4*)(AT + j * 68 + 16 * mb + 4 * fq) = o;
            } else {
#pragma unroll
                for (int r = 0; r < 4; ++r) { const int i = 16 * mb + 4 * fq + r; OUTT[1 * 64 * LDT + i * LDT + kinv(j)] = f2bf(i >= j ? acc[r] * __expf(gi[r] - gj) : 0.f); }
            }
        }
    }
    __syncthreads();
    LAS float* TB = SM + 128;
    if (wid < 4 && lane < 16) {
        float x[16];
#pragma unroll
        for (int i = 0; i < 16; ++i) x[i] = i == lane ? 1.f : 0.f;
#pragma unroll
        for (int j = 0; j < 15; ++j) { const float xj = x[j];
#pragma unroll
            for (int i4 = ((j + 1) & ~3); i4 < 16; i4 += 4) { const f32x4 av = *(const LAS f32x4*)(AT + (16 * wid + j) * 68 + 16 * wid + i4);
#pragma unroll
                for (int e = 0; e < 4; ++e) if (i4 + e > j) x[i4 + e] -= av[e] * xj; } }
#pragma unroll
        for (int i = 0; i < 16; ++i) TB[wid * 272 + i * 17 + lane] = x[i];
    }
    {   const float glast = SM[63];
        for (int idx = tid; idx < 1024; idx += 512) {
            const int d4 = (idx & 15) * 4, i = idx >> 4; const float eg = __expf(SM[i]);
            const u32x2 qv = *(const LAS u32x2*)(QN + i * LDT + d4);
            u32x2 w; w.x = cvtpk(__uint_as_float(qv.x << 16) * eg, __uint_as_float(qv.x & 0xffff0000u) * eg); w.y = cvtpk(__uint_as_float(qv.y << 16) * eg, __uint_as_float(qv.y & 0xffff0000u) * eg);
            *(LAS u32x2*)(OUTT + 2 * 64 * LDT + i * LDT + kinv(d4)) = w; }
        for (int idx = tid; idx < 1024; idx += 512) {
            const int m = idx & 63, j4 = (idx >> 6) * 4; float v[4];
#pragma unroll
            for (int e = 0; e < 4; ++e) v[e] = KF[(j4 + e) * 64 + m] * __expf(glast - SM[j4 + e]);
            u32x2 w; w.x = cvtpk(v[0], v[1]); w.y = cvtpk(v[2], v[3]);
            *(LAS u32x2*)(OUTT + 3 * 64 * LDT + m * LDT + kinv(j4)) = w; } }
    __syncthreads();
    {
        const int ct = wid & 3, isw = wid >> 2; f32x4 X[4];
#pragma unroll
        for (int b = 0; b < 4; ++b) { f32x4 acc;
#pragma unroll
            for (int r = 0; r < 4; ++r) { const int i = 16 * b + 4 * fq + r; acc[r] = isw ? SM[64 + i] * __expf(SM[i]) * KF[i * 64 + 16 * ct + fr] : SM[64 + i] * VF[i * 64 + 16 * ct + fr]; }
#pragma unroll
            for (int bp = 0; bp < 4; ++bp) if (bp < b) {
#pragma unroll
                for (int r = 0; r < 4; ++r) acc = mfma4(-AT[(16 * bp + 4 * fq + r) * 68 + 16 * b + fr], X[bp][r], acc); }
            f32x4 xb = {0.f, 0.f, 0.f, 0.f};
#pragma unroll
            for (int r = 0; r < 4; ++r) xb = mfma4(TB[b * 272 + fr * 17 + 4 * fq + r], acc[r], xb);
            X[b] = xb; }
        if (isw == 0) { float* U = (float*)(WSP(a) + WS_DU) + (size_t)u * 4096;
#pragma unroll
            for (int b = 0; b < 4; ++b)
#pragma unroll
                for (int r = 0; r < 4; ++r) U[(16 * b + 4 * fq + r) * 64 + 16 * ct + fr] = X[b][r];
        } else { const int kp = kinv(16 * ct + fr);
#pragma unroll
            for (int b = 0; b < 4; ++b)
#pragma unroll
                for (int r = 0; r < 4; ++r) OUTT[(16 * b + 4 * fq + r) * LDT + kp] = f2bf(X[b][r]); }
    }
    __syncthreads();
    {   const int row = tid >> 3, c8 = tid & 7;
        bf16_t* g0 = (bf16_t*)(WSP(a) + WS_DW) + (size_t)u * 4096; bf16_t* g1 = (bf16_t*)(WSP(a) + WS_DQK) + (size_t)u * 4096;
        bf16_t* g2 = (bf16_t*)(WSP(a) + WS_DQD) + (size_t)u * 4096; bf16_t* g3 = (bf16_t*)(WSP(a) + WS_DKD) + (size_t)u * 4096;
        *(u32x4*)(g0 + tid * 8) = *(const LAS u32x4*)(OUTT + 0 * 64 * LDT + row * LDT + c8 * 8);
        *(u32x4*)(g1 + tid * 8) = *(const LAS u32x4*)(OUTT + 1 * 64 * LDT + row * LDT + c8 * 8);
        *(u32x4*)(g2 + tid * 8) = *(const LAS u32x4*)(OUTT + 2 * 64 * LDT + row * LDT + c8 * 8);
        *(u32x4*)(g3 + tid * 8) = *(const LAS u32x4*)(OUTT + 3 * 64 * LDT + row * LDT + c8 * 8);
        if (tid == 0) ((float*)(WSP(a) + WS_GTD))[u] = __expf(SM[63]); }
    __syncthreads();
}

__device__ __forceinline__ void m1_ssd_prefetch(const CArgs& a, int l, int c, int h, StageRegs<2>& R, float& xd_) {
    const bf16_t* P = (const bf16_t*)(WSP(a) + WS_P); int s; bool first; chunk_seq(c, s, first); const int g = h / 3;
    if ((tidx() >> 6) == 0) xd_ = ldp(P, (size_t)c * 64 + (tidx() & 63), PDT + h);
    stage_load<2>(R, P, c, PXBC + h * 64, PXBC + 384 + g * 64, 0, 0, (first && s >= 2) ? INP(a, 5) + ((size_t)l * 16 + (s - 2)) * 3 * 640 : nullptr, 640, PXBC, first);
}
__device__ __forceinline__ void m1_ssd_unit(const CArgs& a, int l, int c, int h, LAS unsigned char* lds, StageRegs<2>& R, float& xd_, int cn, int hn, bool has_next) {
    const int tid = tidx(), lane = tid & 63, wid = __builtin_amdgcn_readfirstlane(tid >> 6), fr = lane & 15, fq = lane >> 4, g = h / 3;
    const bf16_t* P = (const bf16_t*)(WSP(a) + WS_P);
    LAS bf16_t* RAW = (LAS bf16_t*)lds;
    LAS bf16_t* BDT = (LAS bf16_t*)(lds + 18432);
    LAS bf16_t* XT = BDT + 64 * LDT;
    LAS float* SM = (LAS float*)(XT + 64 * LDT);
    int s; bool first; chunk_seq(c, s, first);
    const int u = c * 6 + h;
    stage_store<2>(RAW, R);
    if (wid == 0) {
        const float dt = softplus_f(xd_ + INP(a, 21)[l * 6 + h]);
        SM[lane] = wave_scan_incl(-__expf(INP(a, 20)[l * 6 + h]) * dt, lane); SM[64 + lane] = dt;
    }
    const int ch = tid & 127, part = tid >> 7, wch = ch < 64 ? h * 64 + ch : 384 + g * 64 + (ch - 64);
    const float* cw = INP(a, 18) + (size_t)l * 4 * 640 + wch; const float w0 = cw[0], w1 = cw[640], w2 = cw[1280], w3 = cw[1920], bias = INP(a, 19)[l * 640 + wch];
    __syncthreads();
    if (has_next) m1_ssd_prefetch(a, l, cn, hn, R, xd_);
    {
        const float glast = SM[63];
        float x0 = bf2f(RAW[(part * 16) * 128 + ch]), x1 = bf2f(RAW[(part * 16 + 1) * 128 + ch]), x2 = bf2f(RAW[(part * 16 + 2) * 128 + ch]);
#pragma unroll 8
        for (int e = 0; e < 16; ++e) { const int j = part * 16 + e; const float x3 = bf2f(RAW[(j + 3) * 128 + ch]);
            const float y = siluf(w0 * x0 + w1 * x1 + w2 * x2 + w3 * x3 + bias); x0 = x1; x1 = x2; x2 = x3;
            if (ch < 64) XT[ch * LDT + j] = f2bf(y); else BDT[(ch - 64) * LDT + j] = f2bf(y * __expf(glast - SM[j]) * SM[64 + j]); } }
    __syncthreads();
    {   const int mb = wid & 3; float* SH = (float*)(WSP(a) + WS_SH) + (size_t)u * 4096;
        const bf16x8 a0 = ldfrag(BDT, 16 * mb + fr, 0, fq), a1 = ldfrag(BDT, 16 * mb + fr, 1, fq);
#pragma unroll
        for (int t = 0; t < 2; ++t) { const int nb = 2 * (wid >> 2) + t;
            const bf16x8 b0 = ldfrag(XT, 16 * nb + fr, 0, fq), b1 = ldfrag(XT, 16 * nb + fr, 1, fq);
            f32x4 acc = {0.f, 0.f, 0.f, 0.f}; acc = mfma16(a0, b0, acc); acc = mfma16(a1, b1, acc);
#pragma unroll
            for (int r = 0; r < 4; ++r) SH[(16 * mb + 4 * fq + r) * 64 + 16 * nb + fr] = acc[r]; }
        if (tid == 0) ((float*)(WSP(a) + WS_GTS))[u] = __expf(SM[63]); }
    __syncthreads();
}

struct LruW { float wrc[32], wic[32], br, bi, spl; };
__device__ __forceinline__ void lru_load_w(const CArgs& a, int l, int ch, LruW& W) {
    const int blk = ch >> 5, d = ch & 31;
    const float* wr = INP(a, 26) + ((size_t)l * 8 + blk) * 1024 + d; const float* wi = INP(a, 28) + ((size_t)l * 8 + blk) * 1024 + d;
#pragma unroll
    for (int cI = 0; cI < 32; ++cI) { W.wrc[cI] = wr[cI * 32]; W.wic[cI] = wi[cI * 32]; }
    W.br = INP(a, 27)[l * 256 + ch]; W.bi = INP(a, 29)[l * 256 + ch]; W.spl = softplus_f(-INP(a, 30)[l * 256 + ch]);
}
template <class F> __device__ __forceinline__ void lru_gates(const LruW& W, const LAS float* XC, int ch, int half, F&& f) {
    const int blk = ch >> 5;
    const float br = W.br, bi = W.bi, spl = W.spl;
#pragma unroll
    for (int e = 0; e < 32; ++e) { const int t = half * 32 + e; float r = br, ig = bi;
#pragma unroll
        for (int c4 = 0; c4 < 8; ++c4) { const f32x4 xv = *(const LAS f32x4*)(XC + t * 256 + blk * 32 + c4 * 4);
#pragma unroll
            for (int k = 0; k < 4; ++k) { r += xv[k] * W.wrc[c4 * 4 + k]; ig += xv[k] * W.wic[c4 * 4 + k]; } }
        const float xc = XC[t * 256 + ch], log_a = -8.0f * sigmoid_f(r) * spl;
        f(e, __expf(log_a), sqrtf(-expm1f(2.0f * log_a)) * (sigmoid_f(ig) * xc)); }
}
__device__ __forceinline__ void lru_stage_conv(const CArgs& a, int l, int c, LAS unsigned char* lds) {
    const int tid = tidx(); const bf16_t* P = (const bf16_t*)(WSP(a) + WS_P);
    LAS bf16_t* RAW = (LAS bf16_t*)lds; LAS float* XC = (LAS float*)(lds + 34816);
    int s; bool first; chunk_seq(c, s, first);
    stage_raw_n<4>(RAW, P, c, PXC, PXC + 64, PXC + 128, PXC + 192, (first && s >= 2) ? INP(a, 7) + ((size_t)l * 16 + (s - 2)) * 3 * 256 : nullptr, 256, PXC, first);
    __syncthreads();
    {   const int ch = tid & 255, par = tid >> 8; const float* cw = INP(a, 24) + (size_t)l * 4 * 256 + ch; const float w0 = cw[0], w1 = cw[256], w2 = cw[512], w3 = cw[768], bias = INP(a, 25)[l * 256 + ch];
        float x0 = bf2f(RAW[(par * 32) * 256 + ch]), x1 = bf2f(RAW[(par * 32 + 1) * 256 + ch]), x2 = bf2f(RAW[(par * 32 + 2) * 256 + ch]);
#pragma unroll 8
        for (int e = 0; e < 32; ++e) { const int i = par * 32 + e; const float x3 = bf2f(RAW[(i + 3) * 256 + ch]);
            XC[i * 256 + ch] = w0 * x0 + w1 * x1 + w2 * x2 + w3 * x3 + bias; x0 = x1; x1 = x2; x2 = x3; } }
    __syncthreads();
}
__device__ __forceinline__ void m1_lru_unit(const CArgs& a, int l, int c, LAS unsigned char* lds, const LruW& W) {
    const int tid = tidx(), ch = tid & 255, half = tid >> 8;
    LAS float* XC = (LAS float*)(lds + 34816); LAS float* SM = (LAS float*)(lds + 34816 + 65536);
    lru_stage_conv(a, l, c, lds);
    float A = 1.f, B = 0.f;
    lru_gates(W, XC, ch, half, [&](int, float at, float bt) { A *= at; B = at * B + bt; });
    if (half == 1) { SM[ch] = A; SM[256 + ch] = B; }
    __syncthreads();
    if (half == 0) { const float A1 = SM[ch], B1 = SM[256 + ch];
        ((float*)(WSP(a) + WS_LA0))[c * 256 + ch] = A; ((float*)(WSP(a) + WS_LB0))[c * 256 + ch] = B;
        ((float*)(WSP(a) + WS_LA))[c * 256 + ch] = A1 * A; ((float*)(WSP(a) + WS_LB))[c * 256 + ch] = A1 * B + B1; }
    __syncthreads();
}

#define UNIT_LOOP(lo, hi) for (int id = (lo) + (((int)blockIdx.x - (lo)) % (int)gridDim.x + (int)gridDim.x) % (int)gridDim.x; id < (hi); id += (int)gridDim.x)
#define LAUNDER_ARGS() const CArgs* ap_ = (const CArgs*)__builtin_amdgcn_kernarg_segment_ptr(); asm volatile("" : "+s"(ap_)); const CArgs& a = *ap_
__device__ __forceinline__ void m1_phase(const CArgs& a0, int l, LAS unsigned char* lds) {
    { LAUNDER_ARGS(); const int G = (int)gridDim.x; int id = (int)blockIdx.x;
      if (id < NDU) { StageRegs<3> R; float xb_ = 0.f, xa_ = 0.f; m1_delta_prefetch(a, l, id / 6, id % 6, R, xb_, xa_);
        for (; id < NDU; id += G) { const int idn = id + G; m1_delta_unit(a, l, id / 6, id % 6, lds, R, xb_, xa_, idn / 6, idn % 6, idn < NDU); } } }
    { LAUNDER_ARGS(); const int G = (int)gridDim.x; int id = NDU + (((int)blockIdx.x - NDU) % G + G) % G;
      if (id < 2 * NDU) { StageRegs<2> R; float xd_ = 0.f; m1_ssd_prefetch(a, l, (id - NDU) / 6, (id - NDU) % 6, R, xd_);
        for (; id < 2 * NDU; id += G) { const int idn = id + G; m1_ssd_unit(a, l, (id - NDU) / 6, (id - NDU) % 6, lds, R, xd_, (idn - NDU) / 6, (idn - NDU) % 6, idn < 2 * NDU); } } }
    { LAUNDER_ARGS(); LruW W; lru_load_w(a, l, tidx() & 255, W); UNIT_LOOP(2 * NDU, 2 * NDU + NCH) m1_lru_unit(a, l, id - 2 * NDU, lds, W); }
}

constexpr int M2_UOFF = 4 * 64 * LDT * 2, M2_GOFF = M2_UOFF + 64 * 68 * 4, M2_BUFB = M2_GOFF + 16, M2_OB = 2 * M2_BUFB, M2_OBB = 64 * 68 * 4;
static_assert(M2_OB + 2 * M2_OBB <= 144 * 1024, "M2 LDS");
__device__ __forceinline__ void m2_delta_chain(const CArgs& a, int h, int c0, int nch, const float* init, bool ident, bool do_o, bool use_u, float* outf, bf16_t* outg, LAS unsigned char* lds) {
    const int tid = tidx(), lane = tid & 63, wid = __builtin_amdgcn_readfirstlane(tid >> 6), fr = lane & 15, fq = lane >> 4, vs = wid & 3;
    float* DU = (float*)(WSP(a) + WS_DU);
    if (wid >= 6) {
        const int ts = tid - 384;
        __syncthreads();
        for (int ci = 0; ci <= nch; ++ci) {
            if (ci > 0 && do_o) { const LAS float* ob = (const LAS float*)(lds + M2_OB + ((ci - 1) & 1) * M2_OBB); float* dst = DU + ((size_t)(c0 + ci - 1) * 6 + h) * 4096;
#pragma unroll
                for (int k = 0; k < 8; ++k) { const int q = ts + 128 * k; *(f32x4*)(dst + q * 4) = *(const LAS f32x4*)(ob + (q >> 4) * 68 + (q & 15) * 4); } }
            if (ci < nch) __syncthreads();
        }
        __syncthreads();
        return;
    }
    if (wid >= 4) {
        const int tl = tid - 256;
        const bf16_t* G0 = (const bf16_t*)(WSP(a) + WS_DW); const bf16_t* G1 = (const bf16_t*)(WSP(a) + WS_DQK); const bf16_t* G2 = (const bf16_t*)(WSP(a) + WS_DQD); const bf16_t* G3 = (const bf16_t*)(WSP(a) + WS_DKD);
        const float* GT = (const float*)(WSP(a) + WS_GTD);
        u32x4 p[16]; f32x4 pu[8]; float pg;
#define M2_LOAD(uu) do { _Pragma("unroll") for (int k = 0; k < 4; ++k) { const int q = tl + 128 * k; p[k] = *(const u32x4*)(G0 + (uu) * 4096 + q * 8); p[4 + k] = *(const u32x4*)(G1 + (uu) * 4096 + q * 8); \
            p[8 + k] = *(const u32x4*)(G2 + (uu) * 4096 + q * 8); p[12 + k] = *(const u32x4*)(G3 + (uu) * 4096 + q * 8); } \
        _Pragma("unroll") for (int k = 0; k < 8; ++k) { const int q = tl + 128 * k; pu[k] = *(const f32x4*)(DU + (uu) * 4096 + q * 4); } pg = GT[uu]; } while (0)
#define M2_WRITE(dstb) do { LAS bf16_t* d_ = (LAS bf16_t*)(dstb); LAS float* du_ = (LAS float*)((dstb) + M2_UOFF); \
        _Pragma("unroll") for (int k = 0; k < 4; ++k) { const int q = tl + 128 * k, o_ = (q >> 3) * LDT + (q & 7) * 8; *(LAS u32x4*)(d_ + o_) = p[k]; *(LAS u32x4*)(d_ + 64 * LDT + o_) = p[4 + k]; \
            *(LAS u32x4*)(d_ + 2 * 64 * LDT + o_) = p[8 + k]; *(LAS u32x4*)(d_ + 3 * 64 * LDT + o_) = p[12 + k]; } \
        _Pragma("unroll") for (int k = 0; k < 8; ++k) { const int q = tl + 128 * k; *(LAS f32x4*)(du_ + (q >> 4) * 68 + (q & 15) * 4) = pu[k]; } \
        if (tl == 0) *(LAS float*)((dstb) + M2_GOFF) = pg; } while (0)
        {   const size_t u = (size_t)c0 * 6 + h, u1 = nch > 1 ? u + 6 : u;
            M2_LOAD(u); M2_WRITE(lds);
            M2_LOAD(u1); }
        __syncthreads();
        for (int ci = 0; ci < nch; ++ci) {
            const size_t u = (size_t)(c0 + ci) * 6 + h; const size_t un2 = ci + 2 < nch ? u + 12 : u;
            LAS unsigned char* nxtb = lds + ((ci + 1) & 1) * M2_BUFB;
            if (ci + 1 < nch) M2_WRITE(nxtb);
            M2_LOAD(un2);
            __syncthreads();
        }
#undef M2_LOAD
#undef M2_WRITE
        __syncthreads();
        return;
    }
    f32x4 S[4];
#pragma unroll
    for (int mb = 0; mb < 4; ++mb) {
        if (init) {
#pragma unroll
            for (int r = 0; r < 4; ++r) S[mb][r] = init[(16 * mb + 4 * fq + r) * 64 + 16 * vs + fr]; }
        else {
#pragma unroll
            for (int r = 0; r < 4; ++r) S[mb][r] = (ident && (16 * mb + 4 * fq + r == 16 * vs + fr)) ? 1.f : 0.f; } }
    __syncthreads();
    for (int ci = 0; ci < nch; ++ci) {
        LAS unsigned char* curb = lds + (ci & 1) * M2_BUFB;
        const LAS bf16_t* cur = (const LAS bf16_t*)curb; const LAS float* UL = (const LAS float*)(curb + M2_UOFF); LAS float* OB = (LAS float*)(lds + M2_OB + (ci & 1) * M2_OBB);
        const float gt = *(const LAS float*)(curb + M2_GOFF);
        const bf16x8 Sb0 = pack8(S[0], S[1]), Sb1 = pack8(S[2], S[3]);
        f32x4 Dl[4], O[4];
#pragma unroll
        for (int mb = 0; mb < 4; ++mb) { f32x4 t = {0.f, 0.f, 0.f, 0.f}, uc;
#pragma unroll
            for (int r = 0; r < 4; ++r) uc[r] = use_u ? UL[(16 * mb + 4 * fq + r) * 68 + 16 * vs + fr] : 0.f;
            t = mfma16(ldfrag(cur + 0 * 64 * LDT, 16 * mb + fr, 0, fq), Sb0, t); t = mfma16(ldfrag(cur + 0 * 64 * LDT, 16 * mb + fr, 1, fq), Sb1, t);
            Dl[mb] = uc - t;
            f32x4 o = {0.f, 0.f, 0.f, 0.f};
            if (do_o) { o = mfma16(ldfrag(cur + 2 * 64 * LDT, 16 * mb + fr, 0, fq), Sb0, o); o = mfma16(ldfrag(cur + 2 * 64 * LDT, 16 * mb + fr, 1, fq), Sb1, o); }
            O[mb] = o; }
        const bf16x8 Db0 = pack8(Dl[0], Dl[1]), Db1 = pack8(Dl[2], Dl[3]);
#pragma unroll
        for (int mb = 0; mb < 4; ++mb) {
            f32x4 sn = S[mb] * gt;
            sn = mfma16(ldfrag(cur + 3 * 64 * LDT, 16 * mb + fr, 0, fq), Db0, sn); sn = mfma16(ldfrag(cur + 3 * 64 * LDT, 16 * mb + fr, 1, fq), Db1, sn);
            S[mb] = sn;
            if (do_o) { O[mb] = mfma16(ldfrag(cur + 1 * 64 * LDT, 16 * mb + fr, 0, fq), Db0, O[mb]); O[mb] = mfma16(ldfrag(cur + 1 * 64 * LDT, 16 * mb + fr, 1, fq), Db1, O[mb]);
#pragma unroll
                for (int r = 0; r < 4; ++r) OB[(16 * mb + 4 * fq + r) * 68 + 16 * vs + fr] = O[mb][r]; } }
        __syncthreads();
    }
    if (outf) {
#pragma unroll
        for (int mb = 0; mb < 4; ++mb)
#pragma unroll
            for (int r = 0; r < 4; ++r) outf[(16 * mb + 4 * fq + r) * 64 + 16 * vs + fr] = S[mb][r]; }
    if (outg) { const int kp = kinv(16 * vs + fr);
#pragma unroll
        for (int mb = 0; mb < 4; ++mb)
#pragma unroll
            for (int r = 0; r < 4; ++r) outg[(16 * mb + 4 * fq + r) * 64 + kp] = f2bf(S[mb][r]); }
    __syncthreads();
}
__device__ __forceinline__ void m2_level2(const CArgs& a, int q) {
    const int tid = tidx(), lane = tid & 63, wid = __builtin_amdgcn_readfirstlane(tid >> 6), fr = lane & 15, fq = lane >> 4, vs = wid & 3;
    if (wid >= 4) return;
    const bf16_t* GP = (const bf16_t*)(WSP(a) + WS_GP) + (size_t)q * 16 * 4096; const float* HH = (const float*)(WSP(a) + WS_HH) + (size_t)q * 16 * 4096; float* SST = (float*)(WSP(a) + WS_SST) + (size_t)q * 16 * 4096;
    f32x4 S[4], hn[4]; bf16x8 an[4][2];
#pragma unroll
    for (int mb = 0; mb < 4; ++mb) { S[mb] = (f32x4){0.f, 0.f, 0.f, 0.f};
#pragma unroll
        for (int r = 0; r < 4; ++r) hn[mb][r] = HH[(16 * mb + 4 * fq + r) * 64 + 16 * vs + fr];
        an[mb][0] = *(const bf16x8*)(GP + (16 * mb + fr) * 64 + 8 * fq); an[mb][1] = *(const bf16x8*)(GP + (16 * mb + fr) * 64 + 32 + 8 * fq); }
    for (int g = 0; g < 16; ++g) {
#pragma unroll
        for (int mb = 0; mb < 4; ++mb)
#pragma unroll
            for (int r = 0; r < 4; ++r) SST[(size_t)g * 4096 + (16 * mb + 4 * fq + r) * 64 + 16 * vs + fr] = S[mb][r];
        if (g == 15) break;
        f32x4 hc[4]; bf16x8 ac[4][2];
#pragma unroll
        for (int mb = 0; mb < 4; ++mb) { hc[mb] = hn[mb]; ac[mb][0] = an[mb][0]; ac[mb][1] = an[mb][1]; }
        const int gn = g + 1 < 15 ? g + 1 : g;
#pragma unroll
        for (int mb = 0; mb < 4; ++mb) {
#pragma unroll
            for (int r = 0; r < 4; ++r) hn[mb][r] = HH[(size_t)gn * 4096 + (16 * mb + 4 * fq + r) * 64 + 16 * vs + fr];
            an[mb][0] = *(const bf16x8*)(GP + (size_t)gn * 4096 + (16 * mb + fr) * 64 + 8 * fq); an[mb][1] = *(const bf16x8*)(GP + (size_t)gn * 4096 + (16 * mb + fr) * 64 + 32 + 8 * fq); }
        const bf16x8 Sb0 = pack8(S[0], S[1]), Sb1 = pack8(S[2], S[3]);
#pragma unroll
        for (int mb = 0; mb < 4; ++mb) { f32x4 t = mfma16(ac[mb][0], Sb0, hc[mb]); S[mb] = mfma16(ac[mb][1], Sb1, t); }
    }
}
__device__ __forceinline__ void m2_scan_unit(const CArgs& a, int l, int su) {
    const int tid = tidx();
    if (su < 864) {
        int s, h, e; const int gi = (su < 96 ? su : su - 96) * 512 + tid;
        if (su < 96) { s = gi / (6 * 4096); h = (gi / 4096) % 6; e = gi & 4095; } else { s = 2 + gi / (6 * 4096); h = (gi / 4096) % 6; e = gi & 4095; }
        const int nch = seq_len(s) / 64, c0 = s < 2 ? s * 256 : 512 + (s - 2);
        float hs = s < 2 ? 0.f : INP(a, 4)[(((size_t)l * 16 + (s - 2)) * 6 + h) * 4096 + e];
        float* SH = (float*)(WSP(a) + WS_SH); const float* GT = (const float*)(WSP(a) + WS_GTS);
        int ci = 0;
        for (; ci + 8 <= nch; ci += 8) { float hl[8], gt[8];
#pragma unroll
            for (int k = 0; k < 8; ++k) { const size_t u = (size_t)(c0 + ci + k) * 6 + h; hl[k] = SH[u * 4096 + e]; gt[k] = GT[u]; }
#pragma unroll
            for (int k = 0; k < 8; ++k) { const size_t u = (size_t)(c0 + ci + k) * 6 + h; SH[u * 4096 + e] = hs; hs = gt[k] * hs + hl[k]; } }
        for (; ci < nch; ++ci) { const size_t u = (size_t)(c0 + ci) * 6 + h; const float hl = SH[u * 4096 + e], gt = GT[u]; SH[u * 4096 + e] = hs; hs = gt * hs + hl; }
        state_out(OUTP(a), O_PSH, O_SSH, l, s, 6 * 4096)[(size_t)h * 4096 + e] = hs;
    } else {
        const int gi = (su == 864 ? 0 : su - 865) * 512 + tid; const int s = su == 864 ? gi / 256 : 2 + gi / 256, ch = gi & 255;
        const int nch = seq_len(s) / 64, c0 = s < 2 ? s * 256 : 512 + (s - 2);
        float hs = s < 2 ? 0.f : INP(a, 6)[((size_t)l * 16 + (s - 2)) * 256 + ch];
        const float* LA = (const float*)(WSP(a) + WS_LA); float* LB = (float*)(WSP(a) + WS_LB);
        int ci = 0;
        for (; ci + 8 <= nch; ci += 8) { float A[8], B[8];
#pragma unroll
            for (int k = 0; k < 8; ++k) { A[k] = LA[(c0 + ci + k) * 256 + ch]; B[k] = LB[(c0 + ci + k) * 256 + ch]; }
#pragma unroll
            for (int k = 0; k < 8; ++k) { LB[(c0 + ci + k) * 256 + ch] = hs; hs = A[k] * hs + B[k]; } }
        for (; ci < nch; ++ci) { const float A = LA[(c0 + ci) * 256 + ch], B = LB[(c0 + ci) * 256 + ch]; LB[(c0 + ci) * 256 + ch] = hs; hs = A * hs + B; }
        state_out(OUTP(a), O_PLH, O_SLH, l, s, 256)[ch] = hs;
    }
}
__device__ __forceinline__ void m2_scan2_unit(float* V, size_t vcs, const float* Dc, size_t dcs, int des, int e0, float* fin, LAS unsigned char* lds) {
    const int tid = tidx(), g = tid >> 5, el = tid & 31; LAS float* CG = (LAS float*)lds; LAS float* CH = CG + 512;
    float v[16], d[16];
#pragma unroll
    for (int k = 0; k < 16; ++k) { v[k] = V[(size_t)(16 * g + k) * vcs + e0 + el]; d[k] = Dc[(size_t)(16 * g + k) * dcs + (size_t)des * (e0 + el)]; }
    float hs = 0.f, gp = 1.f;
#pragma unroll
    for (int k = 0; k < 16; ++k) { const float t = v[k]; v[k] = hs; hs = d[k] * hs + t; gp *= d[k]; }
    CG[tid] = gp; CH[tid] = hs;
    __syncthreads();
    float S = 0.f;
    for (int j = 0; j < g; ++j) S = CG[j * 32 + el] * S + CH[j * 32 + el];
    float pk = 1.f;
#pragma unroll
    for (int k = 0; k < 16; ++k) { V[(size_t)(16 * g + k) * vcs + e0 + el] = v[k] + pk * S; pk *= d[k]; }
    if (g == 15) fin[e0 + el] = hs + gp * S;
    __syncthreads();
}
__device__ __forceinline__ void m2a_phase(const CArgs& a0, int l, LAS unsigned char* lds) {
    { LAUNDER_ARGS(); UNIT_LOOP(0, 1552) {
        if (id < 1536) { const int q = id >> 7, s = q / 6, h = q % 6, e0 = (id & 127) * 32;
            m2_scan2_unit((float*)(WSP(a) + WS_SH) + ((size_t)s * 256 * 6 + h) * 4096, (size_t)6 * 4096, (const float*)(WSP(a) + WS_GTS) + (size_t)s * 256 * 6 + h, 6, 0, e0,
                          state_out(OUTP(a), O_PSH, O_SSH, l, s, 6 * 4096) + (size_t)h * 4096, lds); }
        else { const int j = id - 1536, s = j >> 3, e0 = (j & 7) * 32;
            m2_scan2_unit((float*)(WSP(a) + WS_LB) + (size_t)s * 256 * 256, 256, (const float*)(WSP(a) + WS_LA) + (size_t)s * 256 * 256, 256, 1, e0, state_out(OUTP(a), O_PLH, O_SLH, l, s, 256), lds); } } }
    { LAUNDER_ARGS(); UNIT_LOOP(1552, 1552 + 360) { const int j = id - 1552, q = j / 30, g = (j >> 1) % 15, half = j & 1; const size_t qg = (size_t)q * 16 + g;
        m2_delta_chain(a, q % 6, (q / 6) * 256 + 16 * g, 16, nullptr, half == 1, false, half == 0, half == 0 ? (float*)(WSP(a) + WS_HH) + qg * 4096 : nullptr, half == 1 ? (bf16_t*)(WSP(a) + WS_GP) + qg * 4096 : nullptr, lds); } }
    { LAUNDER_ARGS(); const int b = (int)blockIdx.x;
      const int k = b >= 120 ? b - 120 : (b < 16 ? 136 + b : -1);
      if (k >= 0) for (int j = k; j < 776; j += 152) m2_scan_unit(a, l, j < 768 ? 96 + j : 865 + (j - 768)); }
}
__device__ __forceinline__ void m2b_phase(const CArgs& a0, int l) { LAUNDER_ARGS(); if (blockIdx.x < 12) m2_level2(a, blockIdx.x); }
__device__ __forceinline__ void m2c_phase(const CArgs& a0, int l, LAS unsigned char* lds) {
    LAUNDER_ARGS();
    const int b = (int)blockIdx.x;
    if (b < 192) { const int id = b, q = id >> 4, g = id & 15, s = q / 6, h = q % 6;
        m2_delta_chain(a, h, s * 256 + 16 * g, 16, (const float*)(WSP(a) + WS_SST) + (size_t)id * 4096, false, true, true, g == 15 ? state_out(OUTP(a), O_PDS, O_SDS, l, s, 6 * 4096) + (size_t)h * 4096 : nullptr, nullptr, lds); }
    else for (int j = b - 192; j < 96; j += (int)gridDim.x - 192) { const int sb = j / 6, h = j % 6;
        m2_delta_chain(a, h, 512 + sb, 1, INP(a, 2) + (((size_t)l * 16 + sb) * 6 + h) * 4096, false, true, true, state_out(OUTP(a), O_PDS, O_SDS, l, 2 + sb, 6 * 4096) + (size_t)h * 4096, nullptr, lds); }
}

__device__ __forceinline__ void m3_delta_unit(const CArgs& a, int l, int c) {
    const int tid = tidx(), i = tid >> 3, part = tid & 7; const size_t row = (size_t)c * 64 + i;
    const bf16_t* P = (const bf16_t*)(WSP(a) + WS_P); bf16_t* MIX = (bf16_t*)(WSP(a) + WS_H); const float* DU = (const float*)(WSP(a) + WS_DU);
    f32x4 nw0 = *(const f32x4*)(INP(a, 17) + l * 64 + part * 8), nw1 = *(const f32x4*)(INP(a, 17) + l * 64 + part * 8 + 4);
    f32x4 oo[6][2]; u32x4 zz[6];
#pragma unroll
    for (int h = 0; h < 6; ++h) { const float* o = DU + ((size_t)c * 6 + h) * 4096 + i * 64 + part * 8; oo[h][0] = *(const f32x4*)o; oo[h][1] = *(const f32x4*)(o + 4);
        zz[h] = *(const u32x4*)(P + row * PSTR + PZA + h * 64 + part * 8); }
#pragma unroll
    for (int h = 0; h < 6; ++h) {
        const f32x4 o0 = oo[h][0], o1 = oo[h][1];
        float ss = o0[0] * o0[0] + o0[1] * o0[1] + o0[2] * o0[2] + o0[3] * o0[3] + o1[0] * o1[0] + o1[1] * o1[1] + o1[2] * o1[2] + o1[3] * o1[3];
        ss += __shfl_xor(ss, 1); ss += __shfl_xor(ss, 2); ss += __shfl_xor(ss, 4);
        const float rs = rsqrtf(ss * (1.0f / 64.f) + 1e-6f);
        const u32x4 z = zz[h];
        float zf[8] = {__uint_as_float(z.x << 16), __uint_as_float(z.x & 0xffff0000u), __uint_as_float(z.y << 16), __uint_as_float(z.y & 0xffff0000u),
                       __uint_as_float(z.z << 16), __uint_as_float(z.z & 0xffff0000u), __uint_as_float(z.w << 16), __uint_as_float(z.w & 0xffff0000u)};
        u32x4 w;
        w.x = cvtpk(o0[0] * rs * nw0[0] * siluf(zf[0]), o0[1] * rs * nw0[1] * siluf(zf[1])); w.y = cvtpk(o0[2] * rs * nw0[2] * siluf(zf[2]), o0[3] * rs * nw0[3] * siluf(zf[3]));
        w.z = cvtpk(o1[0] * rs * nw1[0] * siluf(zf[4]), o1[1] * rs * nw1[1] * siluf(zf[5])); w.w = cvtpk(o1[2] * rs * nw1[2] * siluf(zf[6]), o1[3] * rs * nw1[3] * siluf(zf[7]));
        *(u32x4*)(MIX + row * D + h * 64 + part * 8) = w;
    }
}
__device__ __forceinline__ void m3_ssd_unit(const CArgs& a, int l, int c, int g, LAS unsigned char* lds) {
    const int tid = tidx(), lane = tid & 63, wid = __builtin_amdgcn_readfirstlane(tid >> 6), fr = lane & 15, fq = lane >> 4;
    const bf16_t* P = (const bf16_t*)(WSP(a) + WS_P); bf16_t* MIX = (bf16_t*)(WSP(a) + WS_H);
    LAS bf16_t* RAWBC = (LAS bf16_t*)lds;
    LAS bf16_t* SC = (LAS bf16_t*)lds; LAS bf16_t* HT = SC + 64 * LDT;
    LAS bf16_t* BN = (LAS bf16_t*)(lds + 18432); LAS bf16_t* CN = BN + 64 * LDT;
    LAS bf16_t* RAWX = (LAS bf16_t*)(lds + 36864);
    LAS bf16_t* XDT = (LAS bf16_t*)(lds + 46080);
    LAS float* XS = (LAS float*)(lds + 55296);
    LAS float* Y = (LAS float*)(lds + 71680);
    LAS float* SM = (LAS float*)(lds + 120832);
    int s; bool first; chunk_seq(c, s, first);
    const float* st = (first && s >= 2) ? INP(a, 5) + ((size_t)l * 16 + (s - 2)) * 3 * 640 : nullptr;
    stage_raw_n<2>(RAWBC, P, c, PXBC + 384 + g * 64, PXBC + 512 + g * 64, 0, 0, st, 640, PXBC, first);
    __syncthreads();
    {   const int ch = tid & 127, part = tid >> 7, wch = ch < 64 ? 384 + g * 64 + ch : 512 + g * 64 + (ch - 64);
        const float* cw = INP(a, 18) + (size_t)l * 4 * 640 + wch; const float w0 = cw[0], w1 = cw[640], w2 = cw[1280], w3 = cw[1920], bias = INP(a, 19)[l * 640 + wch];
        float x0 = bf2f(RAWBC[(part * 16) * 128 + ch]), x1 = bf2f(RAWBC[(part * 16 + 1) * 128 + ch]), x2 = bf2f(RAWBC[(part * 16 + 2) * 128 + ch]);
#pragma unroll 8
        for (int e = 0; e < 16; ++e) { const int j = part * 16 + e; const float x3 = bf2f(RAWBC[(j + 3) * 128 + ch]);
            const float y = siluf(w0 * x0 + w1 * x1 + w2 * x2 + w3 * x3 + bias); x0 = x1; x1 = x2; x2 = x3;
            if (ch < 64) BN[j * LDT + ch] = f2bf(y); else CN[j * LDT + ch - 64] = f2bf(y); } }
    __syncthreads();
    StageRegs<1> RX; float ht[8], zb[8], xd = 0.f, cwx[5];
#define M3_PREFETCH(hh_) do { const int head_ = 3 * g + (hh_); const size_t u_ = (size_t)c * 6 + head_; \
        if (wid == 0) xd = ldp(P, (size_t)c * 64 + lane, PDT + head_); \
        { const float* cw_ = INP(a, 18) + (size_t)l * 4 * 640 + head_ * 64 + (tid & 63); cwx[0] = cw_[0]; cwx[1] = cw_[640]; cwx[2] = cw_[1280]; cwx[3] = cw_[1920]; cwx[4] = INP(a, 19)[l * 640 + head_ * 64 + (tid & 63)]; } \
        stage_load<1>(RX, P, c, PXBC + head_ * 64, 0, 0, 0, st, 640, PXBC, first); \
        { const float* SH_ = (const float*)(WSP(a) + WS_SH) + u_ * 4096; _Pragma("unroll") for (int e = 0; e < 8; ++e) ht[e] = SH_[tid + 512 * e]; } \
        _Pragma("unroll") for (int t = 0; t < 2; ++t) _Pragma("unroll") for (int r = 0; r < 4; ++r) zb[t * 4 + r] = ldp(P, (size_t)c * 64 + 16 * (wid & 3) + 4 * fq + r, PZB + head_ * 64 + 16 * (2 * (wid >> 2) + t) + fr); } while (0)
    M3_PREFETCH(0);
    for (int hh = 0; hh < 3; ++hh) {
        const int head = 3 * g + hh;
        stage_store<1>(RAWX, RX);
        if (wid == 0) {
            const float dt = softplus_f(xd + INP(a, 21)[l * 6 + head]);
            SM[lane] = wave_scan_incl(-__expf(INP(a, 20)[l * 6 + head]) * dt, lane); SM[64 + lane] = dt;
        }
#pragma unroll
        for (int e = 0; e < 8; ++e) { const int idx = tid + 512 * e, n = idx >> 6, p = idx & 63; HT[p * LDT + n] = f2bf(ht[e]); }
        float zc[8]; const float w0 = cwx[0], w1 = cwx[1], w2 = cwx[2], w3 = cwx[3], bias = cwx[4];
#pragma unroll
        for (int e = 0; e < 8; ++e) zc[e] = zb[e];
        __syncthreads();
        if (hh < 2) M3_PREFETCH(hh + 1);
        {   const int p = tid & 63, part = tid >> 6;
            float x0 = bf2f(RAWX[(part * 8) * 64 + p]), x1 = bf2f(RAWX[(part * 8 + 1) * 64 + p]), x2 = bf2f(RAWX[(part * 8 + 2) * 64 + p]);
#pragma unroll
            for (int e = 0; e < 8; ++e) { const int j = part * 8 + e; const float x3 = bf2f(RAWX[(j + 3) * 64 + p]);
                const float y = siluf(w0 * x0 + w1 * x1 + w2 * x2 + w3 * x3 + bias); x0 = x1; x1 = x2; x2 = x3;
                XS[j * 64 + p] = y; XDT[p * LDT + j] = f2bf(y * SM[64 + j]); } }
        {   const int mb = wid & 3;
            const bf16x8 a0 = ldfrag(CN, 16 * mb + fr, 0, fq), a1 = ldfrag(CN, 16 * mb + fr, 1, fq);
            float gi[4];
#pragma unroll
            for (int r = 0; r < 4; ++r) gi[r] = SM[16 * mb + 4 * fq + r];
#pragma unroll
            for (int t = 0; t < 2; ++t) { const int nb = 2 * (wid >> 2) + t;
                const bf16x8 b0 = ldfrag(BN, 16 * nb + fr, 0, fq), b1 = ldfrag(BN, 16 * nb + fr, 1, fq);
                f32x4 acc = {0.f, 0.f, 0.f, 0.f}; acc = mfma16(a0, b0, acc); acc = mfma16(a1, b1, acc);
                const int j = 16 * nb + fr; const float gj = SM[j];
#pragma unroll
                for (int r = 0; r < 4; ++r) { const int i = 16 * mb + 4 * fq + r; SC[i * LDT + j] = f2bf(i >= j ? acc[r] * __expf(gi[r] - gj) : 0.f); } } }
        __syncthreads();
        {   const int mb = wid & 3; const float dsk = INP(a, 22)[l * 6 + head];
            const bf16x8 s0 = ldfrag(SC, 16 * mb + fr, 0, fq), s1 = ldfrag(SC, 16 * mb + fr, 1, fq), c0f = ldfrag(CN, 16 * mb + fr, 0, fq), c1f = ldfrag(CN, 16 * mb + fr, 1, fq);
#pragma unroll
            for (int t = 0; t < 2; ++t) { const int nb = 2 * (wid >> 2) + t;
                f32x4 y1 = {0.f, 0.f, 0.f, 0.f}, y2 = {0.f, 0.f, 0.f, 0.f};
                y1 = mfma16(s0, ldfrag(XDT, 16 * nb + fr, 0, fq), y1); y1 = mfma16(s1, ldfrag(XDT, 16 * nb + fr, 1, fq), y1);
                y2 = mfma16(c0f, ldfrag(HT, 16 * nb + fr, 0, fq), y2); y2 = mfma16(c1f, ldfrag(HT, 16 * nb + fr, 1, fq), y2);
                const int p = 16 * nb + fr;
#pragma unroll
                for (int r = 0; r < 4; ++r) { const int i = 16 * mb + 4 * fq + r;
                    float y = y1[r] + __expf(SM[i]) * y2[r] + dsk * XS[i * 64 + p];
                    y *= siluf(zc[t * 4 + r]);
                    Y[i * 192 + hh * 64 + p] = y; } } }
        __syncthreads();
    }
#undef M3_PREFETCH
    {   const int i = tid >> 3, part = tid & 7; float v[24], ss = 0.f;
#pragma unroll
        for (int e4 = 0; e4 < 6; ++e4) { const f32x4 t = *(const LAS f32x4*)(Y + i * 192 + part * 24 + e4 * 4); v[4 * e4] = t[0]; v[4 * e4 + 1] = t[1]; v[4 * e4 + 2] = t[2]; v[4 * e4 + 3] = t[3]; }
#pragma unroll
        for (int e = 0; e < 24; ++e) ss += v[e] * v[e];
        ss += __shfl_xor(ss, 1); ss += __shfl_xor(ss, 2); ss += __shfl_xor(ss, 4);
        const float rs = rsqrtf(ss * (1.0f / 192.f) + 1e-6f); const float* nw = INP(a, 23) + l * 384 + g * 192 + part * 24;
        bf16_t* dst = MIX + ((size_t)c * 64 + i) * D + 384 + g * 192 + part * 24;
#pragma unroll
        for (int q = 0; q < 3; ++q) { u32x4 w;
            w.x = cvtpk(v[8 * q + 0] * rs * nw[8 * q + 0], v[8 * q + 1] * rs * nw[8 * q + 1]); w.y = cvtpk(v[8 * q + 2] * rs * nw[8 * q + 2], v[8 * q + 3] * rs * nw[8 * q + 3]);
            w.z = cvtpk(v[8 * q + 4] * rs * nw[8 * q + 4], v[8 * q + 5] * rs * nw[8 * q + 5]); w.w = cvtpk(v[8 * q + 6] * rs * nw[8 * q + 6], v[8 * q + 7] * rs * nw[8 * q + 7]);
            *(u32x4*)(dst + 8 * q) = w; } }
    __syncthreads();
}
__device__ __forceinline__ void m3_lru_unit(const CArgs& a, int l, int c, LAS unsigned char* lds, const LruW& W) {
    const int tid = tidx(), ch = tid & 255, half = tid >> 8;
    const bf16_t* P = (const bf16_t*)(WSP(a) + WS_P); bf16_t* MIX = (bf16_t*)(WSP(a) + WS_H);
    LAS float* XC = (LAS float*)(lds + 34816);
    float gz[32];
#pragma unroll
    for (int e = 0; e < 32; ++e) gz[e] = ldp(P, (size_t)c * 64 + half * 32 + e, PGC + ch);
    float hcur = ((const float*)(WSP(a) + WS_LB))[c * 256 + ch];
    const float a0h = ((const float*)(WSP(a) + WS_LA0))[c * 256 + ch], b0h = ((const float*)(WSP(a) + WS_LB0))[c * 256 + ch];
    lru_stage_conv(a, l, c, lds);
    if (half == 1) hcur = a0h * hcur + b0h;
    lru_gates(W, XC, ch, half, [&](int e, float at, float bt) { hcur = at * hcur + bt;
        const size_t row = (size_t)c * 64 + half * 32 + e; MIX[row * D + 768 + ch] = f2bf(hcur * gelu_tanh(gz[e])); });
    __syncthreads();
}
__device__ __forceinline__ void m3_state_unit(const CArgs& a, int l, int s) {
    const bf16_t* P = (const bf16_t*)(WSP(a) + WS_P); const size_t r0 = seq_row0(s) + seq_len(s) - 3;
    float* oa = state_out(OUTP(a), O_PDC, O_SDC, l, s, 3 * 1152); float* ob = state_out(OUTP(a), O_PSC, O_SSC, l, s, 3 * 640); float* oc = state_out(OUTP(a), O_PLC, O_SLC, l, s, 3 * 256);
    for (int idx = tidx(); idx < 3 * 2048; idx += 512) { const int j = idx / 2048, e = idx % 2048;
        if (e < 1152) oa[j * 1152 + e] = ldp(P, r0 + j, e);
        else if (e < 1792) ob[j * 640 + e - 1152] = ldp(P, r0 + j, PXBC + e - 1152);
        else oc[j * 256 + e - 1792] = ldp(P, r0 + j, PXC + e - 1792); }
}
__device__ __forceinline__ void m3_phase(const CArgs& a0, int l, LAS unsigned char* lds) {
    { LAUNDER_ARGS(); UNIT_LOOP(0, 2 * NCH) m3_ssd_unit(a, l, id >> 1, id & 1, lds); }
    { LAUNDER_ARGS(); LruW W; lru_load_w(a, l, tidx() & 255, W); UNIT_LOOP(2 * NCH, 3 * NCH) m3_lru_unit(a, l, id - 2 * NCH, lds, W); }
    { LAUNDER_ARGS(); UNIT_LOOP(3 * NCH, 4 * NCH) m3_delta_unit(a, l, id - 3 * NCH); }
    { LAUNDER_ARGS(); UNIT_LOOP(4 * NCH, 4 * NCH + 18) m3_state_unit(a, l, id - 4 * NCH); }
}
namespace cg = cooperative_groups;
#define GEMM_GU(l, f) do { PH_BEGIN(); pg8::Gemm g{(const bf16_t*)OUTP(a), (const bf16_t*)(WSP(a) + WS_WGU + (size_t)((l) * 2 + (f)) * SZ_WGU), T, NGU, D}; pg8::StaticOrder S; S.init(T, NGU, gridDim.x, blockIdx.x); \
        pg8::rs_prepare(lds, S, (const float*)(WSP(a) + WS_RS), tidx()); pg8::EpiGU E{P, FF, lds}; pg8::gemm_phase<pg8::EpiGU, pg8::StaticOrder, true, true>(lds, g, S, E); } while (0)
#define SPLITK_TAIL(Aptr, Wptr, LDK, NSL) do { pg8::Gemm g2{(Aptr) + (size_t)TP * (LDK), (Wptr), TS, D, 256, (LDK)}; pg8::SplitKOrder S2{TS / 256, D / 256, (NSL), 256, (int)gridDim.x, (int)blockIdx.x}; \
        pg8::EpiSlab E2{(float*)(WSP(a) + WS_SLAB), D, 256, (size_t)TS * D}; pg8::gemm_phase<pg8::EpiSlab, pg8::SplitKOrder, true, true>(lds, g2, S2, E2); } while (0)
#define GEMM_DN(l, f) do { { PH_BEGIN(); const bf16_t* W = (const bf16_t*)(WSP(a) + WS_WDN + (size_t)((l) * 2 + (f)) * SZ_WDN); pg8::Gemm g{P, W, TP, D, FF}; pg8::StaticOrder S; S.init(TP, D, gridDim.x, blockIdx.x); \
        pg8::EpiRes E{(bf16_t*)OUTP(a), ((l) == 1 && (f) == 1) ? (bf16_t*)(WSP(a) + WS_H) : (bf16_t*)OUTP(a), 0.5f, (float*)(WSP(a) + WS_RS)}; pg8::gemm_phase<pg8::EpiRes, pg8::StaticOrder, true, true>(lds, g, S, E); \
        SPLITK_TAIL(P, W, FF, 11); } BAR(); \
        { PH_BEGIN(); sample_reduce_phase<11>(a, 0.5f, (l) == 1 && (f) == 1, (float*)(WSP(a) + WS_RS)); } } while (0)
#define GEMM_IN(l) do { PH_BEGIN(); pg8::Gemm g{(const bf16_t*)OUTP(a), (const bf16_t*)(WSP(a) + WS_WIN + (size_t)(l) * SZ_WIN), T, NPIN, D}; pg8::StaticOrder S; S.init(T, NPIN, gridDim.x, blockIdx.x); \
        pg8::rs_prepare(lds, S, (const float*)(WSP(a) + WS_RS), tidx()); pg8::EpiP E{P, PSTR, PSTR, lds}; pg8::gemm_phase<pg8::EpiP, pg8::StaticOrder, true, true>(lds, g, S, E); } while (0)
#define GEMM_OUT(l) do { { PH_BEGIN(); const bf16_t* W = (const bf16_t*)(WSP(a) + WS_WOUT + (size_t)(l) * SZ_WOUT); pg8::Gemm g{H, W, TP, D, D}; pg8::StaticOrder S; S.init(TP, D, gridDim.x, blockIdx.x); \
        pg8::EpiRes E{(bf16_t*)OUTP(a), (bf16_t*)OUTP(a), 1.0f, (float*)(WSP(a) + WS_RS)}; pg8::gemm_phase<pg8::EpiRes, pg8::StaticOrder, true, true>(lds, g, S, E); \
        SPLITK_TAIL(H, W, D, 4); } BAR(); \
        { PH_BEGIN(); sample_reduce_phase<4>(a, 1.0f, false, (float*)(WSP(a) + WS_RS)); } } while (0)

__global__ void __launch_bounds__(512, 2) mk_fwd(Args a_) {
#define PH_BEGIN() const CArgs* ap_ = (const CArgs*)__builtin_amdgcn_kernarg_segment_ptr(); asm volatile("" : "+s"(ap_)); const CArgs& a = *ap_; \
        bf16_t* H = (bf16_t*)(WSP(a) + WS_H); bf16_t* P = (bf16_t*)(WSP(a) + WS_P); (void)H; (void)P; LAS unsigned char* lds = (LAS unsigned char*)lds_raw
    extern __shared__ __attribute__((aligned(16))) unsigned char lds_raw[];
    LAS unsigned char* lds = (LAS unsigned char*)lds_raw;
    volatile LAS unsigned* misc = (volatile LAS unsigned*)(lds + MISC_OFF);
    if (threadIdx.x < 4) misc[threadIdx.x] = 0u;
    __syncthreads();
    XcdBarrier bar = xcd_barrier_post((unsigned*)(a_.ws + WS_CTL), misc);
    if (a_.ph_lo < 0) cg::this_grid().sync();
#define BAR() xcd_barrier(bar)
#define NORM(gi, goff, mode) do { PH_BEGIN(); norm_phase(a, INP(a, gi) + (goff), mode); } while (0)
#define MIXER(l) { PH_BEGIN(); m1_phase(a, l, lds); } BAR(); { PH_BEGIN(); m2a_phase(a, l, lds); } BAR(); { PH_BEGIN(); m2b_phase(a, l); } BAR(); { PH_BEGIN(); m2c_phase(a, l, lds); } BAR(); { PH_BEGIN(); m3_phase(a, l, lds); } BAR();
    { PH_BEGIN(); wprep_phase(a, lds); } NORM(8, 0, 0); BAR();
#define LAYER(l) \
        GEMM_GU(l, 0); BAR(); \
        GEMM_DN(l, 0); BAR(); \
        GEMM_IN(l); BAR(); \
        MIXER(l); \
        GEMM_OUT(l); BAR(); \
        GEMM_GU(l, 1); BAR(); \
        GEMM_DN(l, 1); BAR();
    LAYER(0)
    LAYER(1) NORM(36, 0, 2);
}

extern "C" void kernel_launch(void* const* d_in, const int* in_sizes, int n_in, void* d_out, int out_size, void* d_ws, size_t ws_size, hipStream_t stream) {
    static int grid = 0;
    if (grid == 0) {
        if (n_in != 37 || (size_t)out_size != O_END || ws_size < WS_END) { fprintf(stderr, "kernel_launch: unexpected shapes: n_in %d out %d (want %zu) ws %zu (want %zu)\n", n_in, out_size, (size_t)O_END, ws_size, (size_t)WS_END); grid = -1; return; }
        int dev = 0, cus = 0, per_cu = 0;
        if (hipGetDevice(&dev) != hipSuccess || hipDeviceGetAttribute(&cus, hipDeviceAttributeMultiprocessorCount, dev) != hipSuccess) { grid = -1; return; }
        if (hipFuncSetAttribute((const void*)mk_fwd, hipFuncAttributeMaxDynamicSharedMemorySize, LDS_BYTES) != hipSuccess) { fprintf(stderr, "kernel_launch: hipFuncSetAttribute failed\n"); grid = -1; return; }
        if (hipOccupancyMaxActiveBlocksPerMultiprocessor(&per_cu, (const void*)mk_fwd, 512, LDS_BYTES) != hipSuccess || per_cu < 1) { fprintf(stderr, "kernel_launch: occupancy query says %d\n", per_cu); (void)hipGetLastError(); }
        grid = cus;
    }
    if (grid < 0) return;
    (void)hipMemsetAsync((char*)d_ws + WS_CTL, 0, 65536, stream);
    Args a{};
    for (int i = 0; i < 37; ++i) a.in[i] = (const float*)d_in[i];
    a.out = (float*)d_out; a.ws = (unsigned char*)d_ws; a.ph_lo = 0; a.ph_hi = 0;
    void* args[] = {&a};
    hipError_t e = hipLaunchCooperativeKernel((const void*)mk_fwd, dim3(grid), dim3(512), args, LDS_BYTES, stream);
    if (e != hipSuccess) fprintf(stderr, "kernel_launch: cooperative launch failed: %s\n", hipGetErrorString(e));
}
```

```cpp
#include <hip/hip_runtime.h>
#include <hip/hip_cooperative_groups.h>
#include <cstdio>
#include <cstdint>
#define MK_ONE_LAUNCH 1
namespace pg8 {
#define PG8_LAS __attribute__((address_space(3)))
typedef unsigned short bf16_t;
typedef short bf16x8 __attribute__((ext_vector_type(8)));
typedef float f32x4 __attribute__((ext_vector_type(4)));
typedef unsigned u32x4 __attribute__((ext_vector_type(4)));
constexpr int BM = 256, BK = 64, HALF = 128, HTB = HALF * BK * 2  , STAGE_BYTES = 8 * HTB, NXCD = 8, WGM = 8;

__host__ __device__ __forceinline__ int lds_byte(int r, int c) { const int st = (r >> 4) * 2 + (c >> 5), rr = r & 15, cc = c & 31, ob = rr * 64 + cc * 2; return st * 1024 + (ob ^ (((ob >> 9) & 1) << 5)); }
__host__ __device__ __forceinline__ void stage_rc(int b, int& R, int& C) { const int st = b / 1024, sb = b % 1024, swz = sb ^ (((sb >> 9) & 1) << 5); R = (st >> 1) * 16 + swz / 64; C = (st & 1) * 32 + (swz % 64) / 2; }
__host__ __device__ __forceinline__ int perm32(int rho) { const int n = rho >> 4, i = rho & 15; return 8 * (i >> 2) + 4 * n + (i & 3); }

struct Unit { int pm, pn, seq, k0; };
struct Gemm { const bf16_t* A; const bf16_t* Bt; int M, N, K, ld; };

struct StaticOrder {
    int nM, nN, nwg, G, c;
    __host__ __device__ void init(int M, int N, int G_, int c_) { nM = M / BM; nN = N / BM; nwg = nM * nN; G = G_; c = c_; }
    __host__ __device__ bool next(int i, Unit& u) const {
        const long L = (long)i * G + c; if (L >= nwg) return false;
        int wgid = (int)L; { const int q = nwg / NXCD, r = nwg % NXCD, xcd = wgid % NXCD, off = wgid / NXCD; wgid = (xcd < r ? xcd * (q + 1) : r * (q + 1) + (xcd - r) * q) + off; }
        const int nig = WGM * nN, gid = wgid / nig, fm = gid * WGM, gsz = (nM - fm) < WGM ? (nM - fm) : WGM;
        u.pm = fm + ((wgid % nig) % gsz); u.pn = (wgid % nig) / gsz; u.seq = i; u.k0 = 0; return true;
    }
    __device__ __forceinline__ void a_ready(const Unit&) const {}
    __device__ __forceinline__ void done(const Unit&) const {}
};

__device__ __forceinline__ unsigned cvt_pk_bf16(float lo, float hi) { unsigned r; asm volatile("v_cvt_pk_bf16_f32 %0, %1, %2" : "=v"(r) : "v"(lo), "v"(hi)); return r; }
typedef unsigned u32x2v __attribute__((ext_vector_type(2)));
__device__ __forceinline__ float silu_f(float g) { return g * __builtin_amdgcn_rcpf(1.0f + __expf(-g)); }
constexpr int RSLD = 33792;
constexpr int RSL_OFF = 128 * 1024;
template <class Sched> __device__ __forceinline__ void rs_prepare(PG8_LAS unsigned char* lds, const Sched& S, const float* RS, int tid) {
    PG8_LAS float* rsl = (PG8_LAS float*)(lds + RSL_OFF); Unit u; int nU = 0;
    while (S.next(nU, u)) ++nU;
#pragma unroll 2
    for (int idx = tid; idx < nU * 256; idx += 512) { const int i = idx >> 8, r = idx & 255; S.next(i, u); const float* p = RS + (size_t)u.pm * BM + r;
        float q[16];
#pragma unroll
        for (int k = 0; k < 16; ++k) q[k] = p[(size_t)k * RSLD];
        const float s = (((q[0] + q[1]) + (q[2] + q[3])) + ((q[4] + q[5]) + (q[6] + q[7]))) + (((q[8] + q[9]) + (q[10] + q[11])) + ((q[12] + q[13]) + (q[14] + q[15])));
        rsl[i * 256 + r] = rsqrtf(s * (1.0f / 1024.f) + 1e-6f); }
    __syncthreads();
}
__device__ __forceinline__ float row_rs(PG8_LAS unsigned char* lds, const Unit& u, int rloc) { return ((const PG8_LAS float*)(lds + RSL_OFF))[u.seq * 256 + rloc]; }
typedef unsigned u32x4v __attribute__((ext_vector_type(4)));
struct EpiGU {
    static constexpr bool PERM = true, AFTER_DRAIN = false;
    bf16_t* O; int ldo; PG8_LAS unsigned char* lds;
    __device__ __forceinline__ void operator()(const f32x4 (&acc)[2][2][4][2], const Unit& u, int wr, int wc, int fr, int fq) const {
        const int row0 = u.pm * BM + wr * 64 + fr, col0 = u.pn * HALF + wc * 32 + 8 * fq;
#pragma unroll
        for (int ai = 0; ai < 2; ++ai)
#pragma unroll
            for (int m = 0; m < 4; ++m) { const int row = row0 + ai * HALF + m * 16; const float rs = row_rs(lds, u, wr * 64 + ai * HALF + m * 16 + fr);
                const f32x4 g0 = acc[ai][0][m][0] * rs, g1 = acc[ai][0][m][1] * rs, v0 = acc[ai][1][m][0] * rs, v1 = acc[ai][1][m][1] * rs;
                u32x4v w; w.x = cvt_pk_bf16(silu_f(g0[0]) * v0[0], silu_f(g0[1]) * v0[1]); w.y = cvt_pk_bf16(silu_f(g0[2]) * v0[2], silu_f(g0[3]) * v0[3]);
                w.z = cvt_pk_bf16(silu_f(g1[0]) * v1[0], silu_f(g1[1]) * v1[1]); w.w = cvt_pk_bf16(silu_f(g1[2]) * v1[2], silu_f(g1[3]) * v1[3]);
                *(u32x4v*)(O + (size_t)row * ldo + col0) = w; }
    }
};
struct EpiRes {
    static constexpr bool PERM = true, AFTER_DRAIN = false;
    static constexpr int ldc = 1024;
    bf16_t* XB; bf16_t* XO; float scale; float* RS;
    __device__ __forceinline__ void operator()(const f32x4 (&acc)[2][2][4][2], const Unit& u, int wr, int wc, int fr, int fq) const {
        const int row0 = u.pm * BM + wr * 64 + fr, col0 = u.pn * BM + wc * 32 + 8 * fq;
#pragma unroll
        for (int ai = 0; ai < 2; ++ai) {
            u32x4v xi[4][2];
#pragma unroll
            for (int m = 0; m < 4; ++m)
#pragma unroll
                for (int bj = 0; bj < 2; ++bj) xi[m][bj] = *(const u32x4v*)(XB + (size_t)(row0 + ai * HALF + m * 16) * ldc + col0 + bj * HALF);
#pragma unroll
            for (int m = 0; m < 4; ++m) { const int row = row0 + ai * HALF + m * 16; float ss = 0.f;
#pragma unroll
                for (int bj = 0; bj < 2; ++bj) { const u32x4v x = xi[m][bj];
                    f32x4 o0 = {__uint_as_float(x.x << 16), __uint_as_float(x.x & 0xffff0000u), __uint_as_float(x.y << 16), __uint_as_float(x.y & 0xffff0000u)};
                    f32x4 o1 = {__uint_as_float(x.z << 16), __uint_as_float(x.z & 0xffff0000u), __uint_as_float(x.w << 16), __uint_as_float(x.w & 0xffff0000u)};
                    o0 += scale * acc[ai][bj][m][0]; o1 += scale * acc[ai][bj][m][1];
                    { u32x4v w; w.x = cvt_pk_bf16(o0[0], o0[1]); w.y = cvt_pk_bf16(o0[2], o0[3]); w.z = cvt_pk_bf16(o1[0], o1[1]); w.w = cvt_pk_bf16(o1[2], o1[3]);
                        *(u32x4v*)(XO + (size_t)row * ldc + col0 + bj * HALF) = w;
                        const float r0 = __uint_as_float(w.x << 16), r1 = __uint_as_float(w.x & 0xffff0000u), r2 = __uint_as_float(w.y << 16), r3 = __uint_as_float(w.y & 0xffff0000u),
                                    r4 = __uint_as_float(w.z << 16), r5 = __uint_as_float(w.z & 0xffff0000u), r6 = __uint_as_float(w.w << 16), r7 = __uint_as_float(w.w & 0xffff0000u);
                        ss += (r0 * r0 + r1 * r1 + r2 * r2 + r3 * r3) + (r4 * r4 + r5 * r5 + r6 * r6 + r7 * r7); } }
                { ss += __shfl_xor(ss, 16); ss += __shfl_xor(ss, 32); if (fq == 0) RS[(size_t)(u.pn * 4 + wc) * RSLD + row] = ss; } }
        }
    }
};
struct EpiP {
    static constexpr bool PERM = true, AFTER_DRAIN = false;
    bf16_t* O; int ldo; int ncols; PG8_LAS unsigned char* lds;
    __device__ __forceinline__ void operator()(const f32x4 (&acc)[2][2][4][2], const Unit& u, int wr, int wc, int fr, int fq) const {
        const int row0 = u.pm * BM + wr * 64 + fr, col0 = u.pn * BM + wc * 32 + 8 * fq;
#pragma unroll
        for (int ai = 0; ai < 2; ++ai)
#pragma unroll
            for (int m = 0; m < 4; ++m) { const int row = row0 + ai * HALF + m * 16; bf16_t* rowp = O + (size_t)row * ldo; const float rs = row_rs(lds, u, wr * 64 + ai * HALF + m * 16 + fr);
#pragma unroll
                for (int bj = 0; bj < 2; ++bj) { const int c = col0 + bj * HALF; const f32x4 v0 = acc[ai][bj][m][0] * rs, v1 = acc[ai][bj][m][1] * rs;
                    if (c < ncols) { u32x4v w; w.x = cvt_pk_bf16(v0[0], v0[1]); w.y = cvt_pk_bf16(v0[2], v0[3]); w.z = cvt_pk_bf16(v1[0], v1[1]); w.w = cvt_pk_bf16(v1[2], v1[3]); *(u32x4v*)(rowp + c) = w; } } }
    }
};

struct SplitKOrder {
    int nM, nN, nK, kslice, G, c;
    __device__ bool next(int i, Unit& u) const { const int L = i * G + c; if (L >= nM * nN * nK) return false; u.pn = L % nN; u.pm = (L / nN) % nM; u.k0 = (L / (nN * nM)) * kslice; u.seq = i; return true; }
    __device__ __forceinline__ void a_ready(const Unit&) const {}
    __device__ __forceinline__ void done(const Unit&) const {}
};
struct EpiSlab {
    static constexpr bool PERM = false, AFTER_DRAIN = false;
    float* S; int ldc; int kslice; size_t slab;
    __device__ __forceinline__ void operator()(const f32x4 (&acc)[2][2][4][2], const Unit& u, int wr, int wc, int fr, int fq) const {
        const int row0 = u.pm * BM + wr * 64 + fr, col0 = u.pn * BM + wc * 32 + 4 * fq; float* base = S + (size_t)(u.k0 / kslice) * slab;
#pragma unroll
        for (int ai = 0; ai < 2; ++ai)
#pragma unroll
            for (int m = 0; m < 4; ++m) { float* rowp = base + (size_t)(row0 + ai * HALF + m * 16) * ldc + col0;
#pragma unroll
                for (int bj = 0; bj < 2; ++bj)
#pragma unroll
                    for (int n = 0; n < 2; ++n) *(f32x4*)(rowp + bj * HALF + n * 16) = acc[ai][bj][m][n]; }
    }
};
template <class Epi, class Sched, bool ALIGN_EPI = false, bool SP2 = false>
__device__ __forceinline__ void gemm_phase(PG8_LAS unsigned char* lds, const Gemm g, const Sched& S, const Epi& E) {
    int tid_ = threadIdx.x; asm volatile("" : "+v"(tid_));
    const int tid = tid_, wid = __builtin_amdgcn_readfirstlane(tid >> 6), lane = tid & 63, wr = wid >> 2, wc = wid & 3, fr = lane & 15, fq = lane >> 4;
    const int K = g.K, nt = K / BK, LD = g.ld ? g.ld : g.K;
    unsigned voffA[2], voffB[2];
#pragma unroll
    for (int i = 0; i < 2; ++i) { int R, C; stage_rc(tid * 16 + i * 8192, R, C); const int Rb = Epi::PERM ? ((R & ~31) + perm32(R & 31)) : R;
        voffA[i] = (unsigned)(R * LD + C) * 2u; voffB[i] = (unsigned)(Rb * LD + C) * 2u; }
    const size_t kstep = (size_t)(BK * 2);
    const size_t hstep = (size_t)HALF * LD * 2;
    const size_t tstep = 2 * hstep;
    const unsigned ldsw = (unsigned)wid * 1024u;
    const int aoff = lds_byte(wr * 64 + fr, fq * 8), boff = lds_byte(wc * 32 + fr, fq * 8);
#define PG8_SA(b, h) (((b) * 2 + (h)) * HTB)
#define PG8_SB(b, h) ((4 + (b) * 2 + (h)) * HTB)
#define PG8_STAGE(bufoff, gbase, voff) do { _Pragma("unroll") for (int _i = 0; _i < 2; ++_i) \
        __builtin_amdgcn_global_load_lds((const unsigned*)((const char*)(gbase) + (voff)[_i]), (PG8_LAS unsigned*)(lds + (bufoff) + ldsw + _i * 8192), 16, 0, 0); } while (0)
#define PG8_LDA(dst, b, h) do { _Pragma("unroll") for (int m = 0; m < 4; ++m) _Pragma("unroll") for (int k = 0; k < 2; ++k) dst[m][k] = *(const PG8_LAS bf16x8*)(lds + PG8_SA(b, h) + aoff + m * 2048 + k * 1024); } while (0)
#define PG8_LDB(dst, b, h) do { _Pragma("unroll") for (int n = 0; n < 2; ++n) _Pragma("unroll") for (int k = 0; k < 2; ++k) dst[n][k] = *(const PG8_LAS bf16x8*)(lds + PG8_SB(b, h) + boff + n * 2048 + k * 1024); } while (0)
#define PG8_MMA(ai, bj, At, Bt) do { __builtin_amdgcn_s_setprio(1); _Pragma("unroll") for (int m = 0; m < 4; ++m) _Pragma("unroll") for (int n = 0; n < 2; ++n) _Pragma("unroll") for (int k = 0; k < 2; ++k) \
        acc[ai][bj][m][n] = __builtin_amdgcn_mfma_f32_16x16x32_bf16(Bt[n][k], At[m][k], acc[ai][bj][m][n], 0, 0, 0); __builtin_amdgcn_s_setprio(0); } while (0)
#define PG8_WAIT_V(n) asm volatile("s_waitcnt vmcnt(" #n ")" ::: "memory")
#define PG8_WAIT_L(n) asm volatile("s_waitcnt lgkmcnt(" #n ")" ::: "memory")
#define PG8_BAR __builtin_amdgcn_s_barrier()
#define PG8_SCHED __builtin_amdgcn_sched_barrier(0)
    Unit cur, nxt; int ui = 0;
    if (!S.next(0, cur)) return;
    f32x4 acc[2][2][4][2];
#pragma unroll
    for (int a = 0; a < 2; ++a)
#pragma unroll
        for (int b = 0; b < 2; ++b)
#pragma unroll
            for (int m = 0; m < 4; ++m)
#pragma unroll
                for (int n = 0; n < 2; ++n) acc[a][b][m][n] = (f32x4){0.f, 0.f, 0.f, 0.f};
    bf16x8 At[4][2], B0[2][2], B1[2][2];
    const char* cA = (const char*)g.A + (size_t)cur.pm * tstep + (size_t)cur.k0 * 2; const char* cB = (const char*)g.Bt + (size_t)cur.pn * tstep + (size_t)cur.k0 * 2;
    S.a_ready(cur);
    if constexpr (SP2) {
        PG8_STAGE(PG8_SB(0, 0), cB, voffB); PG8_STAGE(PG8_SB(0, 1), cB + hstep, voffB); PG8_STAGE(PG8_SA(0, 0), cA, voffA); PG8_STAGE(PG8_SA(0, 1), cA + hstep, voffA);
        if (wr == 1) PG8_BAR;
        PG8_WAIT_V(2); PG8_BAR;
        PG8_STAGE(PG8_SB(1, 0), cB + kstep, voffB); PG8_STAGE(PG8_SA(1, 0), cA + kstep, voffA); PG8_STAGE(PG8_SB(1, 1), cB + hstep + kstep, voffB);
        PG8_WAIT_V(6); PG8_BAR;
    } else {
        PG8_STAGE(PG8_SB(0, 0), cB, voffB); PG8_STAGE(PG8_SA(0, 0), cA, voffA); PG8_STAGE(PG8_SB(0, 1), cB + hstep, voffB); PG8_STAGE(PG8_SA(0, 1), cA + hstep, voffA);
        if (wr == 1) PG8_BAR;
        PG8_WAIT_V(4); PG8_BAR;
        PG8_STAGE(PG8_SB(1, 0), cB + kstep, voffB); PG8_STAGE(PG8_SA(1, 0), cA + kstep, voffA); PG8_STAGE(PG8_SB(1, 1), cB + hstep + kstep, voffB);
        PG8_WAIT_V(6); PG8_BAR;
    }
    for (;;) {
        const bool has_next = S.next(ui + 1, nxt);
        const char* nA = has_next ? (const char*)g.A + (size_t)nxt.pm * tstep + (size_t)nxt.k0 * 2 : cA; const char* nB = has_next ? (const char*)g.Bt + (size_t)nxt.pn * tstep + (size_t)nxt.k0 * 2 : cB;
        for (int t = 0; t < nt; t += 2) {
            const bool last = (t == nt - 2);
            const char* a1 = cA + (size_t)(t + 1) * kstep;
            const char* a2 = last ? nA : cA + (size_t)(t + 2) * kstep; const char* b2 = last ? nB : cB + (size_t)(t + 2) * kstep;
            const char* a3 = a2 + kstep; const char* b3 = b2 + kstep;
            if (last && has_next) S.a_ready(nxt);
            if constexpr (SP2) {
            PG8_LDB(B0, 0, 0); PG8_LDB(B1, 0, 1); PG8_SCHED; PG8_LDA(At, 0, 0); PG8_STAGE(PG8_SA(1, 1), a1 + hstep, voffA);
            PG8_WAIT_V(8); PG8_WAIT_L(0); PG8_BAR; PG8_MMA(0, 0, At, B0); PG8_MMA(0, 1, At, B1); PG8_BAR; PG8_SCHED;
            PG8_LDA(At, 0, 1); PG8_STAGE(PG8_SB(0, 0), b2, voffB); PG8_STAGE(PG8_SB(0, 1), b2 + hstep, voffB); PG8_STAGE(PG8_SA(0, 0), a2, voffA);
            PG8_WAIT_V(8); PG8_WAIT_L(0); PG8_BAR; PG8_MMA(1, 0, At, B0); PG8_MMA(1, 1, At, B1); PG8_BAR; PG8_SCHED;
            PG8_LDB(B0, 1, 0); PG8_LDB(B1, 1, 1); PG8_SCHED; PG8_LDA(At, 1, 0); PG8_STAGE(PG8_SA(0, 1), a2 + hstep, voffA);
            PG8_WAIT_V(8); PG8_WAIT_L(0); PG8_BAR; PG8_MMA(0, 0, At, B0); PG8_MMA(0, 1, At, B1); PG8_BAR; PG8_SCHED;
            PG8_LDA(At, 1, 1); PG8_STAGE(PG8_SB(1, 0), b3, voffB); PG8_STAGE(PG8_SB(1, 1), b3 + hstep, voffB); PG8_STAGE(PG8_SA(1, 0), a3, voffA);
            PG8_WAIT_V(8); PG8_WAIT_L(0); PG8_BAR; PG8_MMA(1, 0, At, B0); PG8_MMA(1, 1, At, B1); PG8_BAR; PG8_SCHED;
            } else {
            PG8_LDB(B0, 0, 0); PG8_SCHED; PG8_LDA(At, 0, 0); PG8_STAGE(PG8_SA(1, 1), a1 + hstep, voffA);
            PG8_WAIT_L(8); PG8_BAR; PG8_WAIT_L(0); PG8_MMA(0, 0, At, B0); PG8_BAR; PG8_SCHED;
            PG8_LDB(B1, 0, 1); PG8_STAGE(PG8_SB(0, 0), b2, voffB);
            PG8_BAR; PG8_WAIT_L(0); PG8_MMA(0, 1, At, B1); PG8_BAR;
            PG8_LDA(At, 0, 1); PG8_STAGE(PG8_SA(0, 0), a2, voffA);
            PG8_BAR; PG8_WAIT_L(0); PG8_MMA(1, 0, At, B0); PG8_BAR; PG8_SCHED;
            PG8_STAGE(PG8_SB(0, 1), b2 + hstep, voffB);
            PG8_WAIT_V(6); PG8_BAR; PG8_MMA(1, 1, At, B1); PG8_BAR;
            PG8_LDB(B0, 1, 0); PG8_SCHED; PG8_LDA(At, 1, 0); PG8_STAGE(PG8_SA(0, 1), a2 + hstep, voffA);
            PG8_WAIT_L(8); PG8_BAR; PG8_WAIT_L(0); PG8_MMA(0, 0, At, B0); PG8_BAR; PG8_SCHED;
            PG8_LDB(B1, 1, 1); PG8_STAGE(PG8_SB(1, 0), b3, voffB);
            PG8_BAR; PG8_WAIT_L(0); PG8_MMA(0, 1, At, B1); PG8_BAR;
            PG8_LDA(At, 1, 1); PG8_STAGE(PG8_SA(1, 0), a3, voffA);
            PG8_BAR; PG8_WAIT_L(0); PG8_MMA(1, 0, At, B0); PG8_BAR; PG8_SCHED;
            PG8_STAGE(PG8_SB(1, 1), b3 + hstep, voffB);
            PG8_WAIT_V(6); PG8_BAR; PG8_MMA(1, 1, At, B1); PG8_BAR;
            }
        }
        if constexpr (ALIGN_EPI) { if (wr == 0) PG8_BAR; }
        if constexpr (!Epi::AFTER_DRAIN) { E(acc, cur, wr, wc, fr, fq); S.done(cur); }
        if (!has_next) break;
#pragma unroll
        for (int a = 0; a < 2; ++a)
#pragma unroll
            for (int b = 0; b < 2; ++b)
#pragma unroll
                for (int m = 0; m < 4; ++m)
#pragma unroll
                    for (int n = 0; n < 2; ++n) acc[a][b][m][n] = (f32x4){0.f, 0.f, 0.f, 0.f};
        cur = nxt; cA = nA; cB = nB; ++ui;
        if constexpr (ALIGN_EPI) { if (wr == 1) PG8_BAR; }
    }
    PG8_WAIT_V(0);
    if constexpr (!ALIGN_EPI) { if (wr == 0) PG8_BAR; }
    PG8_BAR;
    if constexpr (Epi::AFTER_DRAIN) { E.fused(acc, cur, wr, wc, fr, fq, lds, wid, lane); S.done(cur); }
#undef PG8_SA
#undef PG8_SB
#undef PG8_STAGE
#undef PG8_LDA
#undef PG8_LDB
#undef PG8_MMA
#undef PG8_WAIT_V
#undef PG8_WAIT_L
#undef PG8_BAR
#undef PG8_SCHED
}
}
#define XB_TMO      128
#define XB_XCNT(j)  (256  + 64 * (j))
#define XB_XSUB(j)  (1280 + 64 * (j))
#define XB_XGEN(j)  (2304 + 64 * (j))
#define XB_TOP      3328
#define XB_TOPGEN   3392
#define XCD_BAR_WORDS 3456
#define XB_SPIN_CAP (1u << 24)
#define LAS __attribute__((address_space(3)))

__device__ __forceinline__ unsigned xb_ld(unsigned* p)              { return __hip_atomic_load(p, __ATOMIC_RELAXED, __HIP_MEMORY_SCOPE_AGENT); }
__device__ __forceinline__ unsigned xb_add(unsigned* p, unsigned v) { return __hip_atomic_fetch_add(p, v, __ATOMIC_RELAXED, __HIP_MEMORY_SCOPE_AGENT); }
__device__ __forceinline__ unsigned xb_xcc_id() { return (unsigned)__builtin_amdgcn_s_getreg((3 << 11) | 20) & 0xFu; }
#define XB_SPIN(cond, bar) do { unsigned _sp = 0; while (cond) { __builtin_amdgcn_s_sleep(1); \
    if ((++_sp & 255u) == 0u) { if (xb_ld(&(bar)[XB_TMO])) break; if (_sp > XB_SPIN_CAP) { atomicAdd(&(bar)[XB_TMO], 1u); break; } } } } while (0)

struct XcdBarrier {
    unsigned* bar; unsigned x;
    volatile LAS unsigned* st;
};

__device__ __forceinline__ XcdBarrier xcd_barrier_post(unsigned* bar, volatile LAS unsigned* st) {
    XcdBarrier b; b.bar = bar; b.x = xb_xcc_id(); b.st = st;
    if (threadIdx.x == 0) (void)xb_add(&bar[XB_XCNT(b.x)], 1u);
    return b;
}
__device__ __forceinline__ void xcd_barrier_complete(unsigned* bar, unsigned x, unsigned& nloc, unsigned& nx) {
    const unsigned G = gridDim.x * gridDim.y * gridDim.z;
    unsigned sum, cnt, mine, sp = 0u;
    for (;;) {
        sum = 0u; cnt = 0u; mine = 0u;
#pragma unroll
        for (unsigned j = 0; j < 16; ++j) { const unsigned c = xb_ld(&bar[XB_XCNT(j)]); sum += c; cnt += (c > 0u) ? 1u : 0u; mine = (j == x) ? c : mine; }
        if (sum == G) break;
        __builtin_amdgcn_s_sleep(1);
        if ((++sp & 255u) == 0u) { if (xb_ld(&bar[XB_TMO])) break; if (sp > XB_SPIN_CAP) { atomicAdd(&bar[XB_TMO], 1u); break; } }
    }
    nloc = mine > 0u ? mine : 1u; nx = cnt > 0u ? cnt : 1u;
}

__device__ __forceinline__ void xcd_barrier(const XcdBarrier& b) {
    asm volatile("s_waitcnt vmcnt(0)" ::: "memory");
    __syncthreads();
    if (threadIdx.x == 0) {
        unsigned* bar = b.bar;
        __builtin_amdgcn_s_waitcnt(0);
        unsigned nloc = b.st[0], nx = b.st[1];
        if (nloc == 0u) { xcd_barrier_complete(bar, b.x, nloc, nx); b.st[0] = nloc; b.st[1] = nx; }
        const unsigned old = xb_add(&bar[XB_XSUB(b.x)], 1u);
        const unsigned gen = old / nloc;
        if (old + 1u == (gen + 1u) * nloc) {
            __builtin_amdgcn_fence(__ATOMIC_RELEASE, "agent");
            asm volatile("s_waitcnt vmcnt(0)" ::: "memory");
            const unsigned og = xb_add(&bar[XB_TOP], 1u);
            const unsigned tg = og / nx;
            if (og + 1u == (tg + 1u) * nx) xb_add(&bar[XB_TOPGEN], 1u);
            else XB_SPIN(xb_ld(&bar[XB_TOPGEN]) == tg, bar);
            __builtin_amdgcn_fence(__ATOMIC_ACQUIRE, "agent");
            xb_add(&bar[XB_XGEN(b.x)], 1u);
            asm volatile("s_waitcnt vmcnt(0)" ::: "memory");
        } else {
            XB_SPIN(xb_ld(&bar[XB_XGEN(b.x)]) == gen, bar);
            __builtin_amdgcn_fence(__ATOMIC_ACQUIRE, "agent");
            asm volatile("s_waitcnt vmcnt(0)" ::: "memory");
        }
    }
    __syncthreads();
}


typedef unsigned short bf16_t;
typedef float f32x4 __attribute__((ext_vector_type(4)));
typedef unsigned u32x2 __attribute__((ext_vector_type(2)));
typedef unsigned u32x4 __attribute__((ext_vector_type(4)));
constexpr int TP = 32768, TS = 1024, T = 33792, D = 1024, FF = 2816, NGU = 5632, PSTR = 3104, NPIN = 3328;
constexpr int PQ = 0, PK = 384, PV = 768, PZA = 1152, PZB = 1536, PXBC = 1920, PGC = 2560, PXC = 2816, PBA = 3072, PAA = 3078, PDT = 3084;
constexpr size_t SZ_WGU = (size_t)NGU * D * 2, SZ_WDN = (size_t)D * FF * 2, SZ_WIN = (size_t)NPIN * D * 2, SZ_WOUT = (size_t)D * D * 2;
constexpr size_t WS_CTL = 0, WS_WGU = 65536, WS_WDN = WS_WGU + 4 * SZ_WGU, WS_WIN = WS_WDN + 4 * SZ_WDN, WS_WOUT = WS_WIN + 2 * SZ_WIN,
                 WS_H = WS_WOUT + 2 * SZ_WOUT, WS_P = WS_H + (size_t)T * D * 2, WS_M = WS_P + (size_t)T * PSTR * 2;
constexpr size_t WS_END = WS_M + (size_t)160 * 1024 * 1024;
constexpr size_t O_PDS = (size_t)T * D, O_PDC = O_PDS + 2 * 2 * 6 * 4096, O_PSH = O_PDC + 2 * 2 * 3 * 1152, O_PSC = O_PSH + 2 * 2 * 6 * 4096, O_PLH = O_PSC + 2 * 2 * 3 * 640,
                 O_PLC = O_PLH + 2 * 2 * 256, O_SDS = O_PLC + 2 * 2 * 3 * 256, O_SDC = O_SDS + 2 * 16 * 6 * 4096, O_SSH = O_SDC + 2 * 16 * 3 * 1152, O_SSC = O_SSH + 2 * 16 * 6 * 4096,
                 O_SLH = O_SSC + 2 * 16 * 3 * 640, O_SLC = O_SLH + 2 * 16 * 256, O_END = O_SLC + 2 * 16 * 3 * 256;
constexpr int LDS_BYTES = 148 * 1024;
constexpr int MISC_OFF = 144 * 1024;

__device__ __forceinline__ int tidx() { int t = threadIdx.x; asm volatile("" : "+v"(t)); return t; }
struct Args { const float* in[37]; float* out; unsigned char* ws; int ph_lo, ph_hi; };
typedef __attribute__((address_space(4))) Args CArgs;
#define INP(a, k) ((a).in[k])
#define OUTP(a) ((a).out)
#define WSP(a) ((a).ws)

__device__ __forceinline__ float bf2f(bf16_t b) { return __uint_as_float(((unsigned)b) << 16); }
__device__ __forceinline__ bf16_t f2bf(float f) { unsigned u = __float_as_uint(f); u += 0x7FFFu + ((u >> 16) & 1u); return (bf16_t)(u >> 16); }
__device__ __forceinline__ unsigned pk_bf16(float lo, float hi) { return (unsigned)f2bf(lo) | ((unsigned)f2bf(hi) << 16); }
__device__ __forceinline__ float sigmoid_f(float x) { return __builtin_amdgcn_rcpf(1.0f + __expf(-x)); }
__device__ __forceinline__ float softplus_f(float x) { return fmaxf(x, 0.f) + log1pf(__expf(-fabsf(x))); }
__device__ __forceinline__ float siluf(float x) { return x * __builtin_amdgcn_rcpf(1.0f + __expf(-x)); }
__device__ __forceinline__ float gelu_tanh(float x) { const float u = 0.7978845608028654f * (x + 0.044715f * x * x * x); return 0.5f * x * (1.0f + tanhf(u)); }
__device__ __forceinline__ float one_minus_exp(float t) { const float p = -t * (1.0f + t * (0.5f + t * (0.16666667f + t * 0.041666668f))); return t > -0.03125f ? p : 1.0f - __expf(t); }
__device__ __forceinline__ float wave_sum(float v) {
#pragma unroll
    for (int o = 32; o >= 1; o >>= 1) v += __shfl_xor(v, o);
    return v; }
__device__ __forceinline__ float rdlane(float v, int l) { return __int_as_float(__builtin_amdgcn_readlane(__float_as_int(v), l)); }
__device__ __forceinline__ float* state_out(float* out, size_t base_p, size_t base_s, int l, int s, size_t sz) { return s < 2 ? out + base_p + ((size_t)l * 2 + s) * sz : out + base_s + ((size_t)l * 16 + (s - 2)) * sz; }
__device__ __forceinline__ int seq_len(int s) { return s < 2 ? 16384 : 64; }
__device__ __forceinline__ size_t seq_row0(int s) { return s < 2 ? (size_t)s * 16384 : (size_t)TP + (size_t)(s - 2) * 64; }

__device__ __forceinline__ int win_refcol(int c) {
    if (c < 1536) return c;
    if (c < 1920) return 1548 + (c - 1536);
    if (c < 2560) return 1932 + (c - 1920);
    if (c < 2816) return 2578 + (c - 2560);
    if (c < 3072) return 2834 + (c - 2816);
    if (c < 3078) return 1536 + (c - 3072);
    if (c < 3084) return 1542 + (c - 3078);
    if (c < 3090) return 2572 + (c - 3084);
    return -1; }
struct WTile { const float* src; const float* gain; bf16_t* dst; int K, ldw, rho0, k0, col; };
__device__ __forceinline__ void wprep_decode(const CArgs& a, int id, int tid, WTile& t) {
    constexpr int PER_LAYER = 1408 * 2 + 704 * 2 + 832 + 256;
    const int l = id / PER_LAYER; int r = id % PER_LAYER; int kind; const float* w0; const float* w1 = nullptr; t.gain = nullptr;
    if (r < 2816) { const int f = r / 1408; r %= 1408; kind = 0; t.K = D; t.ldw = FF; w0 = INP(a, f ? 33 : 9) + (size_t)l * D * FF; w1 = INP(a, f ? 34 : 10) + (size_t)l * D * FF; t.gain = INP(a, f ? 32 : 8) + (size_t)l * D; t.dst = (bf16_t*)(WSP(a) + WS_WGU + (size_t)(l * 2 + f) * SZ_WGU); }
    else if (r < 4224) { r -= 2816; const int f = r / 704; r %= 704; kind = 1; t.K = FF; t.ldw = D; w0 = INP(a, f ? 35 : 11) + (size_t)l * FF * D; t.dst = (bf16_t*)(WSP(a) + WS_WDN + (size_t)(l * 2 + f) * SZ_WDN); }
    else if (r < 5056) { r -= 4224; kind = 2; t.K = D; t.ldw = 3090; w0 = INP(a, 13) + (size_t)l * D * 3090; t.gain = INP(a, 12) + (size_t)l * D; t.dst = (bf16_t*)(WSP(a) + WS_WIN + (size_t)l * SZ_WIN); }
    else { r -= 5056; kind = 1; t.K = D; t.ldw = D; w0 = INP(a, 31) + (size_t)l * D * D; t.dst = (bf16_t*)(WSP(a) + WS_WOUT + (size_t)l * SZ_WOUT); }
    const int ktiles = t.K / 64; t.rho0 = (r / ktiles) * 64; t.k0 = (r % ktiles) * 64;
    const int rho = t.rho0 + (tid & 63); t.src = w0; t.col = rho;
    if (kind == 0) { const int U = rho >> 8, uu = (rho >> 7) & 1, i = rho & 127; t.src = uu ? w1 : w0; t.col = 128 * U + i; }
    else if (kind == 2) t.col = win_refcol(rho);
}
__device__ __forceinline__ void wprep_load(const WTile& t, int tid, float (&v)[8]) {
    const int kk0 = tid >> 6;
#pragma unroll
    for (int j = 0; j < 8; ++j) { const int kk = kk0 + 8 * j; v[j] = t.col >= 0 ? t.src[(size_t)(t.k0 + kk) * t.ldw + t.col] * (t.gain ? t.gain[t.k0 + kk] : 1.0f) : 0.f; }
}
__device__ void wprep_phase(const CArgs& a, LAS unsigned char* lds) {
    LAS float* tile = (LAS float*)lds;
    const int tid = tidx(); constexpr int NT = 2 * (1408 * 2 + 704 * 2 + 832 + 256);
    int id = blockIdx.x; if (id >= NT) return;
    WTile cur, nxt; float v[8];
    wprep_decode(a, id, tid, cur); wprep_load(cur, tid, v);
    for (; id < NT; id += gridDim.x) {
        {   const int rr = tid & 63, kk0 = tid >> 6;
#pragma unroll
            for (int j = 0; j < 8; ++j) tile[(kk0 + 8 * j) * 65 + rr] = v[j]; }
        __syncthreads();
        const bool more = id + (int)gridDim.x < NT;
        if (more) { wprep_decode(a, id + gridDim.x, tid, nxt); wprep_load(nxt, tid, v); }
        {   const int rr = tid >> 3, ks = tid & 7; float o[8];
#pragma unroll
            for (int e = 0; e < 8; ++e) o[e] = tile[(ks * 8 + e) * 65 + rr];
            u32x4 w; w.x = pk_bf16(o[0], o[1]); w.y = pk_bf16(o[2], o[3]); w.z = pk_bf16(o[4], o[5]); w.w = pk_bf16(o[6], o[7]);
            *(u32x4*)(cur.dst + (size_t)(cur.rho0 + rr) * cur.K + cur.k0 + ks * 8) = w; }
        __syncthreads();
        cur = nxt;
    }
}

constexpr int XSPLIT = T / 2;
constexpr size_t WS_RS = WS_M + (size_t)70 * 1024 * 1024;
__device__ void norm_phase(const CArgs& a, const float* gain, int mode) {
    float* Y = OUTP(a); bf16_t* XB = (bf16_t*)OUTP(a); float* RS = (float*)(WSP(a) + WS_RS); const bf16_t* XF = (const bf16_t*)(WSP(a) + WS_H);
    const int lane = tidx() & 63, gw = blockIdx.x * 8 + (tidx() >> 6), nw = gridDim.x * 8;
    f32x4 g[4];
#pragma unroll
    for (int j = 0; j < 4; ++j) g[j] = mode == 2 ? *(const f32x4*)(gain + j * 256 + lane * 4) : (f32x4){1.f, 1.f, 1.f, 1.f};
    for (int row0 = gw; row0 < T; row0 += 2 * nw) {
        f32x4 v[2][4]; float ss[2] = {0.f, 0.f};
#pragma unroll
        for (int q = 0; q < 2; ++q) { const int row = row0 + q * nw; if (row < T) {
            if (mode == 0) { const float* src = row < TP ? INP(a, 0) + (size_t)row * D : INP(a, 1) + (size_t)(row - TP) * D;
#pragma unroll
                for (int j = 0; j < 4; ++j) v[q][j] = *(const f32x4*)(src + j * 256 + lane * 4); }
            else {
#pragma unroll
                for (int j = 0; j < 4; ++j) { const u32x2 x = *(const u32x2*)(XF + (size_t)row * D + j * 256 + lane * 4);
                    v[q][j] = (f32x4){__uint_as_float(x.x << 16), __uint_as_float(x.x & 0xffff0000u), __uint_as_float(x.y << 16), __uint_as_float(x.y & 0xffff0000u)}; } } } }
#pragma unroll
        for (int q = 0; q < 2; ++q) { const int row = row0 + q * nw; if (row < T) {
#pragma unroll
            for (int j = 0; j < 4; ++j) ss[q] += v[q][j][0] * v[q][j][0] + v[q][j][1] * v[q][j][1] + v[q][j][2] * v[q][j][2] + v[q][j][3] * v[q][j][3];
            ss[q] = wave_sum(ss[q]);
            if (mode == 0) { if (lane < 16) RS[(size_t)lane * T + row] = lane == 0 ? ss[q] : 0.f; }
            const float r = rsqrtf(ss[q] * (1.0f / D) + 1e-6f);
#pragma unroll
            for (int j = 0; j < 4; ++j) {
                if (mode == 0) { u32x2 w; w.x = pk_bf16(v[q][j][0], v[q][j][1]); w.y = pk_bf16(v[q][j][2], v[q][j][3]); *(u32x2*)(XB + (size_t)row * D + j * 256 + lane * 4) = w; }
                else *(f32x4*)(Y + (size_t)row * D + j * 256 + lane * 4) = v[q][j] * r * g[j];
            } } }
    }
}

constexpr size_t WS_SLAB = WS_M + (size_t)80 * 1024 * 1024;
template <int NSL> __device__ __forceinline__ void sample_reduce_phase(const CArgs& a, float scale, bool last, float* RS) {
    bf16_t* XB = (bf16_t*)OUTP(a); bf16_t* XO = last ? (bf16_t*)(WSP(a) + WS_H) : XB; const float* SL = (const float*)(WSP(a) + WS_SLAB);
    const int lane = tidx() & 63, gw = blockIdx.x * 8 + (tidx() >> 6);
    if (gw >= TS) return;
    const size_t row = (size_t)TP + gw; float ss = 0.f;
#pragma unroll
    for (int jh = 0; jh < 2; ++jh) { f32x4 v[2][NSL]; u32x2 xb[2];
#pragma unroll
        for (int jj = 0; jj < 2; ++jj) { const int c = (2 * jh + jj) * 256 + lane * 4; xb[jj] = *(const u32x2*)(XB + row * D + c);
#pragma unroll
            for (int k = 0; k < NSL; ++k) v[jj][k] = *(const f32x4*)(SL + ((size_t)k * TS + gw) * D + c); }
#pragma unroll
        for (int jj = 0; jj < 2; ++jj) { const int c = (2 * jh + jj) * 256 + lane * 4; f32x4 s = v[jj][0];
#pragma unroll
            for (int k = 1; k < NSL; ++k) s += v[jj][k];
            const f32x4 x = {__uint_as_float(xb[jj].x << 16), __uint_as_float(xb[jj].x & 0xffff0000u), __uint_as_float(xb[jj].y << 16), __uint_as_float(xb[jj].y & 0xffff0000u)};
            const f32x4 o = x + scale * s;
            { u32x2 w; w.x = pk_bf16(o[0], o[1]); w.y = pk_bf16(o[2], o[3]); *(u32x2*)(XO + row * D + c) = w;
                const float r0 = __uint_as_float(w.x << 16), r1 = __uint_as_float(w.x & 0xffff0000u), r2 = __uint_as_float(w.y << 16), r3 = __uint_as_float(w.y & 0xffff0000u);
                ss += r0 * r0 + r1 * r1 + r2 * r2 + r3 * r3; } } }
    ss = wave_sum(ss);
    if (lane < 16) RS[(size_t)lane * T + row] = lane == 0 ? ss : 0.f;
}

__device__ __forceinline__ float ldp(const bf16_t* P, size_t row, int col) { return bf2f(P[row * PSTR + col]); }

__device__ void naive_delta_chain(const CArgs& a, int l, int s, int h, int lane) {
    const bf16_t* P = (const bf16_t*)(WSP(a) + WS_P); bf16_t* MIX = (bf16_t*)(WSP(a) + WS_H);
    const int L = seq_len(s); const size_t row0 = seq_row0(s);
    float S[64]; float hq[3], hk[3], hv[3];
    if (s < 2) {
#pragma unroll
        for (int i = 0; i < 64; ++i) S[i] = 0.f;
#pragma unroll
        for (int j = 0; j < 3; ++j) { hq[j] = 0.f; hk[j] = 0.f; hv[j] = 0.f; }
    } else {
        const int sb = s - 2; const float* s0 = INP(a, 2) + (((size_t)l * 16 + sb) * 6 + h) * 4096;
#pragma unroll
        for (int i = 0; i < 64; ++i) S[i] = s0[i * 64 + lane];
        const float* cb = INP(a, 3) + ((size_t)l * 16 + sb) * 3 * 1152;
#pragma unroll
        for (int j = 0; j < 3; ++j) { hq[j] = cb[j * 1152 + PQ + h * 64 + lane]; hk[j] = cb[j * 1152 + PK + h * 64 + lane]; hv[j] = cb[j * 1152 + PV + h * 64 + lane]; }
    }
    const float* cw = INP(a, 14) + (size_t)l * 4 * 1152;
    float wq[4], wk[4], wv[4];
#pragma unroll
    for (int k = 0; k < 4; ++k) { wq[k] = cw[k * 1152 + PQ + h * 64 + lane]; wk[k] = cw[k * 1152 + PK + h * 64 + lane]; wv[k] = cw[k * 1152 + PV + h * 64 + lane]; }
    const float Aexp = __expf(INP(a, 15)[l * 6 + h]), dtb = INP(a, 16)[l * 6 + h], nw = INP(a, 17)[l * 64 + lane];
    float nq = ldp(P, row0, PQ + h * 64 + lane), nk = ldp(P, row0, PK + h * 64 + lane), nv = ldp(P, row0, PV + h * 64 + lane);
    float nb = ldp(P, row0, PBA + h), na = ldp(P, row0, PAA + h), nz = ldp(P, row0, PZA + h * 64 + lane);
    for (int t = 0; t < L; ++t) {
        const size_t row = row0 + t;
        const float xq = nq, xk = nk, xv = nv, xb = nb, xa = na, xz = nz;
        { const size_t rn = row0 + (t + 1 < L ? t + 1 : t);
          nq = ldp(P, rn, PQ + h * 64 + lane); nk = ldp(P, rn, PK + h * 64 + lane); nv = ldp(P, rn, PV + h * 64 + lane);
          nb = ldp(P, rn, PBA + h); na = ldp(P, rn, PAA + h); nz = ldp(P, rn, PZA + h * 64 + lane); }
        float q = siluf(wq[0] * hq[0] + wq[1] * hq[1] + wq[2] * hq[2] + wq[3] * xq);
        float k = siluf(wk[0] * hk[0] + wk[1] * hk[1] + wk[2] * hk[2] + wk[3] * xk);
        const float v = siluf(wv[0] * hv[0] + wv[1] * hv[1] + wv[2] * hv[2] + wv[3] * xv);
        hq[0] = hq[1]; hq[1] = hq[2]; hq[2] = xq; hk[0] = hk[1]; hk[1] = hk[2]; hk[2] = xk; hv[0] = hv[1]; hv[1] = hv[2]; hv[2] = xv;
        q *= rsqrtf(wave_sum(q * q) + 1e-6f) * 0.125f;
        k *= rsqrtf(wave_sum(k * k) + 1e-6f);
        const float beta = sigmoid_f(xb), alpha = __expf(-Aexp * softplus_f(xa + dtb));
        float kS = 0.f;
#pragma unroll
        for (int i = 0; i < 64; ++i) kS += rdlane(k, i) * S[i];
        const float dl = beta * (v - alpha * kS);
        float o = 0.f;
#pragma unroll
        for (int i = 0; i < 64; ++i) { S[i] = alpha * S[i] + rdlane(k, i) * dl; o += rdlane(q, i) * S[i]; }
        const float ms = wave_sum(o * o) * (1.0f / 64.f);
        MIX[row * D + h * 64 + lane] = f2bf(o * rsqrtf(ms + 1e-6f) * nw * siluf(xz));
    }
    float* so = state_out(OUTP(a), O_PDS, O_SDS, l, s, 6 * 4096) + (size_t)h * 4096;
#pragma unroll
    for (int i = 0; i < 64; ++i) so[i * 64 + lane] = S[i];
    float* co = state_out(OUTP(a), O_PDC, O_SDC, l, s, 3 * 1152);
#pragma unroll
    for (int j = 0; j < 3; ++j) { co[j * 1152 + PQ + h * 64 + lane] = hq[j]; co[j * 1152 + PK + h * 64 + lane] = hk[j]; co[j * 1152 + PV + h * 64 + lane] = hv[j]; }
}

__device__ void naive_ssd_block(const CArgs& a, int l, int s, int g, LAS float* red) {
    const bf16_t* P = (const bf16_t*)(WSP(a) + WS_P); bf16_t* MIX = (bf16_t*)(WSP(a) + WS_H);
    const int tid = tidx(), hh = tid >> 6, p = tid & 63, head = g * 3 + (hh < 3 ? hh : 0); const bool act = tid < 192;
    const int L = seq_len(s); const size_t row0 = seq_row0(s);
    const int cx = head * 64 + p, cB = 384 + g * 64 + p, cC = 512 + g * 64 + p;
    float hst[64]; float hx[3], hB[3], hC[3];
    if (s < 2 || !act) {
#pragma unroll
        for (int i = 0; i < 64; ++i) hst[i] = 0.f;
#pragma unroll
        for (int j = 0; j < 3; ++j) { hx[j] = 0.f; hB[j] = 0.f; hC[j] = 0.f; }
    } else {
        const int sb = s - 2; const float* s0 = INP(a, 4) + (((size_t)l * 16 + sb) * 6 + head) * 4096;
#pragma unroll
        for (int i = 0; i < 64; ++i) hst[i] = s0[i * 64 + p];
        const float* cb = INP(a, 5) + ((size_t)l * 16 + sb) * 3 * 640;
#pragma unroll
        for (int j = 0; j < 3; ++j) { hx[j] = cb[j * 640 + cx]; hB[j] = cb[j * 640 + cB]; hC[j] = cb[j * 640 + cC]; }
    }
    const float* cw = INP(a, 18) + (size_t)l * 4 * 640; const float* cbias = INP(a, 19) + (size_t)l * 640;
    float wx[4], wB[4], wC[4];
#pragma unroll
    for (int k = 0; k < 4; ++k) { wx[k] = cw[k * 640 + cx]; wB[k] = cw[k * 640 + cB]; wC[k] = cw[k * 640 + cC]; }
    const float bx = cbias[cx], bB = cbias[cB], bC = cbias[cC];
    const float Aneg = -__expf(INP(a, 20)[l * 6 + head]), dtb = INP(a, 21)[l * 6 + head], dsk = INP(a, 22)[l * 6 + head], nw = INP(a, 23)[l * 384 + g * 192 + (hh < 3 ? hh : 0) * 64 + p];
    for (int t = 0; t < L; ++t) {
        const size_t row = row0 + t;
        float y = 0.f, xs = 0.f;
        if (act) {
            const float rx = ldp(P, row, PXBC + cx), rB = ldp(P, row, PXBC + cB), rC = ldp(P, row, PXBC + cC);
            xs = siluf(wx[0] * hx[0] + wx[1] * hx[1] + wx[2] * hx[2] + wx[3] * rx + bx);
            const float Bn = siluf(wB[0] * hB[0] + wB[1] * hB[1] + wB[2] * hB[2] + wB[3] * rB + bB);
            const float Cn = siluf(wC[0] * hC[0] + wC[1] * hC[1] + wC[2] * hC[2] + wC[3] * rC + bC);
            hx[0] = hx[1]; hx[1] = hx[2]; hx[2] = rx; hB[0] = hB[1]; hB[1] = hB[2]; hB[2] = rB; hC[0] = hC[1]; hC[1] = hC[2]; hC[2] = rC;
            const float dt = softplus_f(ldp(P, row, PDT + head) + dtb), dA = __expf(dt * Aneg), dx = dt * xs;
#pragma unroll
            for (int i = 0; i < 64; ++i) { hst[i] = dA * hst[i] + rdlane(Bn, i) * dx; y += rdlane(Cn, i) * hst[i]; }
            y += dsk * xs;
            y *= siluf(ldp(P, row, PZB + head * 64 + p));
            const float sq = wave_sum(y * y);
            if (p == 0) red[hh] = sq;
        }
        __syncthreads();
        if (act) {
            const float ms = (red[0] + red[1] + red[2]) * (1.0f / 192.f);
            MIX[row * D + 384 + g * 192 + hh * 64 + p] = f2bf(y * rsqrtf(ms + 1e-6f) * nw);
        }
        __syncthreads();
    }
    if (act) {
        float* so = state_out(OUTP(a), O_PSH, O_SSH, l, s, 6 * 4096) + (size_t)head * 4096;
#pragma unroll
        for (int i = 0; i < 64; ++i) so[i * 64 + p] = hst[i];
        float* co = state_out(OUTP(a), O_PSC, O_SSC, l, s, 3 * 640);
#pragma unroll
        for (int j = 0; j < 3; ++j) { co[j * 640 + cx] = hx[j]; if (hh == 0) { co[j * 640 + cB] = hB[j]; co[j * 640 + cC] = hC[j]; } }
    }
}

__device__ void naive_lru_block(const CArgs& a, int l, int s, LAS float* xsh) {
    const bf16_t* P = (const bf16_t*)(WSP(a) + WS_P); bf16_t* MIX = (bf16_t*)(WSP(a) + WS_H);
    const int tid = tidx(), ch = tid & 255; const bool act = tid < 256;
    const int L = seq_len(s); const size_t row0 = seq_row0(s);
    float hx[3] = {0.f, 0.f, 0.f}, h = 0.f;
    if (s >= 2) { const int sb = s - 2; h = INP(a, 6)[((size_t)l * 16 + sb) * 256 + ch]; const float* cb = INP(a, 7) + ((size_t)l * 16 + sb) * 3 * 256;
#pragma unroll
        for (int j = 0; j < 3; ++j) hx[j] = cb[j * 256 + ch]; }
    const float* cw = INP(a, 24) + (size_t)l * 4 * 256; float w[4];
#pragma unroll
    for (int k = 0; k < 4; ++k) w[k] = cw[k * 256 + ch];
    const float cb0 = INP(a, 25)[l * 256 + ch], br = INP(a, 27)[l * 256 + ch], bi = INP(a, 29)[l * 256 + ch];
    const float spl = softplus_f(-INP(a, 30)[l * 256 + ch]);
    const int blk = ch >> 5, d = ch & 31;
    const float* wr = INP(a, 26) + ((size_t)l * 8 + blk) * 1024 + d; const float* wi = INP(a, 28) + ((size_t)l * 8 + blk) * 1024 + d;
    for (int t = 0; t < L; ++t) {
        const size_t row = row0 + t; float xc = 0.f;
        if (act) { const float rx = ldp(P, row, PXC + ch); xc = w[0] * hx[0] + w[1] * hx[1] + w[2] * hx[2] + w[3] * rx + cb0; hx[0] = hx[1]; hx[1] = hx[2]; hx[2] = rx; xsh[ch] = xc; }
        __syncthreads();
        if (act) {
            float r = br, ig = bi;
#pragma unroll 8
            for (int c = 0; c < 32; ++c) { const float xv = xsh[blk * 32 + c]; r += xv * wr[c * 32]; ig += xv * wi[c * 32]; }
            const float log_a = -8.0f * sigmoid_f(r) * spl, av = __expf(log_a), bv = sqrtf(-expm1f(2.0f * log_a)) * (sigmoid_f(ig) * xc);
            h = av * h + bv;
            MIX[row * D + 768 + ch] = f2bf(h * gelu_tanh(ldp(P, row, PGC + ch)));
        }
        __syncthreads();
    }
    if (act) {
        state_out(OUTP(a), O_PLH, O_SLH, l, s, 256)[ch] = h;
        float* co = state_out(OUTP(a), O_PLC, O_SLC, l, s, 3 * 256);
#pragma unroll
        for (int j = 0; j < 3; ++j) co[j * 256 + ch] = hx[j];
    }
}

__device__ void naive_mixer_phase(const CArgs& a, int l, LAS unsigned char* lds) {
    const int b = blockIdx.x, tid = tidx();
    if (b < 108) { if (tid < 64) naive_delta_chain(a, l, b / 6, b % 6, tid); }
    else if (b < 144) { const int u = b - 108; naive_ssd_block(a, l, u / 2, u % 2, (LAS float*)lds); }
    else if (b < 162) naive_lru_block(a, l, b - 144, (LAS float*)lds);
}

typedef short bf16x8 __attribute__((ext_vector_type(8)));
constexpr int NCH = 528, NDU = NCH * 6, LDT = 72;
constexpr size_t WS_DW = WS_H, WS_DQK = WS_H + (size_t)NDU * 8192;
constexpr size_t WS_DQD = WS_M, WS_DKD = WS_DQD + (size_t)NDU * 8192, WS_DU = WS_DKD + (size_t)NDU * 8192, WS_SH = WS_DU + (size_t)NDU * 16384,
                 WS_GTD = WS_SH + (size_t)NDU * 16384, WS_GTS = WS_GTD + 16384, WS_LA = WS_GTS + 16384, WS_LB = WS_LA + (size_t)NCH * 1024, WS_LA0 = WS_LB + (size_t)NCH * 1024, WS_LB0 = WS_LA0 + (size_t)NCH * 1024, WS_GP = WS_LB0 + (size_t)NCH * 1024, WS_HH = WS_GP + (size_t)192 * 8192, WS_SST = WS_HH + (size_t)192 * 16384, WS_MEND = WS_SST + (size_t)192 * 16384;
static_assert(WS_MEND <= WS_END && WS_RS >= WS_DU && WS_RS + (size_t)16 * T * 4 <= WS_SH, "mixer workspace");
static_assert(WS_DQK + (size_t)NDU * 8192 <= WS_P, "DW/DQK must fit the H region");

__device__ __forceinline__ int kinv(int k) { return (k & 32) | ((k & 12) << 1) | ((k & 16) >> 2) | (k & 3); }
__device__ __forceinline__ unsigned cvtpk(float lo, float hi) { unsigned r; asm volatile("v_cvt_pk_bf16_f32 %0, %1, %2" : "=v"(r) : "v"(lo), "v"(hi)); return r; }
__device__ __forceinline__ bf16x8 pack8(const f32x4& x, const f32x4& y) { u32x4 w; w.x = cvtpk(x[0], x[1]); w.y = cvtpk(x[2], x[3]); w.z = cvtpk(y[0], y[1]); w.w = cvtpk(y[2], y[3]); return __builtin_bit_cast(bf16x8, w); }
__device__ __forceinline__ f32x4 mfma16(const bf16x8& a, const bf16x8& b, const f32x4& c) { return __builtin_amdgcn_mfma_f32_16x16x32_bf16(a, b, c, 0, 0, 0); }
__device__ __forceinline__ bf16x8 ldfrag(const LAS bf16_t* tile, int row, int s, int fq) { return *(const LAS bf16x8*)(tile + row * LDT + 32 * s + 8 * fq); }
__device__ __forceinline__ void chunk_seq(int c, int& s, bool& first) { if (c < 256) { s = 0; first = c == 0; } else if (c < 512) { s = 1; first = c == 256; } else { s = 2 + (c - 512); first = true; } }
__device__ __forceinline__ float wave_scan_incl(float v, int lane) {
#pragma unroll
    for (int o = 1; o < 64; o <<= 1) { const float t = __shfl_up(v, o); if (lane >= o) v += t; }
    return v; }
template <int NSEG> struct StageRegs { static constexpr int PPR = NSEG * 8, TOTAL = 67 * PPR, NP = (TOTAL + 511) / 512; u32x4 w[NP]; };
template <int NSEG> __device__ __forceinline__ void stage_load(StageRegs<NSEG>& R, const bf16_t* P, int c, int c0, int c1, int c2, int c3, const float* st, int CS, int stbase, bool first) {
    constexpr int PPR = StageRegs<NSEG>::PPR, TOTAL = StageRegs<NSEG>::TOTAL, NP = StageRegs<NSEG>::NP;
    const int tid = tidx();
#pragma unroll
    for (int k = 0; k < NP; ++k) { const int idx = tid + 512 * k < TOTAL ? tid + 512 * k : TOTAL - 1;
        const int r = idx / PPR, pc = idx - r * PPR, seg = pc >> 3, col = (seg == 0 ? c0 : (seg == 1 ? c1 : (seg == 2 ? c2 : c3))) + (pc & 7) * 8, rr = (r >= 3 || !first) ? r : 3;
        R.w[k] = *(const u32x4*)(P + ((size_t)c * 64 + rr - 3) * PSTR + col); }
    if (first) {
#pragma unroll
        for (int k = 0; k < NP; ++k) { const int idx = tid + 512 * k < TOTAL ? tid + 512 * k : TOTAL - 1;
            const int r = idx / PPR, pc = idx - r * PPR, seg = pc >> 3, col = (seg == 0 ? c0 : (seg == 1 ? c1 : (seg == 2 ? c2 : c3))) + (pc & 7) * 8;
            if (r < 3) {
                if (st) { const float* sp = st + r * CS + (col - stbase); R.w[k].x = pk_bf16(sp[0], sp[1]); R.w[k].y = pk_bf16(sp[2], sp[3]); R.w[k].z = pk_bf16(sp[4], sp[5]); R.w[k].w = pk_bf16(sp[6], sp[7]); }
                else { R.w[k].x = 0u; R.w[k].y = 0u; R.w[k].z = 0u; R.w[k].w = 0u; } } }
    }
}
template <int NSEG> __device__ __forceinline__ void stage_store(LAS bf16_t* dst, const StageRegs<NSEG>& R) {
    constexpr int PPR = StageRegs<NSEG>::PPR, TOTAL = StageRegs<NSEG>::TOTAL, NP = StageRegs<NSEG>::NP;
    const int tid = tidx();
#pragma unroll
    for (int k = 0; k < NP; ++k) { const int idx = tid + 512 * k;
        if (idx < TOTAL) { const int r = idx / PPR, pc = idx - r * PPR; *(LAS u32x4*)(dst + r * (NSEG * 64) + pc * 8) = R.w[k]; } }
}
template <int NSEG> __device__ __forceinline__ void stage_raw_n(LAS bf16_t* dst, const bf16_t* P, int c, int c0, int c1, int c2, int c3, const float* st, int CS, int stbase, bool first) {
    StageRegs<NSEG> R; stage_load<NSEG>(R, P, c, c0, c1, c2, c3, st, CS, stbase, first); stage_store<NSEG>(dst, R);
}
__device__ __forceinline__ f32x4 mfma4(float a, float b, const f32x4& c) { return __builtin_amdgcn_mfma_f32_16x16x4f32(a, b, c, 0, 0, 0); }

__device__ __forceinline__ void m1_delta_prefetch(const CArgs& a, int l, int c, int h, StageRegs<3>& R, float& xb_, float& xa_) {
    const bf16_t* P = (const bf16_t*)(WSP(a) + WS_P); int s; bool first; chunk_seq(c, s, first);
    if ((tidx() >> 6) == 0) { const size_t row = (size_t)c * 64 + (tidx() & 63); xb_ = ldp(P, row, PBA + h); xa_ = ldp(P, row, PAA + h); }
    stage_load<3>(R, P, c, PQ + h * 64, PK + h * 64, PV + h * 64, 0, (first && s >= 2) ? INP(a, 3) + ((size_t)l * 16 + (s - 2)) * 3 * 1152 : nullptr, 1152, 0, first);
}
__device__ __forceinline__ void m1_delta_unit(const CArgs& a, int l, int c, int h, LAS unsigned char* lds, StageRegs<3>& R, float& xb_, float& xa_, int cn, int hn, bool has_next) {
    const int tid = tidx(), lane = tid & 63, wid = __builtin_amdgcn_readfirstlane(tid >> 6), fr = lane & 15, fq = lane >> 4;
    const bf16_t* P = (const bf16_t*)(WSP(a) + WS_P);
    LAS bf16_t* RAW = (LAS bf16_t*)lds;
    LAS bf16_t* OUTT = (LAS bf16_t*)lds;
    LAS float* QF = (LAS float*)(lds + 36864);
    LAS float* AT = QF;
    LAS float* KF = (LAS float*)(lds + 36864 + 17408);
    LAS float* VF = KF + 4096;
    LAS bf16_t* KN = (LAS bf16_t*)(VF + 4096);
    LAS bf16_t* QN = KN + 64 * LDT;
    LAS float* SM = (LAS float*)(QN + 64 * LDT);
    int s; bool first; chunk_seq(c, s, first);
    const int u = c * 6 + h;
    stage_store<3>(RAW, R);
    if (wid == 0) {
        const float beta = sigmoid_f(xb_);
        const float la = -__expf(INP(a, 15)[l * 6 + h]) * softplus_f(xa_ + INP(a, 16)[l * 6 + h]);
        SM[lane] = wave_scan_incl(la, lane); SM[64 + lane] = beta;
    }
    float w0 = 0.f, w1 = 0.f, w2 = 0.f, w3 = 0.f;
    if (tid < 384) { const int ch = tid % 192, seg = ch >> 6, cc = ch & 63; const float* cw = INP(a, 14) + (size_t)l * 4 * 1152 + seg * 384 + h * 64 + cc; w0 = cw[0]; w1 = cw[1152]; w2 = cw[2304]; w3 = cw[3456]; }
    __syncthreads();
    if (has_next) m1_delta_prefetch(a, l, cn, hn, R, xb_, xa_);
    if (tid < 384) {
        const int ch = tid % 192, par = tid / 192, seg = ch >> 6, cc = ch & 63;
        LAS float* dst = seg == 0 ? QF : (seg == 1 ? KF : VF);
        float x0 = bf2f(RAW[(par * 32) * 192 + ch]), x1 = bf2f(RAW[(par * 32 + 1) * 192 + ch]), x2 = bf2f(RAW[(par * 32 + 2) * 192 + ch]);
#pragma unroll 8
        for (int j = 0; j < 32; ++j) { const int i = par * 32 + j; const float x3 = bf2f(RAW[(i + 3) * 192 + ch]);
            dst[i * 64 + cc] = siluf(w0 * x0 + w1 * x1 + w2 * x2 + w3 * x3); x0 = x1; x1 = x2; x2 = x3; }
    }
    __syncthreads();
    {   const int i = tid >> 3, part = tid & 7; float q[8], k[8], sq = 0.f, sk = 0.f;
        {   const f32x4 qa = *(const LAS f32x4*)(QF + i * 64 + part * 8), qb = *(const LAS f32x4*)(QF + i * 64 + part * 8 + 4), ka = *(const LAS f32x4*)(KF + i * 64 + part * 8), kb = *(const LAS f32x4*)(KF + i * 64 + part * 8 + 4);
#pragma unroll
            for (int e = 0; e < 4; ++e) { q[e] = qa[e]; q[4 + e] = qb[e]; k[e] = ka[e]; k[4 + e] = kb[e]; } }
#pragma unroll
        for (int e = 0; e < 8; ++e) { sq += q[e] * q[e]; sk += k[e] * k[e]; }
        sq += __shfl_xor(sq, 1); sq += __shfl_xor(sq, 2); sq += __shfl_xor(sq, 4);
        sk += __shfl_xor(sk, 1); sk += __shfl_xor(sk, 2); sk += __shfl_xor(sk, 4);
        const float rq = rsqrtf(sq + 1e-6f) * 0.125f, rk = rsqrtf(sk + 1e-6f);
#pragma unroll
        for (int e = 0; e < 8; ++e) { q[e] *= rq; k[e] *= rk; }
        *(LAS f32x4*)(KF + i * 64 + part * 8) = (f32x4){k[0], k[1], k[2], k[3]}; *(LAS f32x4*)(KF + i * 64 + part * 8 + 4) = (f32x4){k[4], k[5], k[6], k[7]};
        u32x4 wq, wk; wq.x = cvtpk(q[0], q[1]); wq.y = cvtpk(q[2], q[3]); wq.z = cvtpk(q[4], q[5]); wq.w = cvtpk(q[6], q[7]);
        wk.x = cvtpk(k[0], k[1]); wk.y = cvtpk(k[2], k[3]); wk.z = cvtpk(k[4], k[5]); wk.w = cvtpk(k[6], k[7]);
        *(LAS u32x4*)(QN + i * LDT + part * 8) = wq; *(LAS u32x4*)(KN + i * LDT + part * 8) = wk; }
    __syncthreads();
    {
        const int mb = wid & 3, which = wid >> 2; const LAS bf16_t* Asrc = which ? QN : KN;
        const bf16x8 a0 = ldfrag(Asrc, 16 * mb + fr, 0, fq), a1 = ldfrag(Asrc, 16 * mb + fr, 1, fq);
        float gi[4], bi[4];
#pragma unroll
        for (int r = 0; r < 4; ++r) { gi[r] = SM[16 * mb + 4 * fq + r]; bi[r] = SM[64 + 16 * mb + 4 * fq + r]; }
#pragma unroll
        for (int nb = 0; nb < 4; ++nb) {
            const bf16x8 b0 = ldfrag(KN, 16 * nb + fr, 0, fq), b1 = ldfrag(KN, 16 * nb + fr, 1, fq);
            f32x4 acc = {0.f, 0.f, 0.f, 0.f}; acc = mfma16(a0, b0, acc); acc = mfma16(a1, b1, acc);
            const int j = 16 * nb + fr; const float gj = SM[j];
            if (which == 0) { f32x4 o;
#pragma unroll
                for (int r = 0; r < 4; ++r) { const int i = 16 * mb + 4 * fq + r; o[r] = i > j ? bi[r] * acc[r] * __expf(gi[r] - gj) : 0.f; }
                *(LAS f32x4*)(AT + j * 68 + 16 * mb + 4 * fq) = o;
            } else {
#pragma unroll
                for (int r = 0; r < 4; ++r) { const int i = 16 * mb + 4 * fq + r; OUTT[1 * 64 * LDT + i * LDT + kinv(j)] = f2bf(i >= j ? acc[r] * __expf(gi[r] - gj) : 0.f); }
            }
        }
    }
    __syncthreads();
    LAS float* TB = SM + 128;
    if (wid < 4 && lane < 16) {
        float x[16];
#pragma unroll
        for (int i = 0; i < 16; ++i) x[i] = i == lane ? 1.f : 0.f;
#pragma unroll
        for (int j = 0; j < 15; ++j) { const float xj = x[j];
#pragma unroll
            for (int i4 = ((j + 1) & ~3); i4 < 16; i4 += 4) { const f32x4 av = *(const LAS f32x4*)(AT + (16 * wid + j) * 68 + 16 * wid + i4);
#pragma unroll
                for (int e = 0; e < 4; ++e) if (i4 + e > j) x[i4 + e] -= av[e] * xj; } }
#pragma unroll
        for (int i = 0; i < 16; ++i) TB[wid * 272 + i * 17 + lane] = x[i];
    }
    {   const float glast = SM[63];
        for (int idx = tid; idx < 1024; idx += 512) {
            const int d4 = (idx & 15) * 4, i = idx >> 4; const float eg = __expf(SM[i]);
            const u32x2 qv = *(const LAS u32x2*)(QN + i * LDT + d4);
            u32x2 w; w.x = cvtpk(__uint_as_float(qv.x << 16) * eg, __uint_as_float(qv.x & 0xffff0000u) * eg); w.y = cvtpk(__uint_as_float(qv.y << 16) * eg, __uint_as_float(qv.y & 0xffff0000u) * eg);
            *(LAS u32x2*)(OUTT + 2 * 64 * LDT + i * LDT + kinv(d4)) = w; }
        for (int idx = tid; idx < 1024; idx += 512) {
            const int m = idx & 63, j4 = (idx >> 6) * 4; float v[4];
#pragma unroll
            for (int e = 0; e < 4; ++e) v[e] = KF[(j4 + e) * 64 + m] * __expf(glast - SM[j4 + e]);
            u32x2 w; w.x = cvtpk(v[0], v[1]); w.y = cvtpk(v[2], v[3]);
            *(LAS u32x2*)(OUTT + 3 * 64 * LDT + m * LDT + kinv(j4)) = w; } }
    __syncthreads();
    {
        const int ct = wid & 3, isw = wid >> 2; f32x4 X[4];
#pragma unroll
        for (int b = 0; b < 4; ++b) { f32x4 acc;
#pragma unroll
            for (int r = 0; r < 4; ++r) { const int i = 16 * b + 4 * fq + r; acc[r] = isw ? SM[64 + i] * __expf(SM[i]) * KF[i * 64 + 16 * ct + fr] : SM[64 + i] * VF[i * 64 + 16 * ct + fr]; }
#pragma unroll
            for (int bp = 0; bp < 4; ++bp) if (bp < b) {
#pragma unroll
                for (int r = 0; r < 4; ++r) acc = mfma4(-AT[(16 * bp + 4 * fq + r) * 68 + 16 * b + fr], X[bp][r], acc); }
            f32x4 xb = {0.f, 0.f, 0.f, 0.f};
#pragma unroll
            for (int r = 0; r < 4; ++r) xb = mfma4(TB[b * 272 + fr * 17 + 4 * fq + r], acc[r], xb);
            X[b] = xb; }
        if (isw == 0) { float* U = (float*)(WSP(a) + WS_DU) + (size_t)u * 4096;
#pragma unroll
            for (int b = 0; b < 4; ++b)
#pragma unroll
                for (int r = 0; r < 4; ++r) U[(16 * b + 4 * fq + r) * 64 + 16 * ct + fr] = X[b][r];
        } else { const int kp = kinv(16 * ct + fr);
#pragma unroll
            for (int b = 0; b < 4; ++b)
#pragma unroll
                for (int r = 0; r < 4; ++r) OUTT[(16 * b + 4 * fq + r) * LDT + kp] = f2bf(X[b][r]); }
    }
    __syncthreads();
    {   const int row = tid >> 3, c8 = tid & 7;
        bf16_t* g0 = (bf16_t*)(WSP(a) + WS_DW) + (size_t)u * 4096; bf16_t* g1 = (bf16_t*)(WSP(a) + WS_DQK) + (size_t)u * 4096;
        bf16_t* g2 = (bf16_t*)(WSP(a) + WS_DQD) + (size_t)u * 4096; bf16_t* g3 = (bf16_t*)(WSP(a) + WS_DKD) + (size_t)u * 4096;
        *(u32x4*)(g0 + tid * 8) = *(const LAS u32x4*)(OUTT + 0 * 64 * LDT + row * LDT + c8 * 8);
        *(u32x4*)(g1 + tid * 8) = *(const LAS u32x4*)(OUTT + 1 * 64 * LDT + row * LDT + c8 * 8);
        *(u32x4*)(g2 + tid * 8) = *(const LAS u32x4*)(OUTT + 2 * 64 * LDT + row * LDT + c8 * 8);
        *(u32x4*)(g3 + tid * 8) = *(const LAS u32x4*)(OUTT + 3 * 64 * LDT + row * LDT + c8 * 8);
        if (tid == 0) ((float*)(WSP(a) + WS_GTD))[u] = __expf(SM[63]); }
    __syncthreads();
}

__device__ __forceinline__ void m1_ssd_prefetch(const CArgs& a, int l, int c, int h, StageRegs<2>& R, float& xd_) {
    const bf16_t* P = (const bf16_t*)(WSP(a) + WS_P); int s; bool first; chunk_seq(c, s, first); const int g = h / 3;
    if ((tidx() >> 6) == 0) xd_ = ldp(P, (size_t)c * 64 + (tidx() & 63), PDT + h);
    stage_load<2>(R, P, c, PXBC + h * 64, PXBC + 384 + g * 64, 0, 0, (first && s >= 2) ? INP(a, 5) + ((size_t)l * 16 + (s - 2)) * 3 * 640 : nullptr, 640, PXBC, first);
}
__device__ __forceinline__ void m1_ssd_unit(const CArgs& a, int l, int c, int h, LAS unsigned char* lds, StageRegs<2>& R, float& xd_, int cn, int hn, bool has_next) {
    const int tid = tidx(), lane = tid & 63, wid = __builtin_amdgcn_readfirstlane(tid >> 6), fr = lane & 15, fq = lane >> 4, g = h / 3;
    const bf16_t* P = (const bf16_t*)(WSP(a) + WS_P);
    LAS bf16_t* RAW = (LAS bf16_t*)lds;
    LAS bf16_t* BDT = (LAS bf16_t*)(lds + 18432);
    LAS bf16_t* XT = BDT + 64 * LDT;
    LAS float* SM = (LAS float*)(XT + 64 * LDT);
    int s; bool first; chunk_seq(c, s, first);
    const int u = c * 6 + h;
    stage_store<2>(RAW, R);
    if (wid == 0) {
        const float dt = softplus_f(xd_ + INP(a, 21)[l * 6 + h]);
        SM[lane] = wave_scan_incl(-__expf(INP(a, 20)[l * 6 + h]) * dt, lane); SM[64 + lane] = dt;
    }
    const int ch = tid & 127, part = tid >> 7, wch = ch < 64 ? h * 64 + ch : 384 + g * 64 + (ch - 64);
    const float* cw = INP(a, 18) + (size_t)l * 4 * 640 + wch; const float w0 = cw[0], w1 = cw[640], w2 = cw[1280], w3 = cw[1920], bias = INP(a, 19)[l * 640 + wch];
    __syncthreads();
    if (has_next) m1_ssd_prefetch(a, l, cn, hn, R, xd_);
    {
        const float glast = SM[63];
        float x0 = bf2f(RAW[(part * 16) * 128 + ch]), x1 = bf2f(RAW[(part * 16 + 1) * 128 + ch]), x2 = bf2f(RAW[(part * 16 + 2) * 128 + ch]);
#pragma unroll 8
        for (int e = 0; e < 16; ++e) { const int j = part * 16 + e; const float x3 = bf2f(RAW[(j + 3) * 128 + ch]);
            const float y = siluf(w0 * x0 + w1 * x1 + w2 * x2 + w3 * x3 + bias); x0 = x1; x1 = x2; x2 = x3;
            if (ch < 64) XT[ch * LDT + j] = f2bf(y); else BDT[(ch - 64) * LDT + j] = f2bf(y * __expf(glast - SM[j]) * SM[64 + j]); } }
    __syncthreads();
    {   const int mb = wid & 3; float* SH = (float*)(WSP(a) + WS_SH) + (size_t)u * 4096;
        const bf16x8 a0 = ldfrag(BDT, 16 * mb + fr, 0, fq), a1 = ldfrag(BDT, 16 * mb + fr, 1, fq);
#pragma unroll
        for (int t = 0; t < 2; ++t) { const int nb = 2 * (wid >> 2) + t;
            const bf16x8 b0 = ldfrag(XT, 16 * nb + fr, 0, fq), b1 = ldfrag(XT, 16 * nb + fr, 1, fq);
            f32x4 acc = {0.f, 0.f, 0.f, 0.f}; acc = mfma16(b0, a0, acc); acc = mfma16(b1, a1, acc);
            *(f32x4*)(SH + (16 * mb + fr) * 64 + 16 * nb + 4 * fq) = acc; }
        if (tid == 0) ((float*)(WSP(a) + WS_GTS))[u] = __expf(SM[63]); }
    __syncthreads();
}

struct LruW { float wrc[32], wic[32], br, bi, spl; };
__device__ __forceinline__ void lru_load_w(const CArgs& a, int l, int ch, LruW& W) {
    const int blk = ch >> 5, d = ch & 31;
    const float* wr = INP(a, 26) + ((size_t)l * 8 + blk) * 1024 + d; const float* wi = INP(a, 28) + ((size_t)l * 8 + blk) * 1024 + d;
#pragma unroll
    for (int cI = 0; cI < 32; ++cI) { W.wrc[cI] = wr[cI * 32]; W.wic[cI] = wi[cI * 32]; }
    W.br = INP(a, 27)[l * 256 + ch]; W.bi = INP(a, 29)[l * 256 + ch]; W.spl = softplus_f(-INP(a, 30)[l * 256 + ch]);
}
template <class F> __device__ __forceinline__ void lru_gates(const LruW& W, const LAS float* XC, int ch, int half, F&& f) {
    const int blk = ch >> 5;
    const float br = W.br, bi = W.bi, spl = W.spl;
#pragma unroll
    for (int e = 0; e < 32; ++e) { const int t = half * 32 + e; float r = br, ig = bi;
#pragma unroll
        for (int c4 = 0; c4 < 8; ++c4) { const f32x4 xv = *(const LAS f32x4*)(XC + t * 256 + blk * 32 + c4 * 4);
#pragma unroll
            for (int k = 0; k < 4; ++k) { r += xv[k] * W.wrc[c4 * 4 + k]; ig += xv[k] * W.wic[c4 * 4 + k]; } }
        const float xc = XC[t * 256 + ch], log_a = -8.0f * sigmoid_f(r) * spl;
        f(e, __expf(log_a), sqrtf(-expm1f(2.0f * log_a)) * (sigmoid_f(ig) * xc)); }
}
__device__ __forceinline__ void lru_stage_conv(const CArgs& a, int l, int c, LAS unsigned char* lds) {
    const int tid = tidx(); const bf16_t* P = (const bf16_t*)(WSP(a) + WS_P);
    LAS bf16_t* RAW = (LAS bf16_t*)lds; LAS float* XC = (LAS float*)(lds + 34816);
    int s; bool first; chunk_seq(c, s, first);
    stage_raw_n<4>(RAW, P, c, PXC, PXC + 64, PXC + 128, PXC + 192, (first && s >= 2) ? INP(a, 7) + ((size_t)l * 16 + (s - 2)) * 3 * 256 : nullptr, 256, PXC, first);
    __syncthreads();
    {   const int ch = tid & 255, par = tid >> 8; const float* cw = INP(a, 24) + (size_t)l * 4 * 256 + ch; const float w0 = cw[0], w1 = cw[256], w2 = cw[512], w3 = cw[768], bias = INP(a, 25)[l * 256 + ch];
        float x0 = bf2f(RAW[(par * 32) * 256 + ch]), x1 = bf2f(RAW[(par * 32 + 1) * 256 + ch]), x2 = bf2f(RAW[(par * 32 + 2) * 256 + ch]);
#pragma unroll 8
        for (int e = 0; e < 32; ++e) { const int i = par * 32 + e; const float x3 = bf2f(RAW[(i + 3) * 256 + ch]);
            XC[i * 256 + ch] = w0 * x0 + w1 * x1 + w2 * x2 + w3 * x3 + bias; x0 = x1; x1 = x2; x2 = x3; } }
    __syncthreads();
}
__device__ __forceinline__ void m1_lru_unit(const CArgs& a, int l, int c, LAS unsigned char* lds, const LruW& W) {
    const int tid = tidx(), ch = tid & 255, half = tid >> 8;
    LAS float* XC = (LAS float*)(lds + 34816); LAS float* SM = (LAS float*)(lds + 34816 + 65536);
    lru_stage_conv(a, l, c, lds);
    float A = 1.f, B = 0.f;
    lru_gates(W, XC, ch, half, [&](int, float at, float bt) { A *= at; B = at * B + bt; });
    if (half == 1) { SM[ch] = A; SM[256 + ch] = B; }
    __syncthreads();
    if (half == 0) { const float A1 = SM[ch], B1 = SM[256 + ch];
        ((float*)(WSP(a) + WS_LA0))[c * 256 + ch] = A; ((float*)(WSP(a) + WS_LB0))[c * 256 + ch] = B;
        ((float*)(WSP(a) + WS_LA))[c * 256 + ch] = A1 * A; ((float*)(WSP(a) + WS_LB))[c * 256 + ch] = A1 * B + B1; }
    __syncthreads();
}

#define UNIT_LOOP(lo, hi) for (int id = (lo) + (((int)blockIdx.x - (lo)) % (int)gridDim.x + (int)gridDim.x) % (int)gridDim.x; id < (hi); id += (int)gridDim.x)
#define LAUNDER_ARGS() const CArgs* ap_ = (const CArgs*)__builtin_amdgcn_kernarg_segment_ptr(); asm volatile("" : "+s"(ap_)); const CArgs& a = *ap_
__device__ __forceinline__ void m1_phase(const CArgs& a0, int l, LAS unsigned char* lds) {
    { LAUNDER_ARGS(); const int G = (int)gridDim.x; int id = (int)blockIdx.x;
      if (id < NDU) { StageRegs<3> R; float xb_ = 0.f, xa_ = 0.f; m1_delta_prefetch(a, l, id / 6, id % 6, R, xb_, xa_);
        for (; id < NDU; id += G) { const int idn = id + G; m1_delta_unit(a, l, id / 6, id % 6, lds, R, xb_, xa_, idn / 6, idn % 6, idn < NDU); } } }
    { LAUNDER_ARGS(); const int G = (int)gridDim.x; int id = NDU + (((int)blockIdx.x - NDU) % G + G) % G;
      if (id < 2 * NDU) { StageRegs<2> R; float xd_ = 0.f; m1_ssd_prefetch(a, l, (id - NDU) / 6, (id - NDU) % 6, R, xd_);
        for (; id < 2 * NDU; id += G) { const int idn = id + G; m1_ssd_unit(a, l, (id - NDU) / 6, (id - NDU) % 6, lds, R, xd_, (idn - NDU) / 6, (idn - NDU) % 6, idn < 2 * NDU); } } }
    { LAUNDER_ARGS(); LruW W; lru_load_w(a, l, tidx() & 255, W); UNIT_LOOP(2 * NDU, 2 * NDU + NCH) m1_lru_unit(a, l, id - 2 * NDU, lds, W); }
}

constexpr int M2_UOFF = 4 * 64 * LDT * 2, M2_GOFF = M2_UOFF + 64 * 68 * 4, M2_BUFB = M2_GOFF + 16, M2_OB = 2 * M2_BUFB, M2_OBB = 64 * 68 * 4;
static_assert(M2_OB + 2 * M2_OBB <= 144 * 1024, "M2 LDS");
__device__ __forceinline__ void m2_delta_chain(const CArgs& a, int h, int c0, int nch, const float* init, bool ident, bool do_o, bool use_u, float* outf, bf16_t* outg, LAS unsigned char* lds) {
    const int tid = tidx(), lane = tid & 63, wid = __builtin_amdgcn_readfirstlane(tid >> 6), fr = lane & 15, fq = lane >> 4, vs = wid & 3;
    float* DU = (float*)(WSP(a) + WS_DU);
    if (wid >= 6) {
        const int ts = tid - 384;
        __syncthreads();
        for (int ci = 0; ci <= nch; ++ci) {
            if (ci > 0 && do_o) { const LAS float* ob = (const LAS float*)(lds + M2_OB + ((ci - 1) & 1) * M2_OBB); float* dst = DU + ((size_t)(c0 + ci - 1) * 6 + h) * 4096;
#pragma unroll
                for (int k = 0; k < 8; ++k) { const int q = ts + 128 * k; *(f32x4*)(dst + q * 4) = *(const LAS f32x4*)(ob + (q >> 4) * 68 + (q & 15) * 4); } }
            if (ci < nch) __syncthreads();
        }
        __syncthreads();
        return;
    }
    if (wid >= 4) {
        const int tl = tid - 256;
        const bf16_t* G0 = (const bf16_t*)(WSP(a) + WS_DW); const bf16_t* G1 = (const bf16_t*)(WSP(a) + WS_DQK); const bf16_t* G2 = (const bf16_t*)(WSP(a) + WS_DQD); const bf16_t* G3 = (const bf16_t*)(WSP(a) + WS_DKD);
        const float* GT = (const float*)(WSP(a) + WS_GTD);
        u32x4 p[16]; f32x4 pu[8]; float pg;
#define M2_LOAD(uu) do { _Pragma("unroll") for (int k = 0; k < 4; ++k) { const int q = tl + 128 * k; p[k] = *(const u32x4*)(G0 + (uu) * 4096 + q * 8); p[4 + k] = *(const u32x4*)(G1 + (uu) * 4096 + q * 8); \
            p[8 + k] = *(const u32x4*)(G2 + (uu) * 4096 + q * 8); p[12 + k] = *(const u32x4*)(G3 + (uu) * 4096 + q * 8); } \
        _Pragma("unroll") for (int k = 0; k < 8; ++k) { const int q = tl + 128 * k; pu[k] = *(const f32x4*)(DU + (uu) * 4096 + q * 4); } pg = GT[uu]; } while (0)
#define M2_WRITE(dstb) do { LAS bf16_t* d_ = (LAS bf16_t*)(dstb); LAS float* du_ = (LAS float*)((dstb) + M2_UOFF); \
        _Pragma("unroll") for (int k = 0; k < 4; ++k) { const int q = tl + 128 * k, o_ = (q >> 3) * LDT + (q & 7) * 8; *(LAS u32x4*)(d_ + o_) = p[k]; *(LAS u32x4*)(d_ + 64 * LDT + o_) = p[4 + k]; \
            *(LAS u32x4*)(d_ + 2 * 64 * LDT + o_) = p[8 + k]; *(LAS u32x4*)(d_ + 3 * 64 * LDT + o_) = p[12 + k]; } \
        _Pragma("unroll") for (int k = 0; k < 8; ++k) { const int q = tl + 128 * k; *(LAS f32x4*)(du_ + (q >> 4) * 68 + (q & 15) * 4) = pu[k]; } \
        if (tl == 0) *(LAS float*)((dstb) + M2_GOFF) = pg; } while (0)
        {   const size_t u = (size_t)c0 * 6 + h, u1 = nch > 1 ? u + 6 : u;
            M2_LOAD(u); M2_WRITE(lds);
            M2_LOAD(u1); }
        __syncthreads();
        for (int ci = 0; ci < nch; ++ci) {
            const size_t u = (size_t)(c0 + ci) * 6 + h; const size_t un2 = ci + 2 < nch ? u + 12 : u;
            LAS unsigned char* nxtb = lds + ((ci + 1) & 1) * M2_BUFB;
            if (ci + 1 < nch) M2_WRITE(nxtb);
            M2_LOAD(un2);
            __syncthreads();
        }
#undef M2_LOAD
#undef M2_WRITE
        __syncthreads();
        return;
    }
    f32x4 S[4];
#pragma unroll
    for (int mb = 0; mb < 4; ++mb) {
        if (init) {
#pragma unroll
            for (int r = 0; r < 4; ++r) S[mb][r] = init[(16 * mb + 4 * fq + r) * 64 + 16 * vs + fr]; }
        else {
#pragma unroll
            for (int r = 0; r < 4; ++r) S[mb][r] = (ident && (16 * mb + 4 * fq + r == 16 * vs + fr)) ? 1.f : 0.f; } }
    __syncthreads();
    for (int ci = 0; ci < nch; ++ci) {
        LAS unsigned char* curb = lds + (ci & 1) * M2_BUFB;
        const LAS bf16_t* cur = (const LAS bf16_t*)curb; const LAS float* UL = (const LAS float*)(curb + M2_UOFF); LAS float* OB = (LAS float*)(lds + M2_OB + (ci & 1) * M2_OBB);
        const float gt = *(const LAS float*)(curb + M2_GOFF);
        const bf16x8 Sb0 = pack8(S[0], S[1]), Sb1 = pack8(S[2], S[3]);
        f32x4 Dl[4], O[4];
#pragma unroll
        for (int mb = 0; mb < 4; ++mb) { f32x4 t = {0.f, 0.f, 0.f, 0.f}, uc;
#pragma unroll
            for (int r = 0; r < 4; ++r) uc[r] = use_u ? UL[(16 * mb + 4 * fq + r) * 68 + 16 * vs + fr] : 0.f;
            t = mfma16(ldfrag(cur + 0 * 64 * LDT, 16 * mb + fr, 0, fq), Sb0, t); t = mfma16(ldfrag(cur + 0 * 64 * LDT, 16 * mb + fr, 1, fq), Sb1, t);
            Dl[mb] = uc - t;
            f32x4 o = {0.f, 0.f, 0.f, 0.f};
            if (do_o) { o = mfma16(ldfrag(cur + 2 * 64 * LDT, 16 * mb + fr, 0, fq), Sb0, o); o = mfma16(ldfrag(cur + 2 * 64 * LDT, 16 * mb + fr, 1, fq), Sb1, o); }
            O[mb] = o; }
        const bf16x8 Db0 = pack8(Dl[0], Dl[1]), Db1 = pack8(Dl[2], Dl[3]);
#pragma unroll
        for (int mb = 0; mb < 4; ++mb) {
            f32x4 sn = S[mb] * gt;
            sn = mfma16(ldfrag(cur + 3 * 64 * LDT, 16 * mb + fr, 0, fq), Db0, sn); sn = mfma16(ldfrag(cur + 3 * 64 * LDT, 16 * mb + fr, 1, fq), Db1, sn);
            S[mb] = sn;
            if (do_o) { O[mb] = mfma16(ldfrag(cur + 1 * 64 * LDT, 16 * mb + fr, 0, fq), Db0, O[mb]); O[mb] = mfma16(ldfrag(cur + 1 * 64 * LDT, 16 * mb + fr, 1, fq), Db1, O[mb]);
#pragma unroll
                for (int r = 0; r < 4; ++r) OB[(16 * mb + 4 * fq + r) * 68 + 16 * vs + fr] = O[mb][r]; } }
        __syncthreads();
    }
    if (outf) {
#pragma unroll
        for (int mb = 0; mb < 4; ++mb)
#pragma unroll
            for (int r = 0; r < 4; ++r) outf[(16 * mb + 4 * fq + r) * 64 + 16 * vs + fr] = S[mb][r]; }
    if (outg) { const int kp = kinv(16 * vs + fr);
#pragma unroll
        for (int mb = 0; mb < 4; ++mb)
#pragma unroll
            for (int r = 0; r < 4; ++r) outg[(16 * mb + 4 * fq + r) * 64 + kp] = f2bf(S[mb][r]); }
    __syncthreads();
}
__device__ __forceinline__ void m2_level2(const CArgs& a, int q) {
    const int tid = tidx(), lane = tid & 63, wid = __builtin_amdgcn_readfirstlane(tid >> 6), fr = lane & 15, fq = lane >> 4, vs = wid & 3;
    if (wid >= 4) return;
    const bf16_t* GP = (const bf16_t*)(WSP(a) + WS_GP) + (size_t)q * 16 * 4096; const float* HH = (const float*)(WSP(a) + WS_HH) + (size_t)q * 16 * 4096; float* SST = (float*)(WSP(a) + WS_SST) + (size_t)q * 16 * 4096;
    f32x4 S[4], hn[4]; bf16x8 an[4][2];
#pragma unroll
    for (int mb = 0; mb < 4; ++mb) { S[mb] = (f32x4){0.f, 0.f, 0.f, 0.f};
#pragma unroll
        for (int r = 0; r < 4; ++r) hn[mb][r] = HH[(16 * mb + 4 * fq + r) * 64 + 16 * vs + fr];
        an[mb][0] = *(const bf16x8*)(GP + (16 * mb + fr) * 64 + 8 * fq); an[mb][1] = *(const bf16x8*)(GP + (16 * mb + fr) * 64 + 32 + 8 * fq); }
    for (int g = 0; g < 16; ++g) {
#pragma unroll
        for (int mb = 0; mb < 4; ++mb)
#pragma unroll
            for (int r = 0; r < 4; ++r) SST[(size_t)g * 4096 + (16 * mb + 4 * fq + r) * 64 + 16 * vs + fr] = S[mb][r];
        if (g == 15) break;
        f32x4 hc[4]; bf16x8 ac[4][2];
#pragma unroll
        for (int mb = 0; mb < 4; ++mb) { hc[mb] = hn[mb]; ac[mb][0] = an[mb][0]; ac[mb][1] = an[mb][1]; }
        const int gn = g + 1 < 15 ? g + 1 : g;
#pragma unroll
        for (int mb = 0; mb < 4; ++mb) {
#pragma unroll
            for (int r = 0; r < 4; ++r) hn[mb][r] = HH[(size_t)gn * 4096 + (16 * mb + 4 * fq + r) * 64 + 16 * vs + fr];
            an[mb][0] = *(const bf16x8*)(GP + (size_t)gn * 4096 + (16 * mb + fr) * 64 + 8 * fq); an[mb][1] = *(const bf16x8*)(GP + (size_t)gn * 4096 + (16 * mb + fr) * 64 + 32 + 8 * fq); }
        const bf16x8 Sb0 = pack8(S[0], S[1]), Sb1 = pack8(S[2], S[3]);
#pragma unroll
        for (int mb = 0; mb < 4; ++mb) { f32x4 t = mfma16(ac[mb][0], Sb0, hc[mb]); S[mb] = mfma16(ac[mb][1], Sb1, t); }
    }
}
__device__ __forceinline__ void m2_scan_unit(const CArgs& a, int l, int su) {
    const int tid = tidx();
    if (su < 864) {
        int s, h, e; const int gi = (su < 96 ? su : su - 96) * 512 + tid;
        if (su < 96) { s = gi / (6 * 4096); h = (gi / 4096) % 6; e = gi & 4095; } else { s = 2 + gi / (6 * 4096); h = (gi / 4096) % 6; e = gi & 4095; }
        const int nch = seq_len(s) / 64, c0 = s < 2 ? s * 256 : 512 + (s - 2);
        float hs = s < 2 ? 0.f : INP(a, 4)[(((size_t)l * 16 + (s - 2)) * 6 + h) * 4096 + e];
        float* SH = (float*)(WSP(a) + WS_SH); const float* GT = (const float*)(WSP(a) + WS_GTS);
        int ci = 0;
        for (; ci + 8 <= nch; ci += 8) { float hl[8], gt[8];
#pragma unroll
            for (int k = 0; k < 8; ++k) { const size_t u = (size_t)(c0 + ci + k) * 6 + h; hl[k] = SH[u * 4096 + e]; gt[k] = GT[u]; }
#pragma unroll
            for (int k = 0; k < 8; ++k) { const size_t u = (size_t)(c0 + ci + k) * 6 + h; SH[u * 4096 + e] = hs; hs = gt[k] * hs + hl[k]; } }
        for (; ci < nch; ++ci) { const size_t u = (size_t)(c0 + ci) * 6 + h; const float hl = SH[u * 4096 + e], gt = GT[u]; SH[u * 4096 + e] = hs; hs = gt * hs + hl; }
        state_out(OUTP(a), O_PSH, O_SSH, l, s, 6 * 4096)[(size_t)h * 4096 + e] = hs;
    } else {
        const int gi = (su == 864 ? 0 : su - 865) * 512 + tid; const int s = su == 864 ? gi / 256 : 2 + gi / 256, ch = gi & 255;
        const int nch = seq_len(s) / 64, c0 = s < 2 ? s * 256 : 512 + (s - 2);
        float hs = s < 2 ? 0.f : INP(a, 6)[((size_t)l * 16 + (s - 2)) * 256 + ch];
        const float* LA = (const float*)(WSP(a) + WS_LA); float* LB = (float*)(WSP(a) + WS_LB);
        int ci = 0;
        for (; ci + 8 <= nch; ci += 8) { float A[8], B[8];
#pragma unroll
            for (int k = 0; k < 8; ++k) { A[k] = LA[(c0 + ci + k) * 256 + ch]; B[k] = LB[(c0 + ci + k) * 256 + ch]; }
#pragma unroll
            for (int k = 0; k < 8; ++k) { LB[(c0 + ci + k) * 256 + ch] = hs; hs = A[k] * hs + B[k]; } }
        for (; ci < nch; ++ci) { const float A = LA[(c0 + ci) * 256 + ch], B = LB[(c0 + ci) * 256 + ch]; LB[(c0 + ci) * 256 + ch] = hs; hs = A * hs + B; }
        state_out(OUTP(a), O_PLH, O_SLH, l, s, 256)[ch] = hs;
    }
}
__device__ __forceinline__ void m2_scan2_unit(float* V, size_t vcs, const float* Dc, size_t dcs, int des, int e0, float* fin, LAS unsigned char* lds) {
    const int tid = tidx(), g = tid >> 5, el = tid & 31; LAS float* CG = (LAS float*)lds; LAS float* CH = CG + 512;
    float v[16], d[16];
#pragma unroll
    for (int k = 0; k < 16; ++k) { v[k] = V[(size_t)(16 * g + k) * vcs + e0 + el]; d[k] = Dc[(size_t)(16 * g + k) * dcs + (size_t)des * (e0 + el)]; }
    float hs = 0.f, gp = 1.f;
#pragma unroll
    for (int k = 0; k < 16; ++k) { const float t = v[k]; v[k] = hs; hs = d[k] * hs + t; gp *= d[k]; }
    CG[tid] = gp; CH[tid] = hs;
    __syncthreads();
    float S = 0.f;
    for (int j = 0; j < g; ++j) S = CG[j * 32 + el] * S + CH[j * 32 + el];
    float pk = 1.f;
#pragma unroll
    for (int k = 0; k < 16; ++k) { V[(size_t)(16 * g + k) * vcs + e0 + el] = v[k] + pk * S; pk *= d[k]; }
    if (g == 15) fin[e0 + el] = hs + gp * S;
    __syncthreads();
}
__device__ __forceinline__ void m2a_phase(const CArgs& a0, int l, LAS unsigned char* lds) {
    { LAUNDER_ARGS(); UNIT_LOOP(0, 1552) {
        if (id < 1536) { const int q = id >> 7, s = q / 6, h = q % 6, e0 = (id & 127) * 32;
            m2_scan2_unit((float*)(WSP(a) + WS_SH) + ((size_t)s * 256 * 6 + h) * 4096, (size_t)6 * 4096, (const float*)(WSP(a) + WS_GTS) + (size_t)s * 256 * 6 + h, 6, 0, e0,
                          state_out(OUTP(a), O_PSH, O_SSH, l, s, 6 * 4096) + (size_t)h * 4096, lds); }
        else { const int j = id - 1536, s = j >> 3, e0 = (j & 7) * 32;
            m2_scan2_unit((float*)(WSP(a) + WS_LB) + (size_t)s * 256 * 256, 256, (const float*)(WSP(a) + WS_LA) + (size_t)s * 256 * 256, 256, 1, e0, state_out(OUTP(a), O_PLH, O_SLH, l, s, 256), lds); } } }
    { LAUNDER_ARGS(); UNIT_LOOP(1552, 1552 + 360) { const int j = id - 1552, q = j / 30, g = (j >> 1) % 15, half = j & 1; const size_t qg = (size_t)q * 16 + g;
        m2_delta_chain(a, q % 6, (q / 6) * 256 + 16 * g, 16, nullptr, half == 1, false, half == 0, half == 0 ? (float*)(WSP(a) + WS_HH) + qg * 4096 : nullptr, half == 1 ? (bf16_t*)(WSP(a) + WS_GP) + qg * 4096 : nullptr, lds); } }
    { LAUNDER_ARGS(); const int b = (int)blockIdx.x;
      const int k = b >= 120 ? b - 120 : (b < 16 ? 136 + b : -1);
      if (k >= 0) for (int j = k; j < 776; j += 152) m2_scan_unit(a, l, j < 768 ? 96 + j : 865 + (j - 768)); }
}
__device__ __forceinline__ void m2b_phase(const CArgs& a0, int l) { LAUNDER_ARGS(); if (blockIdx.x < 12) m2_level2(a, blockIdx.x); }
__device__ __forceinline__ void m2c_phase(const CArgs& a0, int l, LAS unsigned char* lds) {
    LAUNDER_ARGS();
    const int b = (int)blockIdx.x;
    if (b < 192) { const int id = b, q = id >> 4, g = id & 15, s = q / 6, h = q % 6;
        m2_delta_chain(a, h, s * 256 + 16 * g, 16, (const float*)(WSP(a) + WS_SST) + (size_t)id * 4096, false, true, true, g == 15 ? state_out(OUTP(a), O_PDS, O_SDS, l, s, 6 * 4096) + (size_t)h * 4096 : nullptr, nullptr, lds); }
    else for (int j = b - 192; j < 96; j += (int)gridDim.x - 192) { const int sb = j / 6, h = j % 6;
        m2_delta_chain(a, h, 512 + sb, 1, INP(a, 2) + (((size_t)l * 16 + sb) * 6 + h) * 4096, false, true, true, state_out(OUTP(a), O_PDS, O_SDS, l, 2 + sb, 6 * 4096) + (size_t)h * 4096, nullptr, lds); }
}

__device__ __forceinline__ void m3_delta_unit(const CArgs& a, int l, int c) {
    const int tid = tidx(), i = tid >> 3, part = tid & 7; const size_t row = (size_t)c * 64 + i;
    const bf16_t* P = (const bf16_t*)(WSP(a) + WS_P); bf16_t* MIX = (bf16_t*)(WSP(a) + WS_H); const float* DU = (const float*)(WSP(a) + WS_DU);
    f32x4 nw0 = *(const f32x4*)(INP(a, 17) + l * 64 + part * 8), nw1 = *(const f32x4*)(INP(a, 17) + l * 64 + part * 8 + 4);
    f32x4 oo[6][2]; u32x4 zz[6];
#pragma unroll
    for (int h = 0; h < 6; ++h) { const float* o = DU + ((size_t)c * 6 + h) * 4096 + i * 64 + part * 8; oo[h][0] = *(const f32x4*)o; oo[h][1] = *(const f32x4*)(o + 4);
        zz[h] = *(const u32x4*)(P + row * PSTR + PZA + h * 64 + part * 8); }
#pragma unroll
    for (int h = 0; h < 6; ++h) {
        const f32x4 o0 = oo[h][0], o1 = oo[h][1];
        float ss = o0[0] * o0[0] + o0[1] * o0[1] + o0[2] * o0[2] + o0[3] * o0[3] + o1[0] * o1[0] + o1[1] * o1[1] + o1[2] * o1[2] + o1[3] * o1[3];
        ss += __shfl_xor(ss, 1); ss += __shfl_xor(ss, 2); ss += __shfl_xor(ss, 4);
        const float rs = rsqrtf(ss * (1.0f / 64.f) + 1e-6f);
        const u32x4 z = zz[h];
        float zf[8] = {__uint_as_float(z.x << 16), __uint_as_float(z.x & 0xffff0000u), __uint_as_float(z.y << 16), __uint_as_float(z.y & 0xffff0000u),
                       __uint_as_float(z.z << 16), __uint_as_float(z.z & 0xffff0000u), __uint_as_float(z.w << 16), __uint_as_float(z.w & 0xffff0000u)};
        u32x4 w;
        w.x = cvtpk(o0[0] * rs * nw0[0] * siluf(zf[0]), o0[1] * rs * nw0[1] * siluf(zf[1])); w.y = cvtpk(o0[2] * rs * nw0[2] * siluf(zf[2]), o0[3] * rs * nw0[3] * siluf(zf[3]));
        w.z = cvtpk(o1[0] * rs * nw1[0] * siluf(zf[4]), o1[1] * rs * nw1[1] * siluf(zf[5])); w.w = cvtpk(o1[2] * rs * nw1[2] * siluf(zf[6]), o1[3] * rs * nw1[3] * siluf(zf[7]));
        *(u32x4*)(MIX + row * D + h * 64 + part * 8) = w;
    }
}
__device__ __forceinline__ void m3_ssd_unit(const CArgs& a, int l, int c, int g, LAS unsigned char* lds) {
    const int tid = tidx(), lane = tid & 63, wid = __builtin_amdgcn_readfirstlane(tid >> 6), fr = lane & 15, fq = lane >> 4;
    const bf16_t* P = (const bf16_t*)(WSP(a) + WS_P); bf16_t* MIX = (bf16_t*)(WSP(a) + WS_H);
    LAS bf16_t* RAWBC = (LAS bf16_t*)lds;
    LAS bf16_t* SC = (LAS bf16_t*)lds; LAS bf16_t* HT = SC + 64 * LDT;
    LAS bf16_t* BN = (LAS bf16_t*)(lds + 18432); LAS bf16_t* CN = BN + 64 * LDT;
    LAS bf16_t* RAWX = (LAS bf16_t*)(lds + 36864);
    LAS bf16_t* XDT = (LAS bf16_t*)(lds + 46080);
    LAS float* XS = (LAS float*)(lds + 55296);
    LAS float* Y = (LAS float*)(lds + 71680);
    LAS float* SM = (LAS float*)(lds + 120832);
    int s; bool first; chunk_seq(c, s, first);
    const float* st = (first && s >= 2) ? INP(a, 5) + ((size_t)l * 16 + (s - 2)) * 3 * 640 : nullptr;
    stage_raw_n<2>(RAWBC, P, c, PXBC + 384 + g * 64, PXBC + 512 + g * 64, 0, 0, st, 640, PXBC, first);
    __syncthreads();
    {   const int ch = tid & 127, part = tid >> 7, wch = ch < 64 ? 384 + g * 64 + ch : 512 + g * 64 + (ch - 64);
        const float* cw = INP(a, 18) + (size_t)l * 4 * 640 + wch; const float w0 = cw[0], w1 = cw[640], w2 = cw[1280], w3 = cw[1920], bias = INP(a, 19)[l * 640 + wch];
        float x0 = bf2f(RAWBC[(part * 16) * 128 + ch]), x1 = bf2f(RAWBC[(part * 16 + 1) * 128 + ch]), x2 = bf2f(RAWBC[(part * 16 + 2) * 128 + ch]);
#pragma unroll 8
        for (int e = 0; e < 16; ++e) { const int j = part * 16 + e; const float x3 = bf2f(RAWBC[(j + 3) * 128 + ch]);
            const float y = siluf(w0 * x0 + w1 * x1 + w2 * x2 + w3 * x3 + bias); x0 = x1; x1 = x2; x2 = x3;
            if (ch < 64) BN[j * LDT + ch] = f2bf(y); else CN[j * LDT + ch - 64] = f2bf(y); } }
    __syncthreads();
    StageRegs<1> RX; float ht[8], zb[8], xd = 0.f, cwx[5];
#define M3_PREFETCH(hh_) do { const int head_ = 3 * g + (hh_); const size_t u_ = (size_t)c * 6 + head_; \
        if (wid == 0) xd = ldp(P, (size_t)c * 64 + lane, PDT + head_); \
        { const float* cw_ = INP(a, 18) + (size_t)l * 4 * 640 + head_ * 64 + (tid & 63); cwx[0] = cw_[0]; cwx[1] = cw_[640]; cwx[2] = cw_[1280]; cwx[3] = cw_[1920]; cwx[4] = INP(a, 19)[l * 640 + head_ * 64 + (tid & 63)]; } \
        stage_load<1>(RX, P, c, PXBC + head_ * 64, 0, 0, 0, st, 640, PXBC, first); \
        { const float* SH_ = (const float*)(WSP(a) + WS_SH) + u_ * 4096; _Pragma("unroll") for (int e = 0; e < 8; ++e) ht[e] = SH_[tid + 512 * e]; } \
        _Pragma("unroll") for (int t = 0; t < 2; ++t) _Pragma("unroll") for (int r = 0; r < 4; ++r) zb[t * 4 + r] = ldp(P, (size_t)c * 64 + 16 * (wid & 3) + 4 * fq + r, PZB + head_ * 64 + 16 * (2 * (wid >> 2) + t) + fr); } while (0)
    M3_PREFETCH(0);
    for (int hh = 0; hh < 3; ++hh) {
        const int head = 3 * g + hh;
        stage_store<1>(RAWX, RX);
        if (wid == 0) {
            const float dt = softplus_f(xd + INP(a, 21)[l * 6 + head]);
            SM[lane] = wave_scan_incl(-__expf(INP(a, 20)[l * 6 + head]) * dt, lane); SM[64 + lane] = dt;
        }
#pragma unroll
        for (int e = 0; e < 8; ++e) { const int idx = tid + 512 * e, n = idx >> 6, p = idx & 63; HT[p * LDT + n] = f2bf(ht[e]); }
        float zc[8]; const float w0 = cwx[0], w1 = cwx[1], w2 = cwx[2], w3 = cwx[3], bias = cwx[4];
#pragma unroll
        for (int e = 0; e < 8; ++e) zc[e] = zb[e];
        __syncthreads();
        if (hh < 2) M3_PREFETCH(hh + 1);
        {   const int p = tid & 63, part = tid >> 6;
            float x0 = bf2f(RAWX[(part * 8) * 64 + p]), x1 = bf2f(RAWX[(part * 8 + 1) * 64 + p]), x2 = bf2f(RAWX[(part * 8 + 2) * 64 + p]);
#pragma unroll
            for (int e = 0; e < 8; ++e) { const int j = part * 8 + e; const float x3 = bf2f(RAWX[(j + 3) * 64 + p]);
                const float y = siluf(w0 * x0 + w1 * x1 + w2 * x2 + w3 * x3 + bias); x0 = x1; x1 = x2; x2 = x3;
                XS[j * 64 + p] = y; XDT[p * LDT + j] = f2bf(y * SM[64 + j]); } }
        {   const int mb = wid & 3;
            const bf16x8 a0 = ldfrag(CN, 16 * mb + fr, 0, fq), a1 = ldfrag(CN, 16 * mb + fr, 1, fq);
            float gi[4];
#pragma unroll
            for (int r = 0; r < 4; ++r) gi[r] = SM[16 * mb + 4 * fq + r];
#pragma unroll
            for (int t = 0; t < 2; ++t) { const int nb = 2 * (wid >> 2) + t;
                const bf16x8 b0 = ldfrag(BN, 16 * nb + fr, 0, fq), b1 = ldfrag(BN, 16 * nb + fr, 1, fq);
                f32x4 acc = {0.f, 0.f, 0.f, 0.f}; acc = mfma16(a0, b0, acc); acc = mfma16(a1, b1, acc);
                const int j = 16 * nb + fr; const float gj = SM[j];
#pragma unroll
                for (int r = 0; r < 4; ++r) { const int i = 16 * mb + 4 * fq + r; SC[i * LDT + j] = f2bf(i >= j ? acc[r] * __expf(gi[r] - gj) : 0.f); } } }
        __syncthreads();
        {   const int mb = wid & 3; const float dsk = INP(a, 22)[l * 6 + head];
            const bf16x8 s0 = ldfrag(SC, 16 * mb + fr, 0, fq), s1 = ldfrag(SC, 16 * mb + fr, 1, fq), c0f = ldfrag(CN, 16 * mb + fr, 0, fq), c1f = ldfrag(CN, 16 * mb + fr, 1, fq);
#pragma unroll
            for (int t = 0; t < 2; ++t) { const int nb = 2 * (wid >> 2) + t;
                f32x4 y1 = {0.f, 0.f, 0.f, 0.f}, y2 = {0.f, 0.f, 0.f, 0.f};
                y1 = mfma16(s0, ldfrag(XDT, 16 * nb + fr, 0, fq), y1); y1 = mfma16(s1, ldfrag(XDT, 16 * nb + fr, 1, fq), y1);
                y2 = mfma16(c0f, ldfrag(HT, 16 * nb + fr, 0, fq), y2); y2 = mfma16(c1f, ldfrag(HT, 16 * nb + fr, 1, fq), y2);
                const int p = 16 * nb + fr;
#pragma unroll
                for (int r = 0; r < 4; ++r) { const int i = 16 * mb + 4 * fq + r;
                    float y = y1[r] + __expf(SM[i]) * y2[r] + dsk * XS[i * 64 + p];
                    y *= siluf(zc[t * 4 + r]);
                    Y[i * 192 + hh * 64 + p] = y; } } }
        __syncthreads();
    }
#undef M3_PREFETCH
    {   const int i = tid >> 3, part = tid & 7; float v[24], ss = 0.f;
#pragma unroll
        for (int e4 = 0; e4 < 6; ++e4) { const f32x4 t = *(const LAS f32x4*)(Y + i * 192 + part * 24 + e4 * 4); v[4 * e4] = t[0]; v[4 * e4 + 1] = t[1]; v[4 * e4 + 2] = t[2]; v[4 * e4 + 3] = t[3]; }
#pragma unroll
        for (int e = 0; e < 24; ++e) ss += v[e] * v[e];
        ss += __shfl_xor(ss, 1); ss += __shfl_xor(ss, 2); ss += __shfl_xor(ss, 4);
        const float rs = rsqrtf(ss * (1.0f / 192.f) + 1e-6f); const float* nw = INP(a, 23) + l * 384 + g * 192 + part * 24;
        bf16_t* dst = MIX + ((size_t)c * 64 + i) * D + 384 + g * 192 + part * 24;
#pragma unroll
        for (int q = 0; q < 3; ++q) { u32x4 w;
            w.x = cvtpk(v[8 * q + 0] * rs * nw[8 * q + 0], v[8 * q + 1] * rs * nw[8 * q + 1]); w.y = cvtpk(v[8 * q + 2] * rs * nw[8 * q + 2], v[8 * q + 3] * rs * nw[8 * q + 3]);
            w.z = cvtpk(v[8 * q + 4] * rs * nw[8 * q + 4], v[8 * q + 5] * rs * nw[8 * q + 5]); w.w = cvtpk(v[8 * q + 6] * rs * nw[8 * q + 6], v[8 * q + 7] * rs * nw[8 * q + 7]);
            *(u32x4*)(dst + 8 * q) = w; } }
    __syncthreads();
}
__device__ __forceinline__ void m3_lru_unit(const CArgs& a, int l, int c, LAS unsigned char* lds, const LruW& W) {
    const int tid = tidx(), ch = tid & 255, half = tid >> 8;
    const bf16_t* P = (const bf16_t*)(WSP(a) + WS_P); bf16_t* MIX = (bf16_t*)(WSP(a) + WS_H);
    LAS float* XC = (LAS float*)(lds + 34816);
    float gz[32];
#pragma unroll
    for (int e = 0; e < 32; ++e) gz[e] = ldp(P, (size_t)c * 64 + half * 32 + e, PGC + ch);
    float hcur = ((const float*)(WSP(a) + WS_LB))[c * 256 + ch];
    const float a0h = ((const float*)(WSP(a) + WS_LA0))[c * 256 + ch], b0h = ((const float*)(WSP(a) + WS_LB0))[c * 256 + ch];
    lru_stage_conv(a, l, c, lds);
    if (half == 1) hcur = a0h * hcur + b0h;
    lru_gates(W, XC, ch, half, [&](int e, float at, float bt) { hcur = at * hcur + bt;
        const size_t row = (size_t)c * 64 + half * 32 + e; MIX[row * D + 768 + ch] = f2bf(hcur * gelu_tanh(gz[e])); });
    __syncthreads();
}
__device__ __forceinline__ void m3_state_unit(const CArgs& a, int l, int s) {
    const bf16_t* P = (const bf16_t*)(WSP(a) + WS_P); const size_t r0 = seq_row0(s) + seq_len(s) - 3;
    float* oa = state_out(OUTP(a), O_PDC, O_SDC, l, s, 3 * 1152); float* ob = state_out(OUTP(a), O_PSC, O_SSC, l, s, 3 * 640); float* oc = state_out(OUTP(a), O_PLC, O_SLC, l, s, 3 * 256);
    for (int idx = tidx(); idx < 3 * 2048; idx += 512) { const int j = idx / 2048, e = idx % 2048;
        if (e < 1152) oa[j * 1152 + e] = ldp(P, r0 + j, e);
        else if (e < 1792) ob[j * 640 + e - 1152] = ldp(P, r0 + j, PXBC + e - 1152);
        else oc[j * 256 + e - 1792] = ldp(P, r0 + j, PXC + e - 1792); }
}
__device__ __forceinline__ void m3_phase(const CArgs& a0, int l, LAS unsigned char* lds) {
    { LAUNDER_ARGS(); UNIT_LOOP(0, 2 * NCH) m3_ssd_unit(a, l, id >> 1, id & 1, lds); }
    { LAUNDER_ARGS(); LruW W; lru_load_w(a, l, tidx() & 255, W); UNIT_LOOP(2 * NCH, 3 * NCH) m3_lru_unit(a, l, id - 2 * NCH, lds, W); }
    { LAUNDER_ARGS(); UNIT_LOOP(3 * NCH, 4 * NCH) m3_delta_unit(a, l, id - 3 * NCH); }
    { LAUNDER_ARGS(); UNIT_LOOP(4 * NCH, 4 * NCH + 18) m3_state_unit(a, l, id - 4 * NCH); }
}
namespace cg = cooperative_groups;
#define GEMM_GU(l, f) do { PH_BEGIN(); pg8::Gemm g{(const bf16_t*)OUTP(a), (const bf16_t*)(WSP(a) + WS_WGU + (size_t)((l) * 2 + (f)) * SZ_WGU), T, NGU, D}; pg8::StaticOrder S; S.init(T, NGU, gridDim.x, blockIdx.x); \
        pg8::rs_prepare(lds, S, (const float*)(WSP(a) + WS_RS), tidx()); pg8::EpiGU E{P, FF, lds}; pg8::gemm_phase<pg8::EpiGU, pg8::StaticOrder, true, true>(lds, g, S, E); } while (0)
#define SPLITK_TAIL(Aptr, Wptr, LDK, NSL) do { pg8::Gemm g2{(Aptr) + (size_t)TP * (LDK), (Wptr), TS, D, 256, (LDK)}; pg8::SplitKOrder S2{TS / 256, D / 256, (NSL), 256, (int)gridDim.x, (int)blockIdx.x}; \
        pg8::EpiSlab E2{(float*)(WSP(a) + WS_SLAB), D, 256, (size_t)TS * D}; pg8::gemm_phase<pg8::EpiSlab, pg8::SplitKOrder, true, true>(lds, g2, S2, E2); } while (0)
#define GEMM_DN(l, f) do { { PH_BEGIN(); const bf16_t* W = (const bf16_t*)(WSP(a) + WS_WDN + (size_t)((l) * 2 + (f)) * SZ_WDN); pg8::Gemm g{P, W, TP, D, FF}; pg8::StaticOrder S; S.init(TP, D, gridDim.x, blockIdx.x); \
        pg8::EpiRes E{(bf16_t*)OUTP(a), ((l) == 1 && (f) == 1) ? (bf16_t*)(WSP(a) + WS_H) : (bf16_t*)OUTP(a), 0.5f, (float*)(WSP(a) + WS_RS)}; pg8::gemm_phase<pg8::EpiRes, pg8::StaticOrder, true, true>(lds, g, S, E); \
        SPLITK_TAIL(P, W, FF, 11); } BAR(); \
        { PH_BEGIN(); sample_reduce_phase<11>(a, 0.5f, (l) == 1 && (f) == 1, (float*)(WSP(a) + WS_RS)); } } while (0)
#define GEMM_IN(l) do { PH_BEGIN(); pg8::Gemm g{(const bf16_t*)OUTP(a), (const bf16_t*)(WSP(a) + WS_WIN + (size_t)(l) * SZ_WIN), T, NPIN, D}; pg8::StaticOrder S; S.init(T, NPIN, gridDim.x, blockIdx.x); \
        pg8::rs_prepare(lds, S, (const float*)(WSP(a) + WS_RS), tidx()); pg8::EpiP E{P, PSTR, PSTR, lds}; pg8::gemm_phase<pg8::EpiP, pg8::StaticOrder, true, true>(lds, g, S, E); } while (0)
#define GEMM_OUT(l) do { { PH_BEGIN(); const bf16_t* W = (const bf16_t*)(WSP(a) + WS_WOUT + (size_t)(l) * SZ_WOUT); pg8::Gemm g{H, W, TP, D, D}; pg8::StaticOrder S; S.init(TP, D, gridDim.x, blockIdx.x); \
        pg8::EpiRes E{(bf16_t*)OUTP(a), (bf16_t*)OUTP(a), 1.0f, (float*)(WSP(a) + WS_RS)}; pg8::gemm_phase<pg8::EpiRes, pg8::StaticOrder, true, true>(lds, g, S, E); \
        SPLITK_TAIL(H, W, D, 4); } BAR(); \
        { PH_BEGIN(); sample_reduce_phase<4>(a, 1.0f, false, (float*)(WSP(a) + WS_RS)); } } while (0)

__global__ void __launch_bounds__(512, 2) mk_fwd(Args a_) {
#define PH_BEGIN() const CArgs* ap_ = (const CArgs*)__builtin_amdgcn_kernarg_segment_ptr(); asm volatile("" : "+s"(ap_)); const CArgs& a = *ap_; \
        bf16_t* H = (bf16_t*)(WSP(a) + WS_H); bf16_t* P = (bf16_t*)(WSP(a) + WS_P); (void)H; (void)P; LAS unsigned char* lds = (LAS unsigned char*)lds_raw
    extern __shared__ __attribute__((aligned(16))) unsigned char lds_raw[];
    LAS unsigned char* lds = (LAS unsigned char*)lds_raw;
    volatile LAS unsigned* misc = (volatile LAS unsigned*)(lds + MISC_OFF);
    if (threadIdx.x < 4) misc[threadIdx.x] = 0u;
    __syncthreads();
    XcdBarrier bar = xcd_barrier_post((unsigned*)(a_.ws + WS_CTL), misc);
    if (a_.ph_lo < 0) cg::this_grid().sync();
#define BAR() xcd_barrier(bar)
#define NORM(gi, goff, mode) do { PH_BEGIN(); norm_phase(a, INP(a, gi) + (goff), mode); } while (0)
#define MIXER(l) { PH_BEGIN(); m1_phase(a, l, lds); } BAR(); { PH_BEGIN(); m2a_phase(a, l, lds); } BAR(); { PH_BEGIN(); m2b_phase(a, l); } BAR(); { PH_BEGIN(); m2c_phase(a, l, lds); } BAR(); { PH_BEGIN(); m3_phase(a, l, lds); } BAR();
    { PH_BEGIN(); wprep_phase(a, lds); } NORM(8, 0, 0); BAR();
#define LAYER(l) \
        GEMM_GU(l, 0); BAR(); \
        GEMM_DN(l, 0); BAR(); \
        GEMM_IN(l); BAR(); \
        MIXER(l); \
        GEMM_OUT(l); BAR(); \
        GEMM_GU(l, 1); BAR(); \
        GEMM_DN(l, 1); BAR();
    LAYER(0)
    LAYER(1) NORM(36, 0, 2);
}

extern "C" void kernel_launch(void* const* d_in, const int* in_sizes, int n_in, void* d_out, int out_size, void* d_ws, size_t ws_size, hipStream_t stream) {
    static int grid = 0;
    if (grid == 0) {
        if (n_in != 37 || (size_t)out_size != O_END || ws_size < WS_END) { fprintf(stderr, "kernel_launch: unexpected shapes: n_in %d out %d (want %zu) ws %zu (want %zu)\n", n_in, out_size, (size_t)O_END, ws_size, (size_t)WS_END); grid = -1; return; }
        int dev = 0, cus = 0, per_cu = 0;
        if (hipGetDevice(&dev) != hipSuccess || hipDeviceGetAttribute(&cus, hipDeviceAttributeMultiprocessorCount, dev) != hipSuccess) { grid = -1; return; }
        if (hipFuncSetAttribute((const void*)mk_fwd, hipFuncAttributeMaxDynamicSharedMemorySize, LDS_BYTES) != hipSuccess) { fprintf(stderr, "kernel_launch: hipFuncSetAttribute failed\n"); grid = -1; return; }
        if (hipOccupancyMaxActiveBlocksPerMultiprocessor(&per_cu, (const void*)mk_fwd, 512, LDS_BYTES) != hipSuccess || per_cu < 1) { fprintf(stderr, "kernel_launch: occupancy query says %d\n", per_cu); (void)hipGetLastError(); }
        grid = cus;
    }
    if (grid < 0) return;
    (void)hipMemsetAsync((char*)d_ws + WS_CTL, 0, 65536, stream);
    Args a{};
    for (int i = 0; i < 37; ++i) a.in[i] = (const float*)d_in[i];
    a.out = (float*)d_out; a.ws = (unsigned char*)d_ws; a.ph_lo = 0; a.ph_hi = 0;
    void* args[] = {&a};
    hipError_t e = hipLaunchCooperativeKernel((const void*)mk_fwd, dim3(grid), dim3(512), args, LDS_BYTES, stream);
    if (e != hipSuccess) fprintf(stderr, "kernel_launch: cooperative launch failed: %s\n", hipGetErrorString(e));
}
```

```cpp
#include <hip/hip_runtime.h>
#include <hip/hip_cooperative_groups.h>
#include <cstdio>
#include <cstdint>
#define MK_ONE_LAUNCH 1
namespace pg8 {
#define PG8_LAS __attribute__((address_space(3)))
typedef unsigned short bf16_t;
typedef short bf16x8 __attribute__((ext_vector_type(8)));
typedef float f32x4 __attribute__((ext_vector_type(4)));
typedef unsigned u32x4 __attribute__((ext_vector_type(4)));
constexpr int BM = 256, BK = 64, HALF = 128, HTB = HALF * BK * 2  , STAGE_BYTES = 8 * HTB, NXCD = 8, WGM = 8;

__host__ __device__ __forceinline__ int lds_byte(int r, int c) { const int st = (r >> 4) * 2 + (c >> 5), rr = r & 15, cc = c & 31, ob = rr * 64 + cc * 2; return st * 1024 + (ob ^ (((ob >> 9) & 1) << 5)); }
__host__ __device__ __forceinline__ void stage_rc(int b, int& R, int& C) { const int st = b / 1024, sb = b % 1024, swz = sb ^ (((sb >> 9) & 1) << 5); R = (st >> 1) * 16 + swz / 64; C = (st & 1) * 32 + (swz % 64) / 2; }
__host__ __device__ __forceinline__ int perm32(int rho) { const int n = rho >> 4, i = rho & 15; return 8 * (i >> 2) + 4 * n + (i & 3); }

struct Unit { int pm, pn, seq, k0; };
struct Gemm { const bf16_t* A; const bf16_t* Bt; int M, N, K, ld; };

struct StaticOrder {
    int nM, nN, nwg, G, c;
    __host__ __device__ void init(int M, int N, int G_, int c_) { nM = M / BM; nN = N / BM; nwg = nM * nN; G = G_; c = c_; }
    __host__ __device__ bool next(int i, Unit& u) const {
        const long L = (long)i * G + c; if (L >= nwg) return false;
        int wgid = (int)L; { const int q = nwg / NXCD, r = nwg % NXCD, xcd = wgid % NXCD, off = wgid / NXCD; wgid = (xcd < r ? xcd * (q + 1) : r * (q + 1) + (xcd - r) * q) + off; }
        const int nig = WGM * nN, gid = wgid / nig, fm = gid * WGM, gsz = (nM - fm) < WGM ? (nM - fm) : WGM;
        u.pm = fm + ((wgid % nig) % gsz); u.pn = (wgid % nig) / gsz; u.seq = i; u.k0 = 0; return true;
    }
    __device__ __forceinline__ void a_ready(const Unit&) const {}
    __device__ __forceinline__ void done(const Unit&) const {}
};

__device__ __forceinline__ unsigned cvt_pk_bf16(float lo, float hi) { unsigned r; asm volatile("v_cvt_pk_bf16_f32 %0, %1, %2" : "=v"(r) : "v"(lo), "v"(hi)); return r; }
typedef unsigned u32x2v __attribute__((ext_vector_type(2)));
__device__ __forceinline__ float silu_f(float g) { return g * __builtin_amdgcn_rcpf(1.0f + __expf(-g)); }
constexpr int RSLD = 33792;
constexpr int RSL_OFF = 128 * 1024;
template <class Sched> __device__ __forceinline__ void rs_prepare(PG8_LAS unsigned char* lds, const Sched& S, const float* RS, int tid) {
    PG8_LAS float* rsl = (PG8_LAS float*)(lds + RSL_OFF); Unit u; int nU = 0;
    while (S.next(nU, u)) ++nU;
#pragma unroll 2
    for (int idx = tid; idx < nU * 256; idx += 512) { const int i = idx >> 8, r = idx & 255; S.next(i, u); const float* p = RS + (size_t)u.pm * BM + r;
        float q[16];
#pragma unroll
        for (int k = 0; k < 16; ++k) q[k] = p[(size_t)k * RSLD];
        const float s = (((q[0] + q[1]) + (q[2] + q[3])) + ((q[4] + q[5]) + (q[6] + q[7]))) + (((q[8] + q[9]) + (q[10] + q[11])) + ((q[12] + q[13]) + (q[14] + q[15])));
        rsl[i * 256 + r] = rsqrtf(s * (1.0f / 1024.f) + 1e-6f); }
    __syncthreads();
}
__device__ __forceinline__ float row_rs(PG8_LAS unsigned char* lds, const Unit& u, int rloc) { return ((const PG8_LAS float*)(lds + RSL_OFF))[u.seq * 256 + rloc]; }
typedef unsigned u32x4v __attribute__((ext_vector_type(4)));
struct EpiGU {
    static constexpr bool PERM = true, AFTER_DRAIN = false;
    bf16_t* O; int ldo; PG8_LAS unsigned char* lds;
    __device__ __forceinline__ void operator()(const f32x4 (&acc)[2][2][4][2], const Unit& u, int wr, int wc, int fr, int fq) const {
        const int row0 = u.pm * BM + wr * 64 + fr, col0 = u.pn * HALF + wc * 32 + 8 * fq;
#pragma unroll
        for (int ai = 0; ai < 2; ++ai)
#pragma unroll
            for (int m = 0; m < 4; ++m) { const int row = row0 + ai * HALF + m * 16; const float rs = row_rs(lds, u, wr * 64 + ai * HALF + m * 16 + fr);
                const f32x4 g0 = acc[ai][0][m][0] * rs, g1 = acc[ai][0][m][1] * rs, v0 = acc[ai][1][m][0] * rs, v1 = acc[ai][1][m][1] * rs;
                u32x4v w; w.x = cvt_pk_bf16(silu_f(g0[0]) * v0[0], silu_f(g0[1]) * v0[1]); w.y = cvt_pk_bf16(silu_f(g0[2]) * v0[2], silu_f(g0[3]) * v0[3]);
                w.z = cvt_pk_bf16(silu_f(g1[0]) * v1[0], silu_f(g1[1]) * v1[1]); w.w = cvt_pk_bf16(silu_f(g1[2]) * v1[2], silu_f(g1[3]) * v1[3]);
                *(u32x4v*)(O + (size_t)row * ldo + col0) = w; }
    }
};
struct EpiRes {
    static constexpr bool PERM = true, AFTER_DRAIN = false;
    static constexpr int ldc = 1024;
    bf16_t* XB; bf16_t* XO; float scale; float* RS;
    __device__ __forceinline__ void operator()(const f32x4 (&acc)[2][2][4][2], const Unit& u, int wr, int wc, int fr, int fq) const {
        const int row0 = u.pm * BM + wr * 64 + fr, col0 = u.pn * BM + wc * 32 + 8 * fq;
#pragma unroll
        for (int ai = 0; ai < 2; ++ai) {
            u32x4v xi[4][2];
#pragma unroll
            for (int m = 0; m < 4; ++m)
#pragma unroll
                for (int bj = 0; bj < 2; ++bj) xi[m][bj] = *(const u32x4v*)(XB + (size_t)(row0 + ai * HALF + m * 16) * ldc + col0 + bj * HALF);
#pragma unroll
            for (int m = 0; m < 4; ++m) { const int row = row0 + ai * HALF + m * 16; float ss = 0.f;
#pragma unroll
                for (int bj = 0; bj < 2; ++bj) { const u32x4v x = xi[m][bj];
                    f32x4 o0 = {__uint_as_float(x.x << 16), __uint_as_float(x.x & 0xffff0000u), __uint_as_float(x.y << 16), __uint_as_float(x.y & 0xffff0000u)};
                    f32x4 o1 = {__uint_as_float(x.z << 16), __uint_as_float(x.z & 0xffff0000u), __uint_as_float(x.w << 16), __uint_as_float(x.w & 0xffff0000u)};
                    o0 += scale * acc[ai][bj][m][0]; o1 += scale * acc[ai][bj][m][1];
                    { u32x4v w; w.x = cvt_pk_bf16(o0[0], o0[1]); w.y = cvt_pk_bf16(o0[2], o0[3]); w.z = cvt_pk_bf16(o1[0], o1[1]); w.w = cvt_pk_bf16(o1[2], o1[3]);
                        *(u32x4v*)(XO + (size_t)row * ldc + col0 + bj * HALF) = w;
                        const float r0 = __uint_as_float(w.x << 16), r1 = __uint_as_float(w.x & 0xffff0000u), r2 = __uint_as_float(w.y << 16), r3 = __uint_as_float(w.y & 0xffff0000u),
                                    r4 = __uint_as_float(w.z << 16), r5 = __uint_as_float(w.z & 0xffff0000u), r6 = __uint_as_float(w.w << 16), r7 = __uint_as_float(w.w & 0xffff0000u);
                        ss += (r0 * r0 + r1 * r1 + r2 * r2 + r3 * r3) + (r4 * r4 + r5 * r5 + r6 * r6 + r7 * r7); } }
                { ss += __shfl_xor(ss, 16); ss += __shfl_xor(ss, 32); if (fq == 0) RS[(size_t)(u.pn * 4 + wc) * RSLD + row] = ss; } }
        }
    }
};
struct EpiP {
    static constexpr bool PERM = true, AFTER_DRAIN = false;
    bf16_t* O; int ldo; int ncols; PG8_LAS unsigned char* lds;
    __device__ __forceinline__ void operator()(const f32x4 (&acc)[2][2][4][2], const Unit& u, int wr, int wc, int fr, int fq) const {
        const int row0 = u.pm * BM + wr * 64 + fr, col0 = u.pn * BM + wc * 32 + 8 * fq;
#pragma unroll
        for (int ai = 0; ai < 2; ++ai)
#pragma unroll
            for (int m = 0; m < 4; ++m) { const int row = row0 + ai * HALF + m * 16; bf16_t* rowp = O + (size_t)row * ldo; const float rs = row_rs(lds, u, wr * 64 + ai * HALF + m * 16 + fr);
#pragma unroll
                for (int bj = 0; bj < 2; ++bj) { const int c = col0 + bj * HALF; const f32x4 v0 = acc[ai][bj][m][0] * rs, v1 = acc[ai][bj][m][1] * rs;
                    if (c < ncols) { u32x4v w; w.x = cvt_pk_bf16(v0[0], v0[1]); w.y = cvt_pk_bf16(v0[2], v0[3]); w.z = cvt_pk_bf16(v1[0], v1[1]); w.w = cvt_pk_bf16(v1[2], v1[3]); *(u32x4v*)(rowp + c) = w; } } }
    }
};

struct SplitKOrder {
    int nM, nN, nK, kslice, G, c;
    __device__ bool next(int i, Unit& u) const { const int L = i * G + c; if (L >= nM * nN * nK) return false; u.pn = L % nN; u.pm = (L / nN) % nM; u.k0 = (L / (nN * nM)) * kslice; u.seq = i; return true; }
    __device__ __forceinline__ void a_ready(const Unit&) const {}
    __device__ __forceinline__ void done(const Unit&) const {}
};
struct EpiSlab {
    static constexpr bool PERM = false, AFTER_DRAIN = false;
    float* S; int ldc; int kslice; size_t slab;
    __device__ __forceinline__ void operator()(const f32x4 (&acc)[2][2][4][2], const Unit& u, int wr, int wc, int fr, int fq) const {
        const int row0 = u.pm * BM + wr * 64 + fr, col0 = u.pn * BM + wc * 32 + 4 * fq; float* base = S + (size_t)(u.k0 / kslice) * slab;
#pragma unroll
        for (int ai = 0; ai < 2; ++ai)
#pragma unroll
            for (int m = 0; m < 4; ++m) { float* rowp = base + (size_t)(row0 + ai * HALF + m * 16) * ldc + col0;
#pragma unroll
                for (int bj = 0; bj < 2; ++bj)
#pragma unroll
                    for (int n = 0; n < 2; ++n) *(f32x4*)(rowp + bj * HALF + n * 16) = acc[ai][bj][m][n]; }
    }
};
template <class Epi, class Sched, bool ALIGN_EPI = false, bool SP2 = false>
__device__ __forceinline__ void gemm_phase(PG8_LAS unsigned char* lds, const Gemm g, const Sched& S, const Epi& E) {
    int tid_ = threadIdx.x; asm volatile("" : "+v"(tid_));
    const int tid = tid_, wid = __builtin_amdgcn_readfirstlane(tid >> 6), lane = tid & 63, wr = wid >> 2, wc = wid & 3, fr = lane & 15, fq = lane >> 4;
    const int K = g.K, nt = K / BK, LD = g.ld ? g.ld : g.K;
    unsigned voffA[2], voffB[2];
#pragma unroll
    for (int i = 0; i < 2; ++i) { int R, C; stage_rc(tid * 16 + i * 8192, R, C); const int Rb = Epi::PERM ? ((R & ~31) + perm32(R & 31)) : R;
        voffA[i] = (unsigned)(R * LD + C) * 2u; voffB[i] = (unsigned)(Rb * LD + C) * 2u; }
    const size_t kstep = (size_t)(BK * 2);
    const size_t hstep = (size_t)HALF * LD * 2;
    const size_t tstep = 2 * hstep;
    const unsigned ldsw = (unsigned)wid * 1024u;
    const int aoff = lds_byte(wr * 64 + fr, fq * 8), boff = lds_byte(wc * 32 + fr, fq * 8);
#define PG8_SA(b, h) (((b) * 2 + (h)) * HTB)
#define PG8_SB(b, h) ((4 + (b) * 2 + (h)) * HTB)
#define PG8_STAGE(bufoff, gbase, voff) do { _Pragma("unroll") for (int _i = 0; _i < 2; ++_i) \
        __builtin_amdgcn_global_load_lds((const unsigned*)((const char*)(gbase) + (voff)[_i]), (PG8_LAS unsigned*)(lds + (bufoff) + ldsw + _i * 8192), 16, 0, 0); } while (0)
#define PG8_LDA(dst, b, h) do { _Pragma("unroll") for (int m = 0; m < 4; ++m) _Pragma("unroll") for (int k = 0; k < 2; ++k) dst[m][k] = *(const PG8_LAS bf16x8*)(lds + PG8_SA(b, h) + aoff + m * 2048 + k * 1024); } while (0)
#define PG8_LDB(dst, b, h) do { _Pragma("unroll") for (int n = 0; n < 2; ++n) _Pragma("unroll") for (int k = 0; k < 2; ++k) dst[n][k] = *(const PG8_LAS bf16x8*)(lds + PG8_SB(b, h) + boff + n * 2048 + k * 1024); } while (0)
#define PG8_MMA(ai, bj, At, Bt) do { __builtin_amdgcn_s_setprio(1); _Pragma("unroll") for (int m = 0; m < 4; ++m) _Pragma("unroll") for (int n = 0; n < 2; ++n) _Pragma("unroll") for (int k = 0; k < 2; ++k) \
        acc[ai][bj][m][n] = __builtin_amdgcn_mfma_f32_16x16x32_bf16(Bt[n][k], At[m][k], acc[ai][bj][m][n], 0, 0, 0); __builtin_amdgcn_s_setprio(0); } while (0)
#define PG8_WAIT_V(n) asm volatile("s_waitcnt vmcnt(" #n ")" ::: "memory")
#define PG8_WAIT_L(n) asm volatile("s_waitcnt lgkmcnt(" #n ")" ::: "memory")
#define PG8_BAR __builtin_amdgcn_s_barrier()
#define PG8_SCHED __builtin_amdgcn_sched_barrier(0)
    Unit cur, nxt; int ui = 0;
    if (!S.next(0, cur)) return;
    f32x4 acc[2][2][4][2];
#pragma unroll
    for (int a = 0; a < 2; ++a)
#pragma unroll
        for (int b = 0; b < 2; ++b)
#pragma unroll
            for (int m = 0; m < 4; ++m)
#pragma unroll
                for (int n = 0; n < 2; ++n) acc[a][b][m][n] = (f32x4){0.f, 0.f, 0.f, 0.f};
    bf16x8 At[4][2], B0[2][2], B1[2][2];
    const char* cA = (const char*)g.A + (size_t)cur.pm * tstep + (size_t)cur.k0 * 2; const char* cB = (const char*)g.Bt + (size_t)cur.pn * tstep + (size_t)cur.k0 * 2;
    S.a_ready(cur);
    if constexpr (SP2) {
        PG8_STAGE(PG8_SB(0, 0), cB, voffB); PG8_STAGE(PG8_SB(0, 1), cB + hstep, voffB); PG8_STAGE(PG8_SA(0, 0), cA, voffA); PG8_STAGE(PG8_SA(0, 1), cA + hstep, voffA);
        if (wr == 1) PG8_BAR;
        PG8_WAIT_V(2); PG8_BAR;
        PG8_STAGE(PG8_SB(1, 0), cB + kstep, voffB); PG8_STAGE(PG8_SA(1, 0), cA + kstep, voffA); PG8_STAGE(PG8_SB(1, 1), cB + hstep + kstep, voffB);
        PG8_WAIT_V(6); PG8_BAR;
    } else {
        PG8_STAGE(PG8_SB(0, 0), cB, voffB); PG8_STAGE(PG8_SA(0, 0), cA, voffA); PG8_STAGE(PG8_SB(0, 1), cB + hstep, voffB); PG8_STAGE(PG8_SA(0, 1), cA + hstep, voffA);
        if (wr == 1) PG8_BAR;
        PG8_WAIT_V(4); PG8_BAR;
        PG8_STAGE(PG8_SB(1, 0), cB + kstep, voffB); PG8_STAGE(PG8_SA(1, 0), cA + kstep, voffA); PG8_STAGE(PG8_SB(1, 1), cB + hstep + kstep, voffB);
        PG8_WAIT_V(6); PG8_BAR;
    }
    for (;;) {
        const bool has_next = S.next(ui + 1, nxt);
        const char* nA = has_next ? (const char*)g.A + (size_t)nxt.pm * tstep + (size_t)nxt.k0 * 2 : cA; const char* nB = has_next ? (const char*)g.Bt + (size_t)nxt.pn * tstep + (size_t)nxt.k0 * 2 : cB;
        for (int t = 0; t < nt; t += 2) {
            const bool last = (t == nt - 2);
            const char* a1 = cA + (size_t)(t + 1) * kstep;
            const char* a2 = last ? nA : cA + (size_t)(t + 2) * kstep; const char* b2 = last ? nB : cB + (size_t)(t + 2) * kstep;
            const char* a3 = a2 + kstep; const char* b3 = b2 + kstep;
            if (last && has_next) S.a_ready(nxt);
            if constexpr (SP2) {
            PG8_LDB(B0, 0, 0); PG8_LDB(B1, 0, 1); PG8_SCHED; PG8_LDA(At, 0, 0); PG8_STAGE(PG8_SA(1, 1), a1 + hstep, voffA);
            PG8_WAIT_V(8); PG8_WAIT_L(0); PG8_BAR; PG8_MMA(0, 0, At, B0); PG8_MMA(0, 1, At, B1); PG8_BAR; PG8_SCHED;
            PG8_LDA(At, 0, 1); PG8_STAGE(PG8_SB(0, 0), b2, voffB); PG8_STAGE(PG8_SB(0, 1), b2 + hstep, voffB); PG8_STAGE(PG8_SA(0, 0), a2, voffA);
            PG8_WAIT_V(8); PG8_WAIT_L(0); PG8_BAR; PG8_MMA(1, 0, At, B0); PG8_MMA(1, 1, At, B1); PG8_BAR; PG8_SCHED;
            PG8_LDB(B0, 1, 0); PG8_LDB(B1, 1, 1); PG8_SCHED; PG8_LDA(At, 1, 0); PG8_STAGE(PG8_SA(0, 1), a2 + hstep, voffA);
            PG8_WAIT_V(8); PG8_WAIT_L(0); PG8_BAR; PG8_MMA(0, 0, At, B0); PG8_MMA(0, 1, At, B1); PG8_BAR; PG8_SCHED;
            PG8_LDA(At, 1, 1); PG8_STAGE(PG8_SB(1, 0), b3, voffB); PG8_STAGE(PG8_SB(1, 1), b3 + hstep, voffB); PG8_STAGE(PG8_SA(1, 0), a3, voffA);
            PG8_WAIT_V(8); PG8_WAIT_L(0); PG8_BAR; PG8_MMA(1, 0, At, B0); PG8_MMA(1, 1, At, B1); PG8_BAR; PG8_SCHED;
            } else {
            PG8_LDB(B0, 0, 0); PG8_SCHED; PG8_LDA(At, 0, 0); PG8_STAGE(PG8_SA(1, 1), a1 + hstep, voffA);
            PG8_WAIT_L(8); PG8_BAR; PG8_WAIT_L(0); PG8_MMA(0, 0, At, B0); PG8_BAR; PG8_SCHED;
            PG8_LDB(B1, 0, 1); PG8_STAGE(PG8_SB(0, 0), b2, voffB);
            PG8_BAR; PG8_WAIT_L(0); PG8_MMA(0, 1, At, B1); PG8_BAR;
            PG8_LDA(At, 0, 1); PG8_STAGE(PG8_SA(0, 0), a2, voffA);
            PG8_BAR; PG8_WAIT_L(0); PG8_MMA(1, 0, At, B0); PG8_BAR; PG8_SCHED;
            PG8_STAGE(PG8_SB(0, 1), b2 + hstep, voffB);
            PG8_WAIT_V(6); PG8_BAR; PG8_MMA(1, 1, At, B1); PG8_BAR;
            PG8_LDB(B0, 1, 0); PG8_SCHED; PG8_LDA(At, 1, 0); PG8_STAGE(PG8_SA(0, 1), a2 + hstep, voffA);
            PG8_WAIT_L(8); PG8_BAR; PG8_WAIT_L(0); PG8_MMA(0, 0, At, B0); PG8_BAR; PG8_SCHED;
            PG8_LDB(B1, 1, 1); PG8_STAGE(PG8_SB(1, 0), b3, voffB);
            PG8_BAR; PG8_WAIT_L(0); PG8_MMA(0, 1, At, B1); PG8_BAR;
            PG8_LDA(At, 1, 1); PG8_STAGE(PG8_SA(1, 0), a3, voffA);
            PG8_BAR; PG8_WAIT_L(0); PG8_MMA(1, 0, At, B0); PG8_BAR; PG8_SCHED;
            PG8_STAGE(PG8_SB(1, 1), b3 + hstep, voffB);
            PG8_WAIT_V(6); PG8_BAR; PG8_MMA(1, 1, At, B1); PG8_BAR;
            }
        }
        if constexpr (ALIGN_EPI) { if (wr == 0) PG8_BAR; }
        if constexpr (!Epi::AFTER_DRAIN) { E(acc, cur, wr, wc, fr, fq); S.done(cur); }
        if (!has_next) break;
#pragma unroll
        for (int a = 0; a < 2; ++a)
#pragma unroll
            for (int b = 0; b < 2; ++b)
#pragma unroll
                for (int m = 0; m < 4; ++m)
#pragma unroll
                    for (int n = 0; n < 2; ++n) acc[a][b][m][n] = (f32x4){0.f, 0.f, 0.f, 0.f};
        cur = nxt; cA = nA; cB = nB; ++ui;
        if constexpr (ALIGN_EPI) { if (wr == 1) PG8_BAR; }
    }
    PG8_WAIT_V(0);
    if constexpr (!ALIGN_EPI) { if (wr == 0) PG8_BAR; }
    PG8_BAR;
    if constexpr (Epi::AFTER_DRAIN) { E.fused(acc, cur, wr, wc, fr, fq, lds, wid, lane); S.done(cur); }
#undef PG8_SA
#undef PG8_SB
#undef PG8_STAGE
#undef PG8_LDA
#undef PG8_LDB
#undef PG8_MMA
#undef PG8_WAIT_V
#undef PG8_WAIT_L
#undef PG8_BAR
#undef PG8_SCHED
}
}
#define XB_TMO      128
#define XB_XCNT(j)  (256  + 64 * (j))
#define XB_XSUB(j)  (1280 + 64 * (j))
#define XB_XGEN(j)  (2304 + 64 * (j))
#define XB_TOP      3328
#define XB_TOPGEN   3392
#define XCD_BAR_WORDS 3456
#define XB_SPIN_CAP (1u << 24)
#define LAS __attribute__((address_space(3)))

__device__ __forceinline__ unsigned xb_ld(unsigned* p)              { return __hip_atomic_load(p, __ATOMIC_RELAXED, __HIP_MEMORY_SCOPE_AGENT); }
__device__ __forceinline__ unsigned xb_add(unsigned* p, unsigned v) { return __hip_atomic_fetch_add(p, v, __ATOMIC_RELAXED, __HIP_MEMORY_SCOPE_AGENT); }
__device__ __forceinline__ unsigned xb_xcc_id() { return (unsigned)__builtin_amdgcn_s_getreg((3 << 11) | 20) & 0xFu; }
#define XB_SPIN(cond, bar) do { unsigned _sp = 0; while (cond) { __builtin_amdgcn_s_sleep(1); \
    if ((++_sp & 255u) == 0u) { if (xb_ld(&(bar)[XB_TMO])) break; if (_sp > XB_SPIN_CAP) { atomicAdd(&(bar)[XB_TMO], 1u); break; } } } } while (0)

struct XcdBarrier {
    unsigned* bar; unsigned x;
    volatile LAS unsigned* st;
};

__device__ __forceinline__ XcdBarrier xcd_barrier_post(unsigned* bar, volatile LAS unsigned* st) {
    XcdBarrier b; b.bar = bar; b.x = xb_xcc_id(); b.st = st;
    if (threadIdx.x == 0) (void)xb_add(&bar[XB_XCNT(b.x)], 1u);
    return b;
}
__device__ __forceinline__ void xcd_barrier_complete(unsigned* bar, unsigned x, unsigned& nloc, unsigned& nx) {
    const unsigned G = gridDim.x * gridDim.y * gridDim.z;
    unsigned sum, cnt, mine, sp = 0u;
    for (;;) {
        sum = 0u; cnt = 0u; mine = 0u;
#pragma unroll
        for (unsigned j = 0; j < 16; ++j) { const unsigned c = xb_ld(&bar[XB_XCNT(j)]); sum += c; cnt += (c > 0u) ? 1u : 0u; mine = (j == x) ? c : mine; }
        if (sum == G) break;
        __builtin_amdgcn_s_sleep(1);
        if ((++sp & 255u) == 0u) { if (xb_ld(&bar[XB_TMO])) break; if (sp > XB_SPIN_CAP) { atomicAdd(&bar[XB_TMO], 1u); break; } }
    }
    nloc = mine > 0u ? mine : 1u; nx = cnt > 0u ? cnt : 1u;
}

__device__ __forceinline__ void xcd_barrier(const XcdBarrier& b) {
    asm volatile("s_waitcnt vmcnt(0)" ::: "memory");
    __syncthreads();
    if (threadIdx.x == 0) {
        unsigned* bar = b.bar;
        __builtin_amdgcn_s_waitcnt(0);
        unsigned nloc = b.st[0], nx = b.st[1];
        if (nloc == 0u) { xcd_barrier_complete(bar, b.x, nloc, nx); b.st[0] = nloc; b.st[1] = nx; }
        const unsigned old = xb_add(&bar[XB_XSUB(b.x)], 1u);
        const unsigned gen = old / nloc;
        if (old + 1u == (gen + 1u) * nloc) {
            __builtin_amdgcn_fence(__ATOMIC_RELEASE, "agent");
            asm volatile("s_waitcnt vmcnt(0)" ::: "memory");
            const unsigned og = xb_add(&bar[XB_TOP], 1u);
            const unsigned tg = og / nx;
            if (og + 1u == (tg + 1u) * nx) xb_add(&bar[XB_TOPGEN], 1u);
            else XB_SPIN(xb_ld(&bar[XB_TOPGEN]) == tg, bar);
            __builtin_amdgcn_fence(__ATOMIC_ACQUIRE, "agent");
            xb_add(&bar[XB_XGEN(b.x)], 1u);
            asm volatile("s_waitcnt vmcnt(0)" ::: "memory");
        } else {
            XB_SPIN(xb_ld(&bar[XB_XGEN(b.x)]) == gen, bar);
            __builtin_amdgcn_fence(__ATOMIC_ACQUIRE, "agent");
            asm volatile("s_waitcnt vmcnt(0)" ::: "memory");
        }
    }
    __syncthreads();
}


typedef unsigned short bf16_t;
typedef float f32x4 __attribute__((ext_vector_type(4)));
typedef unsigned u32x2 __attribute__((ext_vector_type(2)));
typedef unsigned u32x4 __attribute__((ext_vector_type(4)));
constexpr int TP = 32768, TS = 1024, T = 33792, D = 1024, FF = 2816, NGU = 5632, PSTR = 3104, NPIN = 3328;
constexpr int PQ = 0, PK = 384, PV = 768, PZA = 1152, PZB = 1536, PXBC = 1920, PGC = 2560, PXC = 2816, PBA = 3072, PAA = 3078, PDT = 3084;
constexpr size_t SZ_WGU = (size_t)NGU * D * 2, SZ_WDN = (size_t)D * FF * 2, SZ_WIN = (size_t)NPIN * D * 2, SZ_WOUT = (size_t)D * D * 2;
constexpr size_t WS_CTL = 0, WS_WGU = 65536, WS_WDN = WS_WGU + 4 * SZ_WGU, WS_WIN = WS_WDN + 4 * SZ_WDN, WS_WOUT = WS_WIN + 2 * SZ_WIN,
                 WS_H = WS_WOUT + 2 * SZ_WOUT, WS_P = WS_H + (size_t)T * D * 2, WS_M = WS_P + (size_t)T * PSTR * 2;
constexpr size_t WS_END = WS_M + (size_t)160 * 1024 * 1024;
constexpr size_t O_PDS = (size_t)T * D, O_PDC = O_PDS + 2 * 2 * 6 * 4096, O_PSH = O_PDC + 2 * 2 * 3 * 1152, O_PSC = O_PSH + 2 * 2 * 6 * 4096, O_PLH = O_PSC + 2 * 2 * 3 * 640,
                 O_PLC = O_PLH + 2 * 2 * 256, O_SDS = O_PLC + 2 * 2 * 3 * 256, O_SDC = O_SDS + 2 * 16 * 6 * 4096, O_SSH = O_SDC + 2 * 16 * 3 * 1152, O_SSC = O_SSH + 2 * 16 * 6 * 4096,
                 O_SLH = O_SSC + 2 * 16 * 3 * 640, O_SLC = O_SLH + 2 * 16 * 256, O_END = O_SLC + 2 * 16 * 3 * 256;
constexpr int LDS_BYTES = 148 * 1024;
constexpr int MISC_OFF = 144 * 1024;

__device__ __forceinline__ int tidx() { int t = threadIdx.x; asm volatile("" : "+v"(t)); return t; }
struct Args { const float* in[37]; float* out; unsigned char* ws; int ph_lo, ph_hi; };
typedef __attribute__((address_space(4))) Args CArgs;
#define INP(a, k) ((a).in[k])
#define OUTP(a) ((a).out)
#define WSP(a) ((a).ws)

__device__ __forceinline__ float bf2f(bf16_t b) { return __uint_as_float(((unsigned)b) << 16); }
__device__ __forceinline__ bf16_t f2bf(float f) { unsigned u = __float_as_uint(f); u += 0x7FFFu + ((u >> 16) & 1u); return (bf16_t)(u >> 16); }
__device__ __forceinline__ unsigned pk_bf16(float lo, float hi) { return (unsigned)f2bf(lo) | ((unsigned)f2bf(hi) << 16); }
__device__ __forceinline__ float sigmoid_f(float x) { return __builtin_amdgcn_rcpf(1.0f + __expf(-x)); }
__device__ __forceinline__ float softplus_f(float x) { return fmaxf(x, 0.f) + log1pf(__expf(-fabsf(x))); }
__device__ __forceinline__ float siluf(float x) { return x * __builtin_amdgcn_rcpf(1.0f + __expf(-x)); }
__device__ __forceinline__ float gelu_tanh(float x) { const float u = 0.7978845608028654f * (x + 0.044715f * x * x * x); return 0.5f * x * (1.0f + tanhf(u)); }
__device__ __forceinline__ float one_minus_exp(float t) { const float p = -t * (1.0f + t * (0.5f + t * (0.16666667f + t * 0.041666668f))); return t > -0.03125f ? p : 1.0f - __expf(t); }
__device__ __forceinline__ float wave_sum(float v) {
#pragma unroll
    for (int o = 32; o >= 1; o >>= 1) v += __shfl_xor(v, o);
    return v; }
__device__ __forceinline__ float rdlane(float v, int l) { return __int_as_float(__builtin_amdgcn_readlane(__float_as_int(v), l)); }
__device__ __forceinline__ float* state_out(float* out, size_t base_p, size_t base_s, int l, int s, size_t sz) { return s < 2 ? out + base_p + ((size_t)l * 2 + s) * sz : out + base_s + ((size_t)l * 16 + (s - 2)) * sz; }
__device__ __forceinline__ int seq_len(int s) { return s < 2 ? 16384 : 64; }
__device__ __forceinline__ size_t seq_row0(int s) { return s < 2 ? (size_t)s * 16384 : (size_t)TP + (size_t)(s - 2) * 64; }

__device__ __forceinline__ int win_refcol(int c) {
    if (c < 1536) return c;
    if (c < 1920) return 1548 + (c - 1536);
    if (c < 2560) return 1932 + (c - 1920);
    if (c < 2816) return 2578 + (c - 2560);
    if (c < 3072) return 2834 + (c - 2816);
    if (c < 3078) return 1536 + (c - 3072);
    if (c < 3084) return 1542 + (c - 3078);
    if (c < 3090) return 2572 + (c - 3084);
    return -1; }
struct WTile { const float* src; const float* gain; bf16_t* dst; int K, ldw, rho0, k0, col; };
__device__ __forceinline__ void wprep_decode(const CArgs& a, int id, int tid, WTile& t) {
    constexpr int PER_LAYER = 1408 * 2 + 704 * 2 + 832 + 256;
    const int l = id / PER_LAYER; int r = id % PER_LAYER; int kind; const float* w0; const float* w1 = nullptr; t.gain = nullptr;
    if (r < 2816) { const int f = r / 1408; r %= 1408; kind = 0; t.K = D; t.ldw = FF; w0 = INP(a, f ? 33 : 9) + (size_t)l * D * FF; w1 = INP(a, f ? 34 : 10) + (size_t)l * D * FF; t.gain = INP(a, f ? 32 : 8) + (size_t)l * D; t.dst = (bf16_t*)(WSP(a) + WS_WGU + (size_t)(l * 2 + f) * SZ_WGU); }
    else if (r < 4224) { r -= 2816; const int f = r / 704; r %= 704; kind = 1; t.K = FF; t.ldw = D; w0 = INP(a, f ? 35 : 11) + (size_t)l * FF * D; t.dst = (bf16_t*)(WSP(a) + WS_WDN + (size_t)(l * 2 + f) * SZ_WDN); }
    else if (r < 5056) { r -= 4224; kind = 2; t.K = D; t.ldw = 3090; w0 = INP(a, 13) + (size_t)l * D * 3090; t.gain = INP(a, 12) + (size_t)l * D; t.dst = (bf16_t*)(WSP(a) + WS_WIN + (size_t)l * SZ_WIN); }
    else { r -= 5056; kind = 1; t.K = D; t.ldw = D; w0 = INP(a, 31) + (size_t)l * D * D; t.dst = (bf16_t*)(WSP(a) + WS_WOUT + (size_t)l * SZ_WOUT); }
    const int ktiles = t.K / 64; t.rho0 = (r / ktiles) * 64; t.k0 = (r % ktiles) * 64;
    const int rho = t.rho0 + (tid & 63); t.src = w0; t.col = rho;
    if (kind == 0) { const int U = rho >> 8, uu = (rho >> 7) & 1, i = rho & 127; t.src = uu ? w1 : w0; t.col = 128 * U + i; }
    else if (kind == 2) t.col = win_refcol(rho);
}
__device__ __forceinline__ void wprep_load(const WTile& t, int tid, float (&v)[8]) {
    const int kk0 = tid >> 6;
#pragma unroll
    for (int j = 0; j < 8; ++j) { const int kk = kk0 + 8 * j; v[j] = t.col >= 0 ? t.src[(size_t)(t.k0 + kk) * t.ldw + t.col] * (t.gain ? t.gain[t.k0 + kk] : 1.0f) : 0.f; }
}
__device__ void wprep_phase(const CArgs& a, LAS unsigned char* lds) {
    LAS float* tile = (LAS float*)lds;
    const int tid = tidx(); constexpr int NT = 2 * (1408 * 2 + 704 * 2 + 832 + 256);
    int id = blockIdx.x; if (id >= NT) return;
    WTile cur, nxt; float v[8];
    wprep_decode(a, id, tid, cur); wprep_load(cur, tid, v);
    for (; id < NT; id += gridDim.x) {
        {   const int rr = tid & 63, kk0 = tid >> 6;
#pragma unroll
            for (int j = 0; j < 8; ++j) tile[(kk0 + 8 * j) * 65 + rr] = v[j]; }
        __syncthreads();
        const bool more = id + (int)gridDim.x < NT;
        if (more) { wprep_decode(a, id + gridDim.x, tid, nxt); wprep_load(nxt, tid, v); }
        {   const int rr = tid >> 3, ks = tid & 7; float o[8];
#pragma unroll
            for (int e = 0; e < 8; ++e) o[e] = tile[(ks * 8 + e) * 65 + rr];
            u32x4 w; w.x = pk_bf16(o[0], o[1]); w.y = pk_bf16(o[2], o[3]); w.z = pk_bf16(o[4], o[5]); w.w = pk_bf16(o[6], o[7]);
            *(u32x4*)(cur.dst + (size_t)(cur.rho0 + rr) * cur.K + cur.k0 + ks * 8) = w; }
        __syncthreads();
        cur = nxt;
    }
}

constexpr int XSPLIT = T / 2;
constexpr size_t WS_RS = WS_M + (size_t)70 * 1024 * 1024;
__device__ void norm_phase(const CArgs& a, const float* gain, int mode) {
    float* Y = OUTP(a); bf16_t* XB = (bf16_t*)OUTP(a); float* RS = (float*)(WSP(a) + WS_RS); const bf16_t* XF = (const bf16_t*)(WSP(a) + WS_H);
    const int lane = tidx() & 63, gw = blockIdx.x * 8 + (tidx() >> 6), nw = gridDim.x * 8;
    f32x4 g[4];
#pragma unroll
    for (int j = 0; j < 4; ++j) g[j] = mode == 2 ? *(const f32x4*)(gain + j * 256 + lane * 4) : (f32x4){1.f, 1.f, 1.f, 1.f};
    for (int row0 = gw; row0 < T; row0 += 2 * nw) {
        f32x4 v[2][4]; float ss[2] = {0.f, 0.f};
#pragma unroll
        for (int q = 0; q < 2; ++q) { const int row = row0 + q * nw; if (row < T) {
            if (mode == 0) { const float* src = row < TP ? INP(a, 0) + (size_t)row * D : INP(a, 1) + (size_t)(row - TP) * D;
#pragma unroll
                for (int j = 0; j < 4; ++j) v[q][j] = *(const f32x4*)(src + j * 256 + lane * 4); }
            else {
#pragma unroll
                for (int j = 0; j < 4; ++j) { const u32x2 x = *(const u32x2*)(XF + (size_t)row * D + j * 256 + lane * 4);
                    v[q][j] = (f32x4){__uint_as_float(x.x << 16), __uint_as_float(x.x & 0xffff0000u), __uint_as_float(x.y << 16), __uint_as_float(x.y & 0xffff0000u)}; } } } }
#pragma unroll
        for (int q = 0; q < 2; ++q) { const int row = row0 + q * nw; if (row < T) {
#pragma unroll
            for (int j = 0; j < 4; ++j) ss[q] += v[q][j][0] * v[q][j][0] + v[q][j][1] * v[q][j][1] + v[q][j][2] * v[q][j][2] + v[q][j][3] * v[q][j][3];
            ss[q] = wave_sum(ss[q]);
            if (mode == 0) { if (lane < 16) RS[(size_t)lane * T + row] = lane == 0 ? ss[q] : 0.f; }
            const float r = rsqrtf(ss[q] * (1.0f / D) + 1e-6f);
#pragma unroll
            for (int j = 0; j < 4; ++j) {
                if (mode == 0) { u32x2 w; w.x = pk_bf16(v[q][j][0], v[q][j][1]); w.y = pk_bf16(v[q][j][2], v[q][j][3]); *(u32x2*)(XB + (size_t)row * D + j * 256 + lane * 4) = w; }
                else *(f32x4*)(Y + (size_t)row * D + j * 256 + lane * 4) = v[q][j] * r * g[j];
            } } }
    }
}

constexpr size_t WS_SLAB = WS_M + (size_t)80 * 1024 * 1024;
template <int NSL> __device__ __forceinline__ void sample_reduce_phase(const CArgs& a, float scale, bool last, float* RS) {
    bf16_t* XB = (bf16_t*)OUTP(a); bf16_t* XO = last ? (bf16_t*)(WSP(a) + WS_H) : XB; const float* SL = (const float*)(WSP(a) + WS_SLAB);
    const int lane = tidx() & 63, gw = blockIdx.x * 8 + (tidx() >> 6);
    if (gw >= TS) return;
    const size_t row = (size_t)TP + gw; float ss = 0.f;
#pragma unroll
    for (int jh = 0; jh < 2; ++jh) { f32x4 v[2][NSL]; u32x2 xb[2];
#pragma unroll
        for (int jj = 0; jj < 2; ++jj) { const int c = (2 * jh + jj) * 256 + lane * 4; xb[jj] = *(const u32x2*)(XB + row * D + c);
#pragma unroll
            for (int k = 0; k < NSL; ++k) v[jj][k] = *(const f32x4*)(SL + ((size_t)k * TS + gw) * D + c); }
#pragma unroll
        for (int jj = 0; jj < 2; ++jj) { const int c = (2 * jh + jj) * 256 + lane * 4; f32x4 s = v[jj][0];
#pragma unroll
            for (int k = 1; k < NSL; ++k) s += v[jj][k];
            const f32x4 x = {__uint_as_float(xb[jj].x << 16), __uint_as_float(xb[jj].x & 0xffff0000u), __uint_as_float(xb[jj].y << 16), __uint_as_float(xb[jj].y & 0xffff0000u)};
            const f32x4 o = x + scale * s;
            { u32x2 w; w.x = pk_bf16(o[0], o[1]); w.y = pk_bf16(o[2], o[3]); *(u32x2*)(XO + row * D + c) = w;
                const float r0 = __uint_as_float(w.x << 16), r1 = __uint_as_float(w.x & 0xffff0000u), r2 = __uint_as_float(w.y << 16), r3 = __uint_as_float(w.y & 0xffff0000u);
                ss += r0 * r0 + r1 * r1 + r2 * r2 + r3 * r3; } } }
    ss = wave_sum(ss);
    if (lane < 16) RS[(size_t)lane * T + row] = lane == 0 ? ss : 0.f;
}

__device__ __forceinline__ float ldp(const bf16_t* P, size_t row, int col) { return bf2f(P[row * PSTR + col]); }

__device__ void naive_delta_chain(const CArgs& a, int l, int s, int h, int lane) {
    const bf16_t* P = (const bf16_t*)(WSP(a) + WS_P); bf16_t* MIX = (bf16_t*)(WSP(a) + WS_H);
    const int L = seq_len(s); const size_t row0 = seq_row0(s);
    float S[64]; float hq[3], hk[3], hv[3];
    if (s < 2) {
#pragma unroll
        for (int i = 0; i < 64; ++i) S[i] = 0.f;
#pragma unroll
        for (int j = 0; j < 3; ++j) { hq[j] = 0.f; hk[j] = 0.f; hv[j] = 0.f; }
    } else {
        const int sb = s - 2; const float* s0 = INP(a, 2) + (((size_t)l * 16 + sb) * 6 + h) * 4096;
#pragma unroll
        for (int i = 0; i < 64; ++i) S[i] = s0[i * 64 + lane];
        const float* cb = INP(a, 3) + ((size_t)l * 16 + sb) * 3 * 1152;
#pragma unroll
        for (int j = 0; j < 3; ++j) { hq[j] = cb[j * 1152 + PQ + h * 64 + lane]; hk[j] = cb[j * 1152 + PK + h * 64 + lane]; hv[j] = cb[j * 1152 + PV + h * 64 + lane]; }
    }
    const float* cw = INP(a, 14) + (size_t)l * 4 * 1152;
    float wq[4], wk[4], wv[4];
#pragma unroll
    for (int k = 0; k < 4; ++k) { wq[k] = cw[k * 1152 + PQ + h * 64 + lane]; wk[k] = cw[k * 1152 + PK + h * 64 + lane]; wv[k] = cw[k * 1152 + PV + h * 64 + lane]; }
    const float Aexp = __expf(INP(a, 15)[l * 6 + h]), dtb = INP(a, 16)[l * 6 + h], nw = INP(a, 17)[l * 64 + lane];
    float nq = ldp(P, row0, PQ + h * 64 + lane), nk = ldp(P, row0, PK + h * 64 + lane), nv = ldp(P, row0, PV + h * 64 + lane);
    float nb = ldp(P, row0, PBA + h), na = ldp(P, row0, PAA + h), nz = ldp(P, row0, PZA + h * 64 + lane);
    for (int t = 0; t < L; ++t) {
        const size_t row = row0 + t;
        const float xq = nq, xk = nk, xv = nv, xb = nb, xa = na, xz = nz;
        { const size_t rn = row0 + (t + 1 < L ? t + 1 : t);
          nq = ldp(P, rn, PQ + h * 64 + lane); nk = ldp(P, rn, PK + h * 64 + lane); nv = ldp(P, rn, PV + h * 64 + lane);
          nb = ldp(P, rn, PBA + h); na = ldp(P, rn, PAA + h); nz = ldp(P, rn, PZA + h * 64 + lane); }
        float q = siluf(wq[0] * hq[0] + wq[1] * hq[1] + wq[2] * hq[2] + wq[3] * xq);
        float k = siluf(wk[0] * hk[0] + wk[1] * hk[1] + wk[2] * hk[2] + wk[3] * xk);
        const float v = siluf(wv[0] * hv[0] + wv[1] * hv[1] + wv[2] * hv[2] + wv[3] * xv);
        hq[0] = hq[1]; hq[1] = hq[2]; hq[2] = xq; hk[0] = hk[1]; hk[1] = hk[2]; hk[2] = xk; hv[0] = hv[1]; hv[1] = hv[2]; hv[2] = xv;
        q *= rsqrtf(wave_sum(q * q) + 1e-6f) * 0.125f;
        k *= rsqrtf(wave_sum(k * k) + 1e-6f);
        const float beta = sigmoid_f(xb), alpha = __expf(-Aexp * softplus_f(xa + dtb));
        float kS = 0.f;
#pragma unroll
        for (int i = 0; i < 64; ++i) kS += rdlane(k, i) * S[i];
        const float dl = beta * (v - alpha * kS);
        float o = 0.f;
#pragma unroll
        for (int i = 0; i < 64; ++i) { S[i] = alpha * S[i] + rdlane(k, i) * dl; o += rdlane(q, i) * S[i]; }
        const float ms = wave_sum(o * o) * (1.0f / 64.f);
        MIX[row * D + h * 64 + lane] = f2bf(o * rsqrtf(ms + 1e-6f) * nw * siluf(xz));
    }
    float* so = state_out(OUTP(a), O_PDS, O_SDS, l, s, 6 * 4096) + (size_t)h * 4096;
#pragma unroll
    for (int i = 0; i < 64; ++i) so[i * 64 + lane] = S[i];
    float* co = state_out(OUTP(a), O_PDC, O_SDC, l, s, 3 * 1152);
#pragma unroll
    for (int j = 0; j < 3; ++j) { co[j * 1152 + PQ + h * 64 + lane] = hq[j]; co[j * 1152 + PK + h * 64 + lane] = hk[j]; co[j * 1152 + PV + h * 64 + lane] = hv[j]; }
}

__device__ void naive_ssd_block(const CArgs& a, int l, int s, int g, LAS float* red) {
    const bf16_t* P = (const bf16_t*)(WSP(a) + WS_P); bf16_t* MIX = (bf16_t*)(WSP(a) + WS_H);
    const int tid = tidx(), hh = tid >> 6, p = tid & 63, head = g * 3 + (hh < 3 ? hh : 0); const bool act = tid < 192;
    const int L = seq_len(s); const size_t row0 = seq_row0(s);
    const int cx = head * 64 + p, cB = 384 + g * 64 + p, cC = 512 + g * 64 + p;
    float hst[64]; float hx[3], hB[3], hC[3];
    if (s < 2 || !act) {
#pragma unroll
        for (int i = 0; i < 64; ++i) hst[i] = 0.f;
#pragma unroll
        for (int j = 0; j < 3; ++j) { hx[j] = 0.f; hB[j] = 0.f; hC[j] = 0.f; }
    } else {
        const int sb = s - 2; const float* s0 = INP(a, 4) + (((size_t)l * 16 + sb) * 6 + head) * 4096;
#pragma unroll
        for (int i = 0; i < 64; ++i) hst[i] = s0[i * 64 + p];
        const float* cb = INP(a, 5) + ((size_t)l * 16 + sb) * 3 * 640;
#pragma unroll
        for (int j = 0; j < 3; ++j) { hx[j] = cb[j * 640 + cx]; hB[j] = cb[j * 640 + cB]; hC[j] = cb[j * 640 + cC]; }
    }
    const float* cw = INP(a, 18) + (size_t)l * 4 * 640; const float* cbias = INP(a, 19) + (size_t)l * 640;
    float wx[4], wB[4], wC[4];
#pragma unroll
    for (int k = 0; k < 4; ++k) { wx[k] = cw[k * 640 + cx]; wB[k] = cw[k * 640 + cB]; wC[k] = cw[k * 640 + cC]; }
    const float bx = cbias[cx], bB = cbias[cB], bC = cbias[cC];
    const float Aneg = -__expf(INP(a, 20)[l * 6 + head]), dtb = INP(a, 21)[l * 6 + head], dsk = INP(a, 22)[l * 6 + head], nw = INP(a, 23)[l * 384 + g * 192 + (hh < 3 ? hh : 0) * 64 + p];
    for (int t = 0; t < L; ++t) {
        const size_t row = row0 + t;
        float y = 0.f, xs = 0.f;
        if (act) {
            const float rx = ldp(P, row, PXBC + cx), rB = ldp(P, row, PXBC + cB), rC = ldp(P, row, PXBC + cC);
            xs = siluf(wx[0] * hx[0] + wx[1] * hx[1] + wx[2] * hx[2] + wx[3] * rx + bx);
            const float Bn = siluf(wB[0] * hB[0] + wB[1] * hB[1] + wB[2] * hB[2] + wB[3] * rB + bB);
            const float Cn = siluf(wC[0] * hC[0] + wC[1] * hC[1] + wC[2] * hC[2] + wC[3] * rC + bC);
            hx[0] = hx[1]; hx[1] = hx[2]; hx[2] = rx; hB[0] = hB[1]; hB[1] = hB[2]; hB[2] = rB; hC[0] = hC[1]; hC[1] = hC[2]; hC[2] = rC;
            const float dt = softplus_f(ldp(P, row, PDT + head) + dtb), dA = __expf(dt * Aneg), dx = dt * xs;
#pragma unroll
            for (int i = 0; i < 64; ++i) { hst[i] = dA * hst[i] + rdlane(Bn, i) * dx; y += rdlane(Cn, i) * hst[i]; }
            y += dsk * xs;
            y *= siluf(ldp(P, row, PZB + head * 64 + p));
            const float sq = wave_sum(y * y);
            if (p == 0) red[hh] = sq;
        }
        __syncthreads();
        if (act) {
            const float ms = (red[0] + red[1] + red[2]) * (1.0f / 192.f);
            MIX[row * D + 384 + g * 192 + hh * 64 + p] = f2bf(y * rsqrtf(ms + 1e-6f) * nw);
        }
        __syncthreads();
    }
    if (act) {
        float* so = state_out(OUTP(a), O_PSH, O_SSH, l, s, 6 * 4096) + (size_t)head * 4096;
#pragma unroll
        for (int i = 0; i < 64; ++i) so[i * 64 + p] = hst[i];
        float* co = state_out(OUTP(a), O_PSC, O_SSC, l, s, 3 * 640);
#pragma unroll
        for (int j = 0; j < 3; ++j) { co[j * 640 + cx] = hx[j]; if (hh == 0) { co[j * 640 + cB] = hB[j]; co[j * 640 + cC] = hC[j]; } }
    }
}

__device__ void naive_lru_block(const CArgs& a, int l, int s, LAS float* xsh) {
    const bf16_t* P = (const bf16_t*)(WSP(a) + WS_P); bf16_t* MIX = (bf16_t*)(WSP(a) + WS_H);
    const int tid = tidx(), ch = tid & 255; const bool act = tid < 256;
    const int L = seq_len(s); const size_t row0 = seq_row0(s);
    float hx[3] = {0.f, 0.f, 0.f}, h = 0.f;
    if (s >= 2) { const int sb = s - 2; h = INP(a, 6)[((size_t)l * 16 + sb) * 256 + ch]; const float* cb = INP(a, 7) + ((size_t)l * 16 + sb) * 3 * 256;
#pragma unroll
        for (int j = 0; j < 3; ++j) hx[j] = cb[j * 256 + ch]; }
    const float* cw = INP(a, 24) + (size_t)l * 4 * 256; float w[4];
#pragma unroll
    for (int k = 0; k < 4; ++k) w[k] = cw[k * 256 + ch];
    const float cb0 = INP(a, 25)[l * 256 + ch], br = INP(a, 27)[l * 256 + ch], bi = INP(a, 29)[l * 256 + ch];
    const float spl = softplus_f(-INP(a, 30)[l * 256 + ch]);
    const int blk = ch >> 5, d = ch & 31;
    const float* wr = INP(a, 26) + ((size_t)l * 8 + blk) * 1024 + d; const float* wi = INP(a, 28) + ((size_t)l * 8 + blk) * 1024 + d;
    for (int t = 0; t < L; ++t) {
        const size_t row = row0 + t; float xc = 0.f;
        if (act) { const float rx = ldp(P, row, PXC + ch); xc = w[0] * hx[0] + w[1] * hx[1] + w[2] * hx[2] + w[3] * rx + cb0; hx[0] = hx[1]; hx[1] = hx[2]; hx[2] = rx; xsh[ch] = xc; }
        __syncthreads();
        if (act) {
            float r = br, ig = bi;
#pragma unroll 8
            for (int c = 0; c < 32; ++c) { const float xv = xsh[blk * 32 + c]; r += xv * wr[c * 32]; ig += xv * wi[c * 32]; }
            const float log_a = -8.0f * sigmoid_f(r) * spl, av = __expf(log_a), bv = sqrtf(-expm1f(2.0f * log_a)) * (sigmoid_f(ig) * xc);
            h = av * h + bv;
            MIX[row * D + 768 + ch] = f2bf(h * gelu_tanh(ldp(P, row, PGC + ch)));
        }
        __syncthreads();
    }
    if (act) {
        state_out(OUTP(a), O_PLH, O_SLH, l, s, 256)[ch] = h;
        float* co = state_out(OUTP(a), O_PLC, O_SLC, l, s, 3 * 256);
#pragma unroll
        for (int j = 0; j < 3; ++j) co[j * 256 + ch] = hx[j];
    }
}

__device__ void naive_mixer_phase(const CArgs& a, int l, LAS unsigned char* lds) {
    const int b = blockIdx.x, tid = tidx();
    if (b < 108) { if (tid < 64) naive_delta_chain(a, l, b / 6, b % 6, tid); }
    else if (b < 144) { const int u = b - 108; naive_ssd_block(a, l, u / 2, u % 2, (LAS float*)lds); }
    else if (b < 162) naive_lru_block(a, l, b - 144, (LAS float*)lds);
}

typedef short bf16x8 __attribute__((ext_vector_type(8)));
constexpr int NCH = 528, NDU = NCH * 6, LDT = 72;
constexpr size_t WS_DW = WS_H, WS_DQK = WS_H + (size_t)NDU * 8192;
constexpr size_t WS_DQD = WS_M, WS_DKD = WS_DQD + (size_t)NDU * 8192, WS_DU = WS_DKD + (size_t)NDU * 8192, WS_SH = WS_DU + (size_t)NDU * 16384,
                 WS_GTD = WS_SH + (size_t)NDU * 16384, WS_GTS = WS_GTD + 16384, WS_LA = WS_GTS + 16384, WS_LB = WS_LA + (size_t)NCH * 1024, WS_LA0 = WS_LB + (size_t)NCH * 1024, WS_LB0 = WS_LA0 + (size_t)NCH * 1024, WS_GP = WS_LB0 + (size_t)NCH * 1024, WS_HH = WS_GP + (size_t)192 * 8192, WS_SST = WS_HH + (size_t)192 * 16384, WS_MEND = WS_SST + (size_t)192 * 16384;
static_assert(WS_MEND <= WS_END && WS_RS >= WS_DU && WS_RS + (size_t)16 * T * 4 <= WS_SH, "mixer workspace");
static_assert(WS_DQK + (size_t)NDU * 8192 <= WS_P, "DW/DQK must fit the H region");

__device__ __forceinline__ int kinv(int k) { return (k & 32) | ((k & 12) << 1) | ((k & 16) >> 2) | (k & 3); }
__device__ __forceinline__ unsigned cvtpk(float lo, float hi) { unsigned r; asm volatile("v_cvt_pk_bf16_f32 %0, %1, %2" : "=v"(r) : "v"(lo), "v"(hi)); return r; }
__device__ __forceinline__ bf16x8 pack8(const f32x4& x, const f32x4& y) { u32x4 w; w.x = cvtpk(x[0], x[1]); w.y = cvtpk(x[2], x[3]); w.z = cvtpk(y[0], y[1]); w.w = cvtpk(y[2], y[3]); return __builtin_bit_cast(bf16x8, w); }
__device__ __forceinline__ f32x4 mfma16(const bf16x8& a, const bf16x8& b, const f32x4& c) { return __builtin_amdgcn_mfma_f32_16x16x32_bf16(a, b, c, 0, 0, 0); }
__device__ __forceinline__ bf16x8 ldfrag(const LAS bf16_t* tile, int row, int s, int fq) { return *(const LAS bf16x8*)(tile + row * LDT + 32 * s + 8 * fq); }
__device__ __forceinline__ void chunk_seq(int c, int& s, bool& first) { if (c < 256) { s = 0; first = c == 0; } else if (c < 512) { s = 1; first = c == 256; } else { s = 2 + (c - 512); first = true; } }
__device__ __forceinline__ float wave_scan_incl(float v, int lane) {
#pragma unroll
    for (int o = 1; o < 64; o <<= 1) { const float t = __shfl_up(v, o); if (lane >= o) v += t; }
    return v; }
template <int NSEG> struct StageRegs { static constexpr int PPR = NSEG * 8, TOTAL = 67 * PPR, NP = (TOTAL + 511) / 512; u32x4 w[NP]; };
template <int NSEG> __device__ __forceinline__ void stage_load(StageRegs<NSEG>& R, const bf16_t* P, int c, int c0, int c1, int c2, int c3, const float* st, int CS, int stbase, bool first) {
    constexpr int PPR = StageRegs<NSEG>::PPR, TOTAL = StageRegs<NSEG>::TOTAL, NP = StageRegs<NSEG>::NP;
    const int tid = tidx();
#pragma unroll
    for (int k = 0; k < NP; ++k) { const int idx = tid + 512 * k < TOTAL ? tid + 512 * k : TOTAL - 1;
        const int r = idx / PPR, pc = idx - r * PPR, seg = pc >> 3, col = (seg == 0 ? c0 : (seg == 1 ? c1 : (seg == 2 ? c2 : c3))) + (pc & 7) * 8, rr = (r >= 3 || !first) ? r : 3;
        R.w[k] = *(const u32x4*)(P + ((size_t)c * 64 + rr - 3) * PSTR + col); }
    if (first) {
#pragma unroll
        for (int k = 0; k < NP; ++k) { const int idx = tid + 512 * k < TOTAL ? tid + 512 * k : TOTAL - 1;
            const int r = idx / PPR, pc = idx - r * PPR, seg = pc >> 3, col = (seg == 0 ? c0 : (seg == 1 ? c1 : (seg == 2 ? c2 : c3))) + (pc & 7) * 8;
            if (r < 3) {
                if (st) { const float* sp = st + r * CS + (col - stbase); R.w[k].x = pk_bf16(sp[0], sp[1]); R.w[k].y = pk_bf16(sp[2], sp[3]); R.w[k].z = pk_bf16(sp[4], sp[5]); R.w[k].w = pk_bf16(sp[6], sp[7]); }
                else { R.w[k].x = 0u; R.w[k].y = 0u; R.w[k].z = 0u; R.w[k].w = 0u; } } }
    }
}
template <int NSEG> __device__ __forceinline__ void stage_store(LAS bf16_t* dst, const StageRegs<NSEG>& R) {
    constexpr int PPR = StageRegs<NSEG>::PPR, TOTAL = StageRegs<NSEG>::TOTAL, NP = StageRegs<NSEG>::NP;
    const int tid = tidx();
#pragma unroll
    for (int k = 0; k < NP; ++k) { const int idx = tid + 512 * k;
        if (idx < TOTAL) { const int r = idx / PPR, pc = idx - r * PPR; *(LAS u32x4*)(dst + r * (NSEG * 64) + pc * 8) = R.w[k]; } }
}
template <int NSEG> __device__ __forceinline__ void stage_raw_n(LAS bf16_t* dst, const bf16_t* P, int c, int c0, int c1, int c2, int c3, const float* st, int CS, int stbase, bool first) {
    StageRegs<NSEG> R; stage_load<NSEG>(R, P, c, c0, c1, c2, c3, st, CS, stbase, first); stage_store<NSEG>(dst, R);
}
__device__ __forceinline__ f32x4 mfma4(float a, float b, const f32x4& c) { return __builtin_amdgcn_mfma_f32_16x16x4f32(a, b, c, 0, 0, 0); }

__device__ __forceinline__ void m1_delta_prefetch(const CArgs& a, int l, int c, int h, StageRegs<3>& R, float& xb_, float& xa_, float (&cwp)[4]) {
    const bf16_t* P = (const bf16_t*)(WSP(a) + WS_P); int s; bool first; chunk_seq(c, s, first);
    { const int t_ = tidx() < 384 ? tidx() : 0, ch = t_ % 192, seg = ch >> 6, cc = ch & 63; const float* cw = INP(a, 14) + (size_t)l * 4 * 1152 + seg * 384 + h * 64 + cc; cwp[0] = cw[0]; cwp[1] = cw[1152]; cwp[2] = cw[2304]; cwp[3] = cw[3456]; }
    if ((tidx() >> 6) == 0) { const size_t row = (size_t)c * 64 + (tidx() & 63); xb_ = ldp(P, row, PBA + h); xa_ = ldp(P, row, PAA + h); }
    stage_load<3>(R, P, c, PQ + h * 64, PK + h * 64, PV + h * 64, 0, (first && s >= 2) ? INP(a, 3) + ((size_t)l * 16 + (s - 2)) * 3 * 1152 : nullptr, 1152, 0, first);
}
__device__ __forceinline__ void m1_delta_unit(const CArgs& a, int l, int c, int h, LAS unsigned char* lds, StageRegs<3>& R, float& xb_, float& xa_, float (&cwp)[4], int cn, int hn, bool has_next) {
    const int tid = tidx(), lane = tid & 63, wid = __builtin_amdgcn_readfirstlane(tid >> 6), fr = lane & 15, fq = lane >> 4;
    const bf16_t* P = (const bf16_t*)(WSP(a) + WS_P);
    LAS bf16_t* RAW = (LAS bf16_t*)lds;
    LAS bf16_t* OUTT = (LAS bf16_t*)lds;
    LAS float* QF = (LAS float*)(lds + 36864);
    LAS float* AT = QF;
    LAS float* KF = (LAS float*)(lds + 36864 + 17408);
    LAS float* VF = KF + 4096;
    LAS bf16_t* KN = (LAS bf16_t*)(VF + 4096);
    LAS bf16_t* QN = KN + 64 * LDT;
    LAS float* SM = (LAS float*)(QN + 64 * LDT);
    int s; bool first; chunk_seq(c, s, first);
    const int u = c * 6 + h;
    stage_store<3>(RAW, R);
    if (wid == 0) {
        const float beta = sigmoid_f(xb_);
        const float la = -__expf(INP(a, 15)[l * 6 + h]) * softplus_f(xa_ + INP(a, 16)[l * 6 + h]);
        SM[lane] = wave_scan_incl(la, lane); SM[64 + lane] = beta;
    }
    const float w0 = cwp[0], w1 = cwp[1], w2 = cwp[2], w3 = cwp[3];
    __syncthreads();
    if (has_next) m1_delta_prefetch(a, l, cn, hn, R, xb_, xa_, cwp);
    if (tid < 384) {
        const int ch = tid % 192, par = tid / 192, seg = ch >> 6, cc = ch & 63;
        LAS float* dst = seg == 0 ? QF : (seg == 1 ? KF : VF);
        float x0 = bf2f(RAW[(par * 32) * 192 + ch]), x1 = bf2f(RAW[(par * 32 + 1) * 192 + ch]), x2 = bf2f(RAW[(par * 32 + 2) * 192 + ch]);
#pragma unroll 8
        for (int j = 0; j < 32; ++j) { const int i = par * 32 + j; const float x3 = bf2f(RAW[(i + 3) * 192 + ch]);
            dst[i * 64 + cc] = siluf(w0 * x0 + w1 * x1 + w2 * x2 + w3 * x3); x0 = x1; x1 = x2; x2 = x3; }
    }
    __syncthreads();
    {   const int i = tid >> 3, part = tid & 7; float q[8], k[8], sq = 0.f, sk = 0.f;
        {   const f32x4 qa = *(const LAS f32x4*)(QF + i * 64 + part * 8), qb = *(const LAS f32x4*)(QF + i * 64 + part * 8 + 4), ka = *(const LAS f32x4*)(KF + i * 64 + part * 8), kb = *(const LAS f32x4*)(KF + i * 64 + part * 8 + 4);
#pragma unroll
            for (int e = 0; e < 4; ++e) { q[e] = qa[e]; q[4 + e] = qb[e]; k[e] = ka[e]; k[4 + e] = kb[e]; } }
#pragma unroll
        for (int e = 0; e < 8; ++e) { sq += q[e] * q[e]; sk += k[e] * k[e]; }
        sq += __shfl_xor(sq, 1); sq += __shfl_xor(sq, 2); sq += __shfl_xor(sq, 4);
        sk += __shfl_xor(sk, 1); sk += __shfl_xor(sk, 2); sk += __shfl_xor(sk, 4);
        const float rq = rsqrtf(sq + 1e-6f) * 0.125f, rk = rsqrtf(sk + 1e-6f);
#pragma unroll
        for (int e = 0; e < 8; ++e) { q[e] *= rq; k[e] *= rk; }
        *(LAS f32x4*)(KF + i * 64 + part * 8) = (f32x4){k[0], k[1], k[2], k[3]}; *(LAS f32x4*)(KF + i * 64 + part * 8 + 4) = (f32x4){k[4], k[5], k[6], k[7]};
        u32x4 wq, wk; wq.x = cvtpk(q[0], q[1]); wq.y = cvtpk(q[2], q[3]); wq.z = cvtpk(q[4], q[5]); wq.w = cvtpk(q[6], q[7]);
        wk.x = cvtpk(k[0], k[1]); wk.y = cvtpk(k[2], k[3]); wk.z = cvtpk(k[4], k[5]); wk.w = cvtpk(k[6], k[7]);
        *(LAS u32x4*)(QN + i * LDT + part * 8) = wq; *(LAS u32x4*)(KN + i * LDT + part * 8) = wk; }
    __syncthreads();
    {
        const int mb = wid & 3, which = wid >> 2; const LAS bf16_t* Asrc = which ? QN : KN;
        const bf16x8 a0 = ldfrag(Asrc, 16 * mb + fr, 0, fq), a1 = ldfrag(Asrc, 16 * mb + fr, 1, fq);
        float gi[4], bi[4];
#pragma unroll
        for (int r = 0; r < 4; ++r) { gi[r] = SM[16 * mb + 4 * fq + r]; bi[r] = SM[64 + 16 * mb + 4 * fq + r]; }
#pragma unroll
        for (int nb = 0; nb < 4; ++nb) {
            const bf16x8 b0 = ldfrag(KN, 16 * nb + fr, 0, fq), b1 = ldfrag(KN, 16 * nb + fr, 1, fq);
            f32x4 acc = {0.f, 0.f, 0.f, 0.f}; acc = mfma16(a0, b0, acc); acc = mfma16(a1, b1, acc);
            const int j = 16 * nb + fr; const float gj = SM[j];
            if (which == 0) { f32x4 o;
#pragma unroll
                for (int r = 0; r < 4; ++r) { const int i = 16 * mb + 4 * fq + r; o[r] = i > j ? bi[r] * acc[r] * __expf(gi[r] - gj) : 0.f; }
                *(LAS f32x4*)(AT + j * 68 + 16 * mb + 4 * fq) = o;
            } else {
#pragma unroll
                for (int r = 0; r < 4; ++r) { const int i = 16 * mb + 4 * fq + r; OUTT[1 * 64 * LDT + i * LDT + kinv(j)] = f2bf(i >= j ? acc[r] * __expf(gi[r] - gj) : 0.f); }
            }
        }
    }
    __syncthreads();
    LAS float* TB = SM + 128;
    if (wid < 4 && lane < 16) {
        float x[16];
#pragma unroll
        for (int i = 0; i < 16; ++i) x[i] = i == lane ? 1.f : 0.f;
#pragma unroll
        for (int j = 0; j < 15; ++j) { const float xj = x[j];
#pragma unroll
            for (int i4 = ((j + 1) & ~3); i4 < 16; i4 += 4) { const f32x4 av = *(const LAS f32x4*)(AT + (16 * wid + j) * 68 + 16 * wid + i4);
#pragma unroll
                for (int e = 0; e < 4; ++e) if (i4 + e > j) x[i4 + e] -= av[e] * xj; } }
#pragma unroll
        for (int i = 0; i < 16; ++i) TB[wid * 272 + i * 17 + lane] = x[i];
    }
    {   const float glast = SM[63];
        for (int idx = tid; idx < 1024; idx += 512) {
            const int d4 = (idx & 15) * 4, i = idx >> 4; const float eg = __expf(SM[i]);
            const u32x2 qv = *(const LAS u32x2*)(QN + i * LDT + d4);
            u32x2 w; w.x = cvtpk(__uint_as_float(qv.x << 16) * eg, __uint_as_float(qv.x & 0xffff0000u) * eg); w.y = cvtpk(__uint_as_float(qv.y << 16) * eg, __uint_as_float(qv.y & 0xffff0000u) * eg);
            *(LAS u32x2*)(OUTT + 2 * 64 * LDT + i * LDT + kinv(d4)) = w; }
        for (int idx = tid; idx < 1024; idx += 512) {
            const int m = idx & 63, j4 = (idx >> 6) * 4; float v[4];
#pragma unroll
            for (int e = 0; e < 4; ++e) v[e] = KF[(j4 + e) * 64 + m] * __expf(glast - SM[j4 + e]);
            u32x2 w; w.x = cvtpk(v[0], v[1]); w.y = cvtpk(v[2], v[3]);
            *(LAS u32x2*)(OUTT + 3 * 64 * LDT + m * LDT + kinv(j4)) = w; } }
    __syncthreads();
    {
        const int ct = wid & 3, isw = wid >> 2; f32x4 X[4];
#pragma unroll
        for (int b = 0; b < 4; ++b) { f32x4 acc;
#pragma unroll
            for (int r = 0; r < 4; ++r) { const int i = 16 * b + 4 * fq + r; acc[r] = isw ? SM[64 + i] * __expf(SM[i]) * KF[i * 64 + 16 * ct + fr] : SM[64 + i] * VF[i * 64 + 16 * ct + fr]; }
#pragma unroll
            for (int bp = 0; bp < 4; ++bp) if (bp < b) {
#pragma unroll
                for (int r = 0; r < 4; ++r) acc = mfma4(-AT[(16 * bp + 4 * fq + r) * 68 + 16 * b + fr], X[bp][r], acc); }
            f32x4 xb = {0.f, 0.f, 0.f, 0.f};
#pragma unroll
            for (int r = 0; r < 4; ++r) xb = mfma4(TB[b * 272 + fr * 17 + 4 * fq + r], acc[r], xb);
            X[b] = xb; }
        if (isw == 0) { float* U = (float*)(WSP(a) + WS_DU) + (size_t)u * 4096;
#pragma unroll
            for (int b = 0; b < 4; ++b)
#pragma unroll
                for (int r = 0; r < 4; ++r) U[(16 * b + 4 * fq + r) * 64 + 16 * ct + fr] = X[b][r];
        } else { const int kp = kinv(16 * ct + fr);
#pragma unroll
            for (int b = 0; b < 4; ++b)
#pragma unroll
                for (int r = 0; r < 4; ++r) OUTT[(16 * b + 4 * fq + r) * LDT + kp] = f2bf(X[b][r]); }
    }
    __syncthreads();
    {   const int row = tid >> 3, c8 = tid & 7;
        bf16_t* g0 = (bf16_t*)(WSP(a) + WS_DW) + (size_t)u * 4096; bf16_t* g1 = (bf16_t*)(WSP(a) + WS_DQK) + (size_t)u * 4096;
        bf16_t* g2 = (bf16_t*)(WSP(a) + WS_DQD) + (size_t)u * 4096; bf16_t* g3 = (bf16_t*)(WSP(a) + WS_DKD) + (size_t)u * 4096;
        *(u32x4*)(g0 + tid * 8) = *(const LAS u32x4*)(OUTT + 0 * 64 * LDT + row * LDT + c8 * 8);
        *(u32x4*)(g1 + tid * 8) = *(const LAS u32x4*)(OUTT + 1 * 64 * LDT + row * LDT + c8 * 8);
        *(u32x4*)(g2 + tid * 8) = *(const LAS u32x4*)(OUTT + 2 * 64 * LDT + row * LDT + c8 * 8);
        *(u32x4*)(g3 + tid * 8) = *(const LAS u32x4*)(OUTT + 3 * 64 * LDT + row * LDT + c8 * 8);
        if (tid == 0) ((float*)(WSP(a) + WS_GTD))[u] = __expf(SM[63]); }
    __syncthreads();
}

__device__ __forceinline__ void m1_ssd_prefetch(const CArgs& a, int l, int c, int h, StageRegs<2>& R, float& xd_) {
    const bf16_t* P = (const bf16_t*)(WSP(a) + WS_P); int s; bool first; chunk_seq(c, s, first); const int g = h / 3;
    if ((tidx() >> 6) == 0) xd_ = ldp(P, (size_t)c * 64 + (tidx() & 63), PDT + h);
    stage_load<2>(R, P, c, PXBC + h * 64, PXBC + 384 + g * 64, 0, 0, (first && s >= 2) ? INP(a, 5) + ((size_t)l * 16 + (s - 2)) * 3 * 640 : nullptr, 640, PXBC, first);
}
__device__ __forceinline__ void m1_ssd_unit(const CArgs& a, int l, int c, int h, LAS unsigned char* lds, StageRegs<2>& R, float& xd_, int cn, int hn, bool has_next) {
    const int tid = tidx(), lane = tid & 63, wid = __builtin_amdgcn_readfirstlane(tid >> 6), fr = lane & 15, fq = lane >> 4, g = h / 3;
    const bf16_t* P = (const bf16_t*)(WSP(a) + WS_P);
    LAS bf16_t* RAW = (LAS bf16_t*)lds;
    LAS bf16_t* BDT = (LAS bf16_t*)(lds + 18432);
    LAS bf16_t* XT = BDT + 64 * LDT;
    LAS float* SM = (LAS float*)(XT + 64 * LDT);
    int s; bool first; chunk_seq(c, s, first);
    const int u = c * 6 + h;
    stage_store<2>(RAW, R);
    if (wid == 0) {
        const float dt = softplus_f(xd_ + INP(a, 21)[l * 6 + h]);
        SM[lane] = wave_scan_incl(-__expf(INP(a, 20)[l * 6 + h]) * dt, lane); SM[64 + lane] = dt;
    }
    const int ch = tid & 127, part = tid >> 7, wch = ch < 64 ? h * 64 + ch : 384 + g * 64 + (ch - 64);
    const float* cw = INP(a, 18) + (size_t)l * 4 * 640 + wch; const float w0 = cw[0], w1 = cw[640], w2 = cw[1280], w3 = cw[1920], bias = INP(a, 19)[l * 640 + wch];
    __syncthreads();
    if (has_next) m1_ssd_prefetch(a, l, cn, hn, R, xd_);
    {
        const float glast = SM[63];
        float x0 = bf2f(RAW[(part * 16) * 128 + ch]), x1 = bf2f(RAW[(part * 16 + 1) * 128 + ch]), x2 = bf2f(RAW[(part * 16 + 2) * 128 + ch]);
#pragma unroll 8
        for (int e = 0; e < 16; ++e) { const int j = part * 16 + e; const float x3 = bf2f(RAW[(j + 3) * 128 + ch]);
            const float y = siluf(w0 * x0 + w1 * x1 + w2 * x2 + w3 * x3 + bias); x0 = x1; x1 = x2; x2 = x3;
            if (ch < 64) XT[ch * LDT + j] = f2bf(y); else BDT[(ch - 64) * LDT + j] = f2bf(y * __expf(glast - SM[j]) * SM[64 + j]); } }
    __syncthreads();
    {   const int mb = wid & 3; float* SH = (float*)(WSP(a) + WS_SH) + (size_t)u * 4096;
        const bf16x8 a0 = ldfrag(BDT, 16 * mb + fr, 0, fq), a1 = ldfrag(BDT, 16 * mb + fr, 1, fq);
#pragma unroll
        for (int t = 0; t < 2; ++t) { const int nb = 2 * (wid >> 2) + t;
            const bf16x8 b0 = ldfrag(XT, 16 * nb + fr, 0, fq), b1 = ldfrag(XT, 16 * nb + fr, 1, fq);
            f32x4 acc = {0.f, 0.f, 0.f, 0.f}; acc = mfma16(b0, a0, acc); acc = mfma16(b1, a1, acc);
            *(f32x4*)(SH + (16 * mb + fr) * 64 + 16 * nb + 4 * fq) = acc; }
        if (tid == 0) ((float*)(WSP(a) + WS_GTS))[u] = __expf(SM[63]); }
    __syncthreads();
}

struct LruW { float wrc[32], wic[32], br, bi, spl; };
__device__ __forceinline__ void lru_load_w(const CArgs& a, int l, int ch, LruW& W) {
    const int blk = ch >> 5, d = ch & 31;
    const float* wr = INP(a, 26) + ((size_t)l * 8 + blk) * 1024 + d; const float* wi = INP(a, 28) + ((size_t)l * 8 + blk) * 1024 + d;
#pragma unroll
    for (int cI = 0; cI < 32; ++cI) { W.wrc[cI] = wr[cI * 32]; W.wic[cI] = wi[cI * 32]; }
    W.br = INP(a, 27)[l * 256 + ch]; W.bi = INP(a, 29)[l * 256 + ch]; W.spl = softplus_f(-INP(a, 30)[l * 256 + ch]);
}
template <class F> __device__ __forceinline__ void lru_gates(const LruW& W, const LAS float* XC, int ch, int half, F&& f) {
    const int blk = ch >> 5;
    const float br = W.br, bi = W.bi, spl = W.spl;
#pragma unroll
    for (int e = 0; e < 32; ++e) { const int t = half * 32 + e; float r = br, ig = bi;
#pragma unroll
        for (int c4 = 0; c4 < 8; ++c4) { const f32x4 xv = *(const LAS f32x4*)(XC + t * 256 + blk * 32 + c4 * 4);
#pragma unroll
            for (int k = 0; k < 4; ++k) { r += xv[k] * W.wrc[c4 * 4 + k]; ig += xv[k] * W.wic[c4 * 4 + k]; } }
        const float xc = XC[t * 256 + ch], log_a = -8.0f * sigmoid_f(r) * spl;
        f(e, __expf(log_a), sqrtf(-expm1f(2.0f * log_a)) * (sigmoid_f(ig) * xc)); }
}
__device__ __forceinline__ void lru_stage_conv(const CArgs& a, int l, int c, LAS unsigned char* lds) {
    const int tid = tidx(); const bf16_t* P = (const bf16_t*)(WSP(a) + WS_P);
    LAS bf16_t* RAW = (LAS bf16_t*)lds; LAS float* XC = (LAS float*)(lds + 34816);
    int s; bool first; chunk_seq(c, s, first);
    stage_raw_n<4>(RAW, P, c, PXC, PXC + 64, PXC + 128, PXC + 192, (first && s >= 2) ? INP(a, 7) + ((size_t)l * 16 + (s - 2)) * 3 * 256 : nullptr, 256, PXC, first);
    __syncthreads();
    {   const int ch = tid & 255, par = tid >> 8; const float* cw = INP(a, 24) + (size_t)l * 4 * 256 + ch; const float w0 = cw[0], w1 = cw[256], w2 = cw[512], w3 = cw[768], bias = INP(a, 25)[l * 256 + ch];
        float x0 = bf2f(RAW[(par * 32) * 256 + ch]), x1 = bf2f(RAW[(par * 32 + 1) * 256 + ch]), x2 = bf2f(RAW[(par * 32 + 2) * 256 + ch]);
#pragma unroll 8
        for (int e = 0; e < 32; ++e) { const int i = par * 32 + e; const float x3 = bf2f(RAW[(i + 3) * 256 + ch]);
            XC[i * 256 + ch] = w0 * x0 + w1 * x1 + w2 * x2 + w3 * x3 + bias; x0 = x1; x1 = x2; x2 = x3; } }
    __syncthreads();
}
__device__ __forceinline__ void m1_lru_unit(const CArgs& a, int l, int c, LAS unsigned char* lds, const LruW& W) {
    const int tid = tidx(), ch = tid & 255, half = tid >> 8;
    LAS float* XC = (LAS float*)(lds + 34816); LAS float* SM = (LAS float*)(lds + 34816 + 65536);
    lru_stage_conv(a, l, c, lds);
    float A = 1.f, B = 0.f;
    lru_gates(W, XC, ch, half, [&](int, float at, float bt) { A *= at; B = at * B + bt; });
    if (half == 1) { SM[ch] = A; SM[256 + ch] = B; }
    __syncthreads();
    if (half == 0) { const float A1 = SM[ch], B1 = SM[256 + ch];
        ((float*)(WSP(a) + WS_LA0))[c * 256 + ch] = A; ((float*)(WSP(a) + WS_LB0))[c * 256 + ch] = B;
        ((float*)(WSP(a) + WS_LA))[c * 256 + ch] = A1 * A; ((float*)(WSP(a) + WS_LB))[c * 256 + ch] = A1 * B + B1; }
    __syncthreads();
}

#define UNIT_LOOP(lo, hi) for (int id = (lo) + (((int)blockIdx.x - (lo)) % (int)gridDim.x + (int)gridDim.x) % (int)gridDim.x; id < (hi); id += (int)gridDim.x)
#define LAUNDER_ARGS() const CArgs* ap_ = (const CArgs*)__builtin_amdgcn_kernarg_segment_ptr(); asm volatile("" : "+s"(ap_)); const CArgs& a = *ap_
__device__ __forceinline__ void m1_phase(const CArgs& a0, int l, LAS unsigned char* lds) {
    { LAUNDER_ARGS(); const int G = (int)gridDim.x; int id = (int)blockIdx.x;
      if (id < NDU) { StageRegs<3> R; float xb_ = 0.f, xa_ = 0.f, cwp[4]; m1_delta_prefetch(a, l, id / 6, id % 6, R, xb_, xa_, cwp);
        for (; id < NDU; id += G) { const int idn = id + G; m1_delta_unit(a, l, id / 6, id % 6, lds, R, xb_, xa_, cwp, idn / 6, idn % 6, idn < NDU); } } }
    { LAUNDER_ARGS(); const int G = (int)gridDim.x; int id = NDU + (((int)blockIdx.x - NDU) % G + G) % G;
      if (id < 2 * NDU) { StageRegs<2> R; float xd_ = 0.f; m1_ssd_prefetch(a, l, (id - NDU) / 6, (id - NDU) % 6, R, xd_);
        for (; id < 2 * NDU; id += G) { const int idn = id + G; m1_ssd_unit(a, l, (id - NDU) / 6, (id - NDU) % 6, lds, R, xd_, (idn - NDU) / 6, (idn - NDU) % 6, idn < 2 * NDU); } } }
    { LAUNDER_ARGS(); LruW W; lru_load_w(a, l, tidx() & 255, W); UNIT_LOOP(2 * NDU, 2 * NDU + NCH) m1_lru_unit(a, l, id - 2 * NDU, lds, W); }
}

constexpr int M2_UOFF = 4 * 64 * LDT * 2, M2_GOFF = M2_UOFF + 64 * 68 * 4, M2_BUFB = M2_GOFF + 16, M2_OB = 2 * M2_BUFB, M2_OBB = 64 * 68 * 4;
static_assert(M2_OB + 2 * M2_OBB <= 144 * 1024, "M2 LDS");
__device__ __forceinline__ void m2_delta_chain(const CArgs& a, int h, int c0, int nch, const float* init, bool ident, bool do_o, bool use_u, float* outf, bf16_t* outg, LAS unsigned char* lds) {
    const int tid = tidx(), lane = tid & 63, wid = __builtin_amdgcn_readfirstlane(tid >> 6), fr = lane & 15, fq = lane >> 4, vs = wid & 3;
    float* DU = (float*)(WSP(a) + WS_DU);
    if (wid >= 6) {
        const int ts = tid - 384;
        __syncthreads();
        for (int ci = 0; ci <= nch; ++ci) {
            if (ci > 0 && do_o) { const LAS float* ob = (const LAS float*)(lds + M2_OB + ((ci - 1) & 1) * M2_OBB); float* dst = DU + ((size_t)(c0 + ci - 1) * 6 + h) * 4096;
#pragma unroll
                for (int k = 0; k < 8; ++k) { const int q = ts + 128 * k; *(f32x4*)(dst + q * 4) = *(const LAS f32x4*)(ob + (q >> 4) * 68 + (q & 15) * 4); } }
            if (ci < nch) __syncthreads();
        }
        __syncthreads();
        return;
    }
    if (wid >= 4) {
        const int tl = tid - 256;
        const bf16_t* G0 = (const bf16_t*)(WSP(a) + WS_DW); const bf16_t* G1 = (const bf16_t*)(WSP(a) + WS_DQK); const bf16_t* G2 = (const bf16_t*)(WSP(a) + WS_DQD); const bf16_t* G3 = (const bf16_t*)(WSP(a) + WS_DKD);
        const float* GT = (const float*)(WSP(a) + WS_GTD);
        u32x4 p[16]; f32x4 pu[8]; float pg;
#define M2_LOAD(uu) do { _Pragma("unroll") for (int k = 0; k < 4; ++k) { const int q = tl + 128 * k; p[k] = *(const u32x4*)(G0 + (uu) * 4096 + q * 8); p[4 + k] = *(const u32x4*)(G1 + (uu) * 4096 + q * 8); \
            p[8 + k] = *(const u32x4*)(G2 + (uu) * 4096 + q * 8); p[12 + k] = *(const u32x4*)(G3 + (uu) * 4096 + q * 8); } \
        _Pragma("unroll") for (int k = 0; k < 8; ++k) { const int q = tl + 128 * k; pu[k] = *(const f32x4*)(DU + (uu) * 4096 + q * 4); } pg = GT[uu]; } while (0)
#define M2_WRITE(dstb) do { LAS bf16_t* d_ = (LAS bf16_t*)(dstb); LAS float* du_ = (LAS float*)((dstb) + M2_UOFF); \
        _Pragma("unroll") for (int k = 0; k < 4; ++k) { const int q = tl + 128 * k, o_ = (q >> 3) * LDT + (q & 7) * 8; *(LAS u32x4*)(d_ + o_) = p[k]; *(LAS u32x4*)(d_ + 64 * LDT + o_) = p[4 + k]; \
            *(LAS u32x4*)(d_ + 2 * 64 * LDT + o_) = p[8 + k]; *(LAS u32x4*)(d_ + 3 * 64 * LDT + o_) = p[12 + k]; } \
        _Pragma("unroll") for (int k = 0; k < 8; ++k) { const int q = tl + 128 * k; *(LAS f32x4*)(du_ + (q >> 4) * 68 + (q & 15) * 4) = pu[k]; } \
        if (tl == 0) *(LAS float*)((dstb) + M2_GOFF) = pg; } while (0)
        {   const size_t u = (size_t)c0 * 6 + h, u1 = nch > 1 ? u + 6 : u;
            M2_LOAD(u); M2_WRITE(lds);
            M2_LOAD(u1); }
        __syncthreads();
        for (int ci = 0; ci < nch; ++ci) {
            const size_t u = (size_t)(c0 + ci) * 6 + h; const size_t un2 = ci + 2 < nch ? u + 12 : u;
            LAS unsigned char* nxtb = lds + ((ci + 1) & 1) * M2_BUFB;
            if (ci + 1 < nch) M2_WRITE(nxtb);
            M2_LOAD(un2);
            __syncthreads();
        }
#undef M2_LOAD
#undef M2_WRITE
        __syncthreads();
        return;
    }
    f32x4 S[4];
#pragma unroll
    for (int mb = 0; mb < 4; ++mb) {
        if (init) {
#pragma unroll
            for (int r = 0; r < 4; ++r) S[mb][r] = init[(16 * mb + 4 * fq + r) * 64 + 16 * vs + fr]; }
        else {
#pragma unroll
            for (int r = 0; r < 4; ++r) S[mb][r] = (ident && (16 * mb + 4 * fq + r == 16 * vs + fr)) ? 1.f : 0.f; } }
    __syncthreads();
    for (int ci = 0; ci < nch; ++ci) {
        LAS unsigned char* curb = lds + (ci & 1) * M2_BUFB;
        const LAS bf16_t* cur = (const LAS bf16_t*)curb; const LAS float* UL = (const LAS float*)(curb + M2_UOFF); LAS float* OB = (LAS float*)(lds + M2_OB + (ci & 1) * M2_OBB);
        const float gt = *(const LAS float*)(curb + M2_GOFF);
        const bf16x8 Sb0 = pack8(S[0], S[1]), Sb1 = pack8(S[2], S[3]);
        f32x4 Dl[4], O[4];
#pragma unroll
        for (int mb = 0; mb < 4; ++mb) { f32x4 t = {0.f, 0.f, 0.f, 0.f}, uc;
#pragma unroll
            for (int r = 0; r < 4; ++r) uc[r] = use_u ? UL[(16 * mb + 4 * fq + r) * 68 + 16 * vs + fr] : 0.f;
            t = mfma16(ldfrag(cur + 0 * 64 * LDT, 16 * mb + fr, 0, fq), Sb0, t); t = mfma16(ldfrag(cur + 0 * 64 * LDT, 16 * mb + fr, 1, fq), Sb1, t);
            Dl[mb] = uc - t;
            f32x4 o = {0.f, 0.f, 0.f, 0.f};
            if (do_o) { o = mfma16(ldfrag(cur + 2 * 64 * LDT, 16 * mb + fr, 0, fq), Sb0, o); o = mfma16(ldfrag(cur + 2 * 64 * LDT, 16 * mb + fr, 1, fq), Sb1, o); }
            O[mb] = o; }
        const bf16x8 Db0 = pack8(Dl[0], Dl[1]), Db1 = pack8(Dl[2], Dl[3]);
#pragma unroll
        for (int mb = 0; mb < 4; ++mb) {
            f32x4 sn = S[mb] * gt;
            sn = mfma16(ldfrag(cur + 3 * 64 * LDT, 16 * mb + fr, 0, fq), Db0, sn); sn = mfma16(ldfrag(cur + 3 * 64 * LDT, 16 * mb + fr, 1, fq), Db1, sn);
            S[mb] = sn;
            if (do_o) { O[mb] = mfma16(ldfrag(cur + 1 * 64 * LDT, 16 * mb + fr, 0, fq), Db0, O[mb]); O[mb] = mfma16(ldfrag(cur + 1 * 64 * LDT, 16 * mb + fr, 1, fq), Db1, O[mb]);
#pragma unroll
                for (int r = 0; r < 4; ++r) OB[(16 * mb + 4 * fq + r) * 68 + 16 * vs + fr] = O[mb][r]; } }
        __syncthreads();
    }
    if (outf) {
#pragma unroll
        for (int mb = 0; mb < 4; ++mb)
#pragma unroll
            for (int r = 0; r < 4; ++r) outf[(16 * mb + 4 * fq + r) * 64 + 16 * vs + fr] = S[mb][r]; }
    if (outg) { const int kp = kinv(16 * vs + fr);
#pragma unroll
        for (int mb = 0; mb < 4; ++mb)
#pragma unroll
            for (int r = 0; r < 4; ++r) outg[(16 * mb + 4 * fq + r) * 64 + kp] = f2bf(S[mb][r]); }
    __syncthreads();
}
__device__ __forceinline__ void m2_level2(const CArgs& a, int q) {
    const int tid = tidx(), lane = tid & 63, wid = __builtin_amdgcn_readfirstlane(tid >> 6), fr = lane & 15, fq = lane >> 4, vs = wid & 3;
    if (wid >= 4) return;
    const bf16_t* GP = (const bf16_t*)(WSP(a) + WS_GP) + (size_t)q * 16 * 4096; const float* HH = (const float*)(WSP(a) + WS_HH) + (size_t)q * 16 * 4096; float* SST = (float*)(WSP(a) + WS_SST) + (size_t)q * 16 * 4096;
    f32x4 S[4], hn[4]; bf16x8 an[4][2];
#pragma unroll
    for (int mb = 0; mb < 4; ++mb) { S[mb] = (f32x4){0.f, 0.f, 0.f, 0.f};
#pragma unroll
        for (int r = 0; r < 4; ++r) hn[mb][r] = HH[(16 * mb + 4 * fq + r) * 64 + 16 * vs + fr];
        an[mb][0] = *(const bf16x8*)(GP + (16 * mb + fr) * 64 + 8 * fq); an[mb][1] = *(const bf16x8*)(GP + (16 * mb + fr) * 64 + 32 + 8 * fq); }
    for (int g = 0; g < 16; ++g) {
#pragma unroll
        for (int mb = 0; mb < 4; ++mb)
#pragma unroll
            for (int r = 0; r < 4; ++r) SST[(size_t)g * 4096 + (16 * mb + 4 * fq + r) * 64 + 16 * vs + fr] = S[mb][r];
        if (g == 15) break;
        f32x4 hc[4]; bf16x8 ac[4][2];
#pragma unroll
        for (int mb = 0; mb < 4; ++mb) { hc[mb] = hn[mb]; ac[mb][0] = an[mb][0]; ac[mb][1] = an[mb][1]; }
        const int gn = g + 1 < 15 ? g + 1 : g;
#pragma unroll
        for (int mb = 0; mb < 4; ++mb) {
#pragma unroll
            for (int r = 0; r < 4; ++r) hn[mb][r] = HH[(size_t)gn * 4096 + (16 * mb + 4 * fq + r) * 64 + 16 * vs + fr];
            an[mb][0] = *(const bf16x8*)(GP + (size_t)gn * 4096 + (16 * mb + fr) * 64 + 8 * fq); an[mb][1] = *(const bf16x8*)(GP + (size_t)gn * 4096 + (16 * mb + fr) * 64 + 32 + 8 * fq); }
        const bf16x8 Sb0 = pack8(S[0], S[1]), Sb1 = pack8(S[2], S[3]);
#pragma unroll
        for (int mb = 0; mb < 4; ++mb) { f32x4 t = mfma16(ac[mb][0], Sb0, hc[mb]); S[mb] = mfma16(ac[mb][1], Sb1, t); }
    }
}
__device__ __forceinline__ void m2_scan_unit(const CArgs& a, int l, int su) {
    const int tid = tidx();
    if (su < 864) {
        int s, h, e; const int gi = (su < 96 ? su : su - 96) * 512 + tid;
        if (su < 96) { s = gi / (6 * 4096); h = (gi / 4096) % 6; e = gi & 4095; } else { s = 2 + gi / (6 * 4096); h = (gi / 4096) % 6; e = gi & 4095; }
        const int nch = seq_len(s) / 64, c0 = s < 2 ? s * 256 : 512 + (s - 2);
        float hs = s < 2 ? 0.f : INP(a, 4)[(((size_t)l * 16 + (s - 2)) * 6 + h) * 4096 + e];
        float* SH = (float*)(WSP(a) + WS_SH); const float* GT = (const float*)(WSP(a) + WS_GTS);
        int ci = 0;
        for (; ci + 8 <= nch; ci += 8) { float hl[8], gt[8];
#pragma unroll
            for (int k = 0; k < 8; ++k) { const size_t u = (size_t)(c0 + ci + k) * 6 + h; hl[k] = SH[u * 4096 + e]; gt[k] = GT[u]; }
#pragma unroll
            for (int k = 0; k < 8; ++k) { const size_t u = (size_t)(c0 + ci + k) * 6 + h; SH[u * 4096 + e] = hs; hs = gt[k] * hs + hl[k]; } }
        for (; ci < nch; ++ci) { const size_t u = (size_t)(c0 + ci) * 6 + h; const float hl = SH[u * 4096 + e], gt = GT[u]; SH[u * 4096 + e] = hs; hs = gt * hs + hl; }
        state_out(OUTP(a), O_PSH, O_SSH, l, s, 6 * 4096)[(size_t)h * 4096 + e] = hs;
    } else {
        const int gi = (su == 864 ? 0 : su - 865) * 512 + tid; const int s = su == 864 ? gi / 256 : 2 + gi / 256, ch = gi & 255;
        const int nch = seq_len(s) / 64, c0 = s < 2 ? s * 256 : 512 + (s - 2);
        float hs = s < 2 ? 0.f : INP(a, 6)[((size_t)l * 16 + (s - 2)) * 256 + ch];
        const float* LA = (const float*)(WSP(a) + WS_LA); float* LB = (float*)(WSP(a) + WS_LB);
        int ci = 0;
        for (; ci + 8 <= nch; ci += 8) { float A[8], B[8];
#pragma unroll
            for (int k = 0; k < 8; ++k) { A[k] = LA[(c0 + ci + k) * 256 + ch]; B[k] = LB[(c0 + ci + k) * 256 + ch]; }
#pragma unroll
            for (int k = 0; k < 8; ++k) { LB[(c0 + ci + k) * 256 + ch] = hs; hs = A[k] * hs + B[k]; } }
        for (; ci < nch; ++ci) { const float A = LA[(c0 + ci) * 256 + ch], B = LB[(c0 + ci) * 256 + ch]; LB[(c0 + ci) * 256 + ch] = hs; hs = A * hs + B; }
        state_out(OUTP(a), O_PLH, O_SLH, l, s, 256)[ch] = hs;
    }
}
__device__ __forceinline__ void m2_scan2_unit(float* V, size_t vcs, const float* Dc, size_t dcs, int des, int e0, float* fin, LAS unsigned char* lds) {
    const int tid = tidx(), g = tid >> 5, el = tid & 31; LAS float* CG = (LAS float*)lds; LAS float* CH = CG + 512;
    float v[16], d[16];
#pragma unroll
    for (int k = 0; k < 16; ++k) { v[k] = V[(size_t)(16 * g + k) * vcs + e0 + el]; d[k] = Dc[(size_t)(16 * g + k) * dcs + (size_t)des * (e0 + el)]; }
    float hs = 0.f, gp = 1.f;
#pragma unroll
    for (int k = 0; k < 16; ++k) { const float t = v[k]; v[k] = hs; hs = d[k] * hs + t; gp *= d[k]; }
    CG[tid] = gp; CH[tid] = hs;
    __syncthreads();
    float S = 0.f;
    for (int j = 0; j < g; ++j) S = CG[j * 32 + el] * S + CH[j * 32 + el];
    float pk = 1.f;
#pragma unroll
    for (int k = 0; k < 16; ++k) { V[(size_t)(16 * g + k) * vcs + e0 + el] = v[k] + pk * S; pk *= d[k]; }
    if (g == 15) fin[e0 + el] = hs + gp * S;
    __syncthreads();
}
__device__ __forceinline__ void m2a_phase(const CArgs& a0, int l, LAS unsigned char* lds) {
    { LAUNDER_ARGS(); UNIT_LOOP(0, 1552) {
        if (id < 1536) { const int q = id >> 7, s = q / 6, h = q % 6, e0 = (id & 127) * 32;
            m2_scan2_unit((float*)(WSP(a) + WS_SH) + ((size_t)s * 256 * 6 + h) * 4096, (size_t)6 * 4096, (const float*)(WSP(a) + WS_GTS) + (size_t)s * 256 * 6 + h, 6, 0, e0,
                          state_out(OUTP(a), O_PSH, O_SSH, l, s, 6 * 4096) + (size_t)h * 4096, lds); }
        else { const int j = id - 1536, s = j >> 3, e0 = (j & 7) * 32;
            m2_scan2_unit((float*)(WSP(a) + WS_LB) + (size_t)s * 256 * 256, 256, (const float*)(WSP(a) + WS_LA) + (size_t)s * 256 * 256, 256, 1, e0, state_out(OUTP(a), O_PLH, O_SLH, l, s, 256), lds); } } }
    { LAUNDER_ARGS(); UNIT_LOOP(1552, 1552 + 360) { const int j = id - 1552, q = j / 30, g = (j >> 1) % 15, half = j & 1; const size_t qg = (size_t)q * 16 + g;
        m2_delta_chain(a, q % 6, (q / 6) * 256 + 16 * g, 16, nullptr, half == 1, false, half == 0, half == 0 ? (float*)(WSP(a) + WS_HH) + qg * 4096 : nullptr, half == 1 ? (bf16_t*)(WSP(a) + WS_GP) + qg * 4096 : nullptr, lds); } }
    { LAUNDER_ARGS(); const int b = (int)blockIdx.x;
      const int k = b >= 120 ? b - 120 : (b < 16 ? 136 + b : -1);
      if (k >= 0) for (int j = k; j < 776; j += 152) m2_scan_unit(a, l, j < 768 ? 96 + j : 865 + (j - 768)); }
}
__device__ __forceinline__ void m2b_phase(const CArgs& a0, int l) { LAUNDER_ARGS(); if (blockIdx.x < 12) m2_level2(a, blockIdx.x); }
__device__ __forceinline__ void m2c_phase(const CArgs& a0, int l, LAS unsigned char* lds) {
    LAUNDER_ARGS();
    const int b = (int)blockIdx.x;
    if (b < 192) { const int id = b, q = id >> 4, g = id & 15, s = q / 6, h = q % 6;
        m2_delta_chain(a, h, s * 256 + 16 * g, 16, (const float*)(WSP(a) + WS_SST) + (size_t)id * 4096, false, true, true, g == 15 ? state_out(OUTP(a), O_PDS, O_SDS, l, s, 6 * 4096) + (size_t)h * 4096 : nullptr, nullptr, lds); }
    else for (int j = b - 192; j < 96; j += (int)gridDim.x - 192) { const int sb = j / 6, h = j % 6;
        m2_delta_chain(a, h, 512 + sb, 1, INP(a, 2) + (((size_t)l * 16 + sb) * 6 + h) * 4096, false, true, true, state_out(OUTP(a), O_PDS, O_SDS, l, 2 + sb, 6 * 4096) + (size_t)h * 4096, nullptr, lds); }
}

__device__ __forceinline__ void m3_delta_unit(const CArgs& a, int l, int c) {
    const int tid = tidx(), i = tid >> 3, part = tid & 7; const size_t row = (size_t)c * 64 + i;
    const bf16_t* P = (const bf16_t*)(WSP(a) + WS_P); bf16_t* MIX = (bf16_t*)(WSP(a) + WS_H); const float* DU = (const float*)(WSP(a) + WS_DU);
    f32x4 nw0 = *(const f32x4*)(INP(a, 17) + l * 64 + part * 8), nw1 = *(const f32x4*)(INP(a, 17) + l * 64 + part * 8 + 4);
    f32x4 oo[6][2]; u32x4 zz[6];
#pragma unroll
    for (int h = 0; h < 6; ++h) { const float* o = DU + ((size_t)c * 6 + h) * 4096 + i * 64 + part * 8; oo[h][0] = *(const f32x4*)o; oo[h][1] = *(const f32x4*)(o + 4);
        zz[h] = *(const u32x4*)(P + row * PSTR + PZA + h * 64 + part * 8); }
#pragma unroll
    for (int h = 0; h < 6; ++h) {
        const f32x4 o0 = oo[h][0], o1 = oo[h][1];
        float ss = o0[0] * o0[0] + o0[1] * o0[1] + o0[2] * o0[2] + o0[3] * o0[3] + o1[0] * o1[0] + o1[1] * o1[1] + o1[2] * o1[2] + o1[3] * o1[3];
        ss += __shfl_xor(ss, 1); ss += __shfl_xor(ss, 2); ss += __shfl_xor(ss, 4);
        const float rs = rsqrtf(ss * (1.0f / 64.f) + 1e-6f);
        const u32x4 z = zz[h];
        float zf[8] = {__uint_as_float(z.x << 16), __uint_as_float(z.x & 0xffff0000u), __uint_as_float(z.y << 16), __uint_as_float(z.y & 0xffff0000u),
                       __uint_as_float(z.z << 16), __uint_as_float(z.z & 0xffff0000u), __uint_as_float(z.w << 16), __uint_as_float(z.w & 0xffff0000u)};
        u32x4 w;
        w.x = cvtpk(o0[0] * rs * nw0[0] * siluf(zf[0]), o0[1] * rs * nw0[1] * siluf(zf[1])); w.y = cvtpk(o0[2] * rs * nw0[2] * siluf(zf[2]), o0[3] * rs * nw0[3] * siluf(zf[3]));
        w.z = cvtpk(o1[0] * rs * nw1[0] * siluf(zf[4]), o1[1] * rs * nw1[1] * siluf(zf[5])); w.w = cvtpk(o1[2] * rs * nw1[2] * siluf(zf[6]), o1[3] * rs * nw1[3] * siluf(zf[7]));
        *(u32x4*)(MIX + row * D + h * 64 + part * 8) = w;
    }
}
__device__ __forceinline__ void m3_ssd_unit(const CArgs& a, int l, int c, int g, LAS unsigned char* lds) {
    const int tid = tidx(), lane = tid & 63, wid = __builtin_amdgcn_readfirstlane(tid >> 6), fr = lane & 15, fq = lane >> 4;
    const bf16_t* P = (const bf16_t*)(WSP(a) + WS_P); bf16_t* MIX = (bf16_t*)(WSP(a) + WS_H);
    LAS bf16_t* RAWBC = (LAS bf16_t*)lds;
    LAS bf16_t* SC = (LAS bf16_t*)lds; LAS bf16_t* HT = SC + 64 * LDT;
    LAS bf16_t* BN = (LAS bf16_t*)(lds + 18432); LAS bf16_t* CN = BN + 64 * LDT;
    LAS bf16_t* RAWX = (LAS bf16_t*)(lds + 36864);
    LAS bf16_t* XDT = (LAS bf16_t*)(lds + 46080);
    LAS float* XS = (LAS float*)(lds + 55296);
    LAS float* Y = (LAS float*)(lds + 71680);
    LAS float* SM = (LAS float*)(lds + 120832);
    int s; bool first; chunk_seq(c, s, first);
    const float* st = (first && s >= 2) ? INP(a, 5) + ((size_t)l * 16 + (s - 2)) * 3 * 640 : nullptr;
    stage_raw_n<2>(RAWBC, P, c, PXBC + 384 + g * 64, PXBC + 512 + g * 64, 0, 0, st, 640, PXBC, first);
    __syncthreads();
    {   const int ch = tid & 127, part = tid >> 7, wch = ch < 64 ? 384 + g * 64 + ch : 512 + g * 64 + (ch - 64);
        const float* cw = INP(a, 18) + (size_t)l * 4 * 640 + wch; const float w0 = cw[0], w1 = cw[640], w2 = cw[1280], w3 = cw[1920], bias = INP(a, 19)[l * 640 + wch];
        float x0 = bf2f(RAWBC[(part * 16) * 128 + ch]), x1 = bf2f(RAWBC[(part * 16 + 1) * 128 + ch]), x2 = bf2f(RAWBC[(part * 16 + 2) * 128 + ch]);
#pragma unroll 8
        for (int e = 0; e < 16; ++e) { const int j = part * 16 + e; const float x3 = bf2f(RAWBC[(j + 3) * 128 + ch]);
            const float y = siluf(w0 * x0 + w1 * x1 + w2 * x2 + w3 * x3 + bias); x0 = x1; x1 = x2; x2 = x3;
            if (ch < 64) BN[j * LDT + ch] = f2bf(y); else CN[j * LDT + ch - 64] = f2bf(y); } }
    __syncthreads();
    StageRegs<1> RX; float ht[8], zb[8], xd = 0.f, cwx[5];
#define M3_PREFETCH(hh_) do { const int head_ = 3 * g + (hh_); const size_t u_ = (size_t)c * 6 + head_; \
        if (wid == 0) xd = ldp(P, (size_t)c * 64 + lane, PDT + head_); \
        { const float* cw_ = INP(a, 18) + (size_t)l * 4 * 640 + head_ * 64 + (tid & 63); cwx[0] = cw_[0]; cwx[1] = cw_[640]; cwx[2] = cw_[1280]; cwx[3] = cw_[1920]; cwx[4] = INP(a, 19)[l * 640 + head_ * 64 + (tid & 63)]; } \
        stage_load<1>(RX, P, c, PXBC + head_ * 64, 0, 0, 0, st, 640, PXBC, first); \
        { const float* SH_ = (const float*)(WSP(a) + WS_SH) + u_ * 4096; _Pragma("unroll") for (int e = 0; e < 8; ++e) ht[e] = SH_[tid + 512 * e]; } \
        _Pragma("unroll") for (int t = 0; t < 2; ++t) _Pragma("unroll") for (int r = 0; r < 4; ++r) zb[t * 4 + r] = ldp(P, (size_t)c * 64 + 16 * (wid & 3) + 4 * fq + r, PZB + head_ * 64 + 16 * (2 * (wid >> 2) + t) + fr); } while (0)
    M3_PREFETCH(0);
    for (int hh = 0; hh < 3; ++hh) {
        const int head = 3 * g + hh;
        stage_store<1>(RAWX, RX);
        if (wid == 0) {
            const float dt = softplus_f(xd + INP(a, 21)[l * 6 + head]);
            SM[lane] = wave_scan_incl(-__expf(INP(a, 20)[l * 6 + head]) * dt, lane); SM[64 + lane] = dt;
        }
#pragma unroll
        for (int e = 0; e < 8; ++e) { const int idx = tid + 512 * e, n = idx >> 6, p = idx & 63; HT[p * LDT + n] = f2bf(ht[e]); }
        float zc[8]; const float w0 = cwx[0], w1 = cwx[1], w2 = cwx[2], w3 = cwx[3], bias = cwx[4];
#pragma unroll
        for (int e = 0; e < 8; ++e) zc[e] = zb[e];
        __syncthreads();
        if (hh < 2) M3_PREFETCH(hh + 1);
        {   const int p = tid & 63, part = tid >> 6;
            float x0 = bf2f(RAWX[(part * 8) * 64 + p]), x1 = bf2f(RAWX[(part * 8 + 1) * 64 + p]), x2 = bf2f(RAWX[(part * 8 + 2) * 64 + p]);
#pragma unroll
            for (int e = 0; e < 8; ++e) { const int j = part * 8 + e; const float x3 = bf2f(RAWX[(j + 3) * 64 + p]);
                const float y = siluf(w0 * x0 + w1 * x1 + w2 * x2 + w3 * x3 + bias); x0 = x1; x1 = x2; x2 = x3;
                XS[j * 64 + p] = y; XDT[p * LDT + j] = f2bf(y * SM[64 + j]); } }
        {   const int mb = wid & 3;
            const bf16x8 a0 = ldfrag(CN, 16 * mb + fr, 0, fq), a1 = ldfrag(CN, 16 * mb + fr, 1, fq);
            float gi[4];
#pragma unroll
            for (int r = 0; r < 4; ++r) gi[r] = SM[16 * mb + 4 * fq + r];
#pragma unroll
            for (int t = 0; t < 2; ++t) { const int nb = 2 * (wid >> 2) + t;
                const bf16x8 b0 = ldfrag(BN, 16 * nb + fr, 0, fq), b1 = ldfrag(BN, 16 * nb + fr, 1, fq);
                f32x4 acc = {0.f, 0.f, 0.f, 0.f}; acc = mfma16(a0, b0, acc); acc = mfma16(a1, b1, acc);
                const int j = 16 * nb + fr; const float gj = SM[j];
#pragma unroll
                for (int r = 0; r < 4; ++r) { const int i = 16 * mb + 4 * fq + r; SC[i * LDT + j] = f2bf(i >= j ? acc[r] * __expf(gi[r] - gj) : 0.f); } } }
        __syncthreads();
        {   const int mb = wid & 3; const float dsk = INP(a, 22)[l * 6 + head];
            const bf16x8 s0 = ldfrag(SC, 16 * mb + fr, 0, fq), s1 = ldfrag(SC, 16 * mb + fr, 1, fq), c0f = ldfrag(CN, 16 * mb + fr, 0, fq), c1f = ldfrag(CN, 16 * mb + fr, 1, fq);
#pragma unroll
            for (int t = 0; t < 2; ++t) { const int nb = 2 * (wid >> 2) + t;
                f32x4 y1 = {0.f, 0.f, 0.f, 0.f}, y2 = {0.f, 0.f, 0.f, 0.f};
                y1 = mfma16(s0, ldfrag(XDT, 16 * nb + fr, 0, fq), y1); y1 = mfma16(s1, ldfrag(XDT, 16 * nb + fr, 1, fq), y1);
                y2 = mfma16(c0f, ldfrag(HT, 16 * nb + fr, 0, fq), y2); y2 = mfma16(c1f, ldfrag(HT, 16 * nb + fr, 1, fq), y2);
                const int p = 16 * nb + fr;
#pragma unroll
                for (int r = 0; r < 4; ++r) { const int i = 16 * mb + 4 * fq + r;
                    float y = y1[r] + __expf(SM[i]) * y2[r] + dsk * XS[i * 64 + p];
                    y *= siluf(zc[t * 4 + r]);
                    Y[i * 192 + hh * 64 + p] = y; } } }
        __syncthreads();
    }
#undef M3_PREFETCH
    {   const int i = tid >> 3, part = tid & 7; float v[24], ss = 0.f;
#pragma unroll
        for (int e4 = 0; e4 < 6; ++e4) { const f32x4 t = *(const LAS f32x4*)(Y + i * 192 + part * 24 + e4 * 4); v[4 * e4] = t[0]; v[4 * e4 + 1] = t[1]; v[4 * e4 + 2] = t[2]; v[4 * e4 + 3] = t[3]; }
#pragma unroll
        for (int e = 0; e < 24; ++e) ss += v[e] * v[e];
        ss += __shfl_xor(ss, 1); ss += __shfl_xor(ss, 2); ss += __shfl_xor(ss, 4);
        const float rs = rsqrtf(ss * (1.0f / 192.f) + 1e-6f); const float* nw = INP(a, 23) + l * 384 + g * 192 + part * 24;
        bf16_t* dst = MIX + ((size_t)c * 64 + i) * D + 384 + g * 192 + part * 24;
#pragma unroll
        for (int q = 0; q < 3; ++q) { u32x4 w;
            w.x = cvtpk(v[8 * q + 0] * rs * nw[8 * q + 0], v[8 * q + 1] * rs * nw[8 * q + 1]); w.y = cvtpk(v[8 * q + 2] * rs * nw[8 * q + 2], v[8 * q + 3] * rs * nw[8 * q + 3]);
            w.z = cvtpk(v[8 * q + 4] * rs * nw[8 * q + 4], v[8 * q + 5] * rs * nw[8 * q + 5]); w.w = cvtpk(v[8 * q + 6] * rs * nw[8 * q + 6], v[8 * q + 7] * rs * nw[8 * q + 7]);
            *(u32x4*)(dst + 8 * q) = w; } }
    __syncthreads();
}
__device__ __forceinline__ void m3_lru_unit(const CArgs& a, int l, int c, LAS unsigned char* lds, const LruW& W) {
    const int tid = tidx(), ch = tid & 255, half = tid >> 8;
    const bf16_t* P = (const bf16_t*)(WSP(a) + WS_P); bf16_t* MIX = (bf16_t*)(WSP(a) + WS_H);
    LAS float* XC = (LAS float*)(lds + 34816);
    float gz[32];
#pragma unroll
    for (int e = 0; e < 32; ++e) gz[e] = ldp(P, (size_t)c * 64 + half * 32 + e, PGC + ch);
    float hcur = ((const float*)(WSP(a) + WS_LB))[c * 256 + ch];
    const float a0h = ((const float*)(WSP(a) + WS_LA0))[c * 256 + ch], b0h = ((const float*)(WSP(a) + WS_LB0))[c * 256 + ch];
    lru_stage_conv(a, l, c, lds);
    if (half == 1) hcur = a0h * hcur + b0h;
    lru_gates(W, XC, ch, half, [&](int e, float at, float bt) { hcur = at * hcur + bt;
        const size_t row = (size_t)c * 64 + half * 32 + e; MIX[row * D + 768 + ch] = f2bf(hcur * gelu_tanh(gz[e])); });
    __syncthreads();
}
__device__ __forceinline__ void m3_state_unit(const CArgs& a, int l, int s) {
    const bf16_t* P = (const bf16_t*)(WSP(a) + WS_P); const size_t r0 = seq_row0(s) + seq_len(s) - 3;
    float* oa = state_out(OUTP(a), O_PDC, O_SDC, l, s, 3 * 1152); float* ob = state_out(OUTP(a), O_PSC, O_SSC, l, s, 3 * 640); float* oc = state_out(OUTP(a), O_PLC, O_SLC, l, s, 3 * 256);
    for (int idx = tidx(); idx < 3 * 2048; idx += 512) { const int j = idx / 2048, e = idx % 2048;
        if (e < 1152) oa[j * 1152 + e] = ldp(P, r0 + j, e);
        else if (e < 1792) ob[j * 640 + e - 1152] = ldp(P, r0 + j, PXBC + e - 1152);
        else oc[j * 256 + e - 1792] = ldp(P, r0 + j, PXC + e - 1792); }
}
__device__ __forceinline__ void m3_phase(const CArgs& a0, int l, LAS unsigned char* lds) {
    { LAUNDER_ARGS(); UNIT_LOOP(0, 2 * NCH) m3_ssd_unit(a, l, id >> 1, id & 1, lds); }
    { LAUNDER_ARGS(); LruW W; lru_load_w(a, l, tidx() & 255, W); UNIT_LOOP(2 * NCH, 3 * NCH) m3_lru_unit(a, l, id - 2 * NCH, lds, W); }
    { LAUNDER_ARGS(); UNIT_LOOP(3 * NCH, 4 * NCH) m3_delta_unit(a, l, id - 3 * NCH); }
    { LAUNDER_ARGS(); UNIT_LOOP(4 * NCH, 4 * NCH + 18) m3_state_unit(a, l, id - 4 * NCH); }
}
namespace cg = cooperative_groups;
#define GEMM_GU(l, f) do { PH_BEGIN(); pg8::Gemm g{(const bf16_t*)OUTP(a), (const bf16_t*)(WSP(a) + WS_WGU + (size_t)((l) * 2 + (f)) * SZ_WGU), T, NGU, D}; pg8::StaticOrder S; S.init(T, NGU, gridDim.x, blockIdx.x); \
        pg8::rs_prepare(lds, S, (const float*)(WSP(a) + WS_RS), tidx()); pg8::EpiGU E{P, FF, lds}; pg8::gemm_phase<pg8::EpiGU, pg8::StaticOrder, true, true>(lds, g, S, E); } while (0)
#define SPLITK_TAIL(Aptr, Wptr, LDK, NSL) do { pg8::Gemm g2{(Aptr) + (size_t)TP * (LDK), (Wptr), TS, D, 256, (LDK)}; pg8::SplitKOrder S2{TS / 256, D / 256, (NSL), 256, (int)gridDim.x, (int)blockIdx.x}; \
        pg8::EpiSlab E2{(float*)(WSP(a) + WS_SLAB), D, 256, (size_t)TS * D}; pg8::gemm_phase<pg8::EpiSlab, pg8::SplitKOrder, true, true>(lds, g2, S2, E2); } while (0)
#define GEMM_DN(l, f) do { { PH_BEGIN(); const bf16_t* W = (const bf16_t*)(WSP(a) + WS_WDN + (size_t)((l) * 2 + (f)) * SZ_WDN); pg8::Gemm g{P, W, TP, D, FF}; pg8::StaticOrder S; S.init(TP, D, gridDim.x, blockIdx.x); \
        pg8::EpiRes E{(bf16_t*)OUTP(a), ((l) == 1 && (f) == 1) ? (bf16_t*)(WSP(a) + WS_H) : (bf16_t*)OUTP(a), 0.5f, (float*)(WSP(a) + WS_RS)}; pg8::gemm_phase<pg8::EpiRes, pg8::StaticOrder, true, true>(lds, g, S, E); \
        SPLITK_TAIL(P, W, FF, 11); } BAR(); \
        { PH_BEGIN(); sample_reduce_phase<11>(a, 0.5f, (l) == 1 && (f) == 1, (float*)(WSP(a) + WS_RS)); } } while (0)
#define GEMM_IN(l) do { PH_BEGIN(); pg8::Gemm g{(const bf16_t*)OUTP(a), (const bf16_t*)(WSP(a) + WS_WIN + (size_t)(l) * SZ_WIN), T, NPIN, D}; pg8::StaticOrder S; S.init(T, NPIN, gridDim.x, blockIdx.x); \
        pg8::rs_prepare(lds, S, (const float*)(WSP(a) + WS_RS), tidx()); pg8::EpiP E{P, PSTR, PSTR, lds}; pg8::gemm_phase<pg8::EpiP, pg8::StaticOrder, true, true>(lds, g, S, E); } while (0)
#define GEMM_OUT(l) do { { PH_BEGIN(); const bf16_t* W = (const bf16_t*)(WSP(a) + WS_WOUT + (size_t)(l) * SZ_WOUT); pg8::Gemm g{H, W, TP, D, D}; pg8::StaticOrder S; S.init(TP, D, gridDim.x, blockIdx.x); \
        pg8::EpiRes E{(bf16_t*)OUTP(a), (bf16_t*)OUTP(a), 1.0f, (float*)(WSP(a) + WS_RS)}; pg8::gemm_phase<pg8::EpiRes, pg8::StaticOrder, true, true>(lds, g, S, E); \
        SPLITK_TAIL(H, W, D, 4); } BAR(); \
        { PH_BEGIN(); sample_reduce_phase<4>(a, 1.0f, false, (float*)(WSP(a) + WS_RS)); } } while (0)

__global__ void __launch_bounds__(512, 2) mk_fwd(Args a_) {
#define PH_BEGIN() const CArgs* ap_ = (const CArgs*)__builtin_amdgcn_kernarg_segment_ptr(); asm volatile("" : "+s"(ap_)); const CArgs& a = *ap_; \
        bf16_t* H = (bf16_t*)(WSP(a) + WS_H); bf16_t* P = (bf16_t*)(WSP(a) + WS_P); (void)H; (void)P; LAS unsigned char* lds = (LAS unsigned char*)lds_raw
    extern __shared__ __attribute__((aligned(16))) unsigned char lds_raw[];
    LAS unsigned char* lds = (LAS unsigned char*)lds_raw;
    volatile LAS unsigned* misc = (volatile LAS unsigned*)(lds + MISC_OFF);
    if (threadIdx.x < 4) misc[threadIdx.x] = 0u;
    __syncthreads();
    XcdBarrier bar = xcd_barrier_post((unsigned*)(a_.ws + WS_CTL), misc);
    if (a_.ph_lo < 0) cg::this_grid().sync();
#define BAR() xcd_barrier(bar)
#define NORM(gi, goff, mode) do { PH_BEGIN(); norm_phase(a, INP(a, gi) + (goff), mode); } while (0)
#define MIXER(l) { PH_BEGIN(); m1_phase(a, l, lds); } BAR(); { PH_BEGIN(); m2a_phase(a, l, lds); } BAR(); { PH_BEGIN(); m2b_phase(a, l); } BAR(); { PH_BEGIN(); m2c_phase(a, l, lds); } BAR(); { PH_BEGIN(); m3_phase(a, l, lds); } BAR();
    { PH_BEGIN(); wprep_phase(a, lds); } NORM(8, 0, 0); BAR();
#define LAYER(l) \
        GEMM_GU(l, 0); BAR(); \
        GEMM_DN(l, 0); BAR(); \
        GEMM_IN(l); BAR(); \
        MIXER(l); \
        GEMM_OUT(l); BAR(); \
        GEMM_GU(l, 1); BAR(); \
        GEMM_DN(l, 1); BAR();
    LAYER(0)
    LAYER(1) NORM(36, 0, 2);
}

extern "C" void kernel_launch(void* const* d_in, const int* in_sizes, int n_in, void* d_out, int out_size, void* d_ws, size_t ws_size, hipStream_t stream) {
    static int grid = 0;
    if (grid == 0) {
        if (n_in != 37 || (size_t)out_size != O_END || ws_size < WS_END) { fprintf(stderr, "kernel_launch: unexpected shapes: n_in %d out %d (want %zu) ws %zu (want %zu)\n", n_in, out_size, (size_t)O_END, ws_size, (size_t)WS_END); grid = -1; return; }
        int dev = 0, cus = 0, per_cu = 0;
        if (hipGetDevice(&dev) != hipSuccess || hipDeviceGetAttribute(&cus, hipDeviceAttributeMultiprocessorCount, dev) != hipSuccess) { grid = -1; return; }
        if (hipFuncSetAttribute((const void*)mk_fwd, hipFuncAttributeMaxDynamicSharedMemorySize, LDS_BYTES) != hipSuccess) { fprintf(stderr, "kernel_launch: hipFuncSetAttribute failed\n"); grid = -1; return; }
        if (hipOccupancyMaxActiveBlocksPerMultiprocessor(&per_cu, (const void*)mk_fwd, 512, LDS_BYTES) != hipSuccess || per_cu < 1) { fprintf(stderr, "kernel_launch: occupancy query says %d\n", per_cu); (void)hipGetLastError(); }
        grid = cus;
    }
    if (grid < 0) return;
    (void)hipMemsetAsync((char*)d_ws + WS_CTL, 0, 65536, stream);
    Args a{};
    for (int i = 0; i < 37; ++i) a.in[i] = (const float*)d_in[i];
    a.out = (float*)d_out; a.ws = (unsigned char*)d_ws; a.ph_lo = 0; a.ph_hi = 0;
    void* args[] = {&a};
    hipError_t e = hipLaunchCooperativeKernel((const void*)mk_fwd, dim3(grid), dim3(512), args, LDS_BYTES, stream);
    if (e != hipSuccess) fprintf(stderr, "kernel_launch: cooperative launch failed: %s\n", hipGetErrorString(e));
}
```

```cpp
#include <hip/hip_runtime.h>
#include <hip/hip_cooperative_groups.h>
#include <cstdio>
#include <cstdint>
#define MK_ONE_LAUNCH 1
namespace pg8 {
#define PG8_LAS __attribute__((address_space(3)))
typedef unsigned short bf16_t;
typedef short bf16x8 __attribute__((ext_vector_type(8)));
typedef float f32x4 __attribute__((ext_vector_type(4)));
typedef unsigned u32x4 __attribute__((ext_vector_type(4)));
constexpr int BM = 256, BK = 64, HALF = 128, HTB = HALF * BK * 2  , STAGE_BYTES = 8 * HTB, NXCD = 8, WGM = 8;

__host__ __device__ __forceinline__ int lds_byte(int r, int c) { const int st = (r >> 4) * 2 + (c >> 5), rr = r & 15, cc = c & 31, ob = rr * 64 + cc * 2; return st * 1024 + (ob ^ (((ob >> 9) & 1) << 5)); }
__host__ __device__ __forceinline__ void stage_rc(int b, int& R, int& C) { const int st = b / 1024, sb = b % 1024, swz = sb ^ (((sb >> 9) & 1) << 5); R = (st >> 1) * 16 + swz / 64; C = (st & 1) * 32 + (swz % 64) / 2; }
__host__ __device__ __forceinline__ int perm32(int rho) { const int n = rho >> 4, i = rho & 15; return 8 * (i >> 2) + 4 * n + (i & 3); }

struct Unit { int pm, pn, seq, k0; };
struct Gemm { const bf16_t* A; const bf16_t* Bt; int M, N, K, ld; };

struct StaticOrder {
    int nM, nN, nwg, G, c;
    __host__ __device__ void init(int M, int N, int G_, int c_) { nM = M / BM; nN = N / BM; nwg = nM * nN; G = G_; c = c_; }
    __host__ __device__ bool next(int i, Unit& u) const {
        const long L = (long)i * G + c; if (L >= nwg) return false;
        int wgid = (int)L; { const int q = nwg / NXCD, r = nwg % NXCD, xcd = wgid % NXCD, off = wgid / NXCD; wgid = (xcd < r ? xcd * (q + 1) : r * (q + 1) + (xcd - r) * q) + off; }
        const int nig = WGM * nN, gid = wgid / nig, fm = gid * WGM, gsz = (nM - fm) < WGM ? (nM - fm) : WGM;
        u.pm = fm + ((wgid % nig) % gsz); u.pn = (wgid % nig) / gsz; u.seq = i; u.k0 = 0; return true;
    }
    __device__ __forceinline__ void a_ready(const Unit&) const {}
    __device__ __forceinline__ void done(const Unit&) const {}
};

__device__ __forceinline__ unsigned cvt_pk_bf16(float lo, float hi) { unsigned r; asm volatile("v_cvt_pk_bf16_f32 %0, %1, %2" : "=v"(r) : "v"(lo), "v"(hi)); return r; }
typedef unsigned u32x2v __attribute__((ext_vector_type(2)));
__device__ __forceinline__ float silu_f(float g) { return g * __builtin_amdgcn_rcpf(1.0f + __expf(-g)); }
constexpr int RSLD = 33792;
constexpr int RSL_OFF = 128 * 1024;
template <class Sched> __device__ __forceinline__ void rs_prepare(PG8_LAS unsigned char* lds, const Sched& S, const float* RS, int tid) {
    PG8_LAS float* rsl = (PG8_LAS float*)(lds + RSL_OFF); Unit u; int nU = 0;
    while (S.next(nU, u)) ++nU;
#pragma unroll 2
    for (int idx = tid; idx < nU * 256; idx += 512) { const int i = idx >> 8, r = idx & 255; S.next(i, u); const float* p = RS + (size_t)u.pm * BM + r;
        float q[16];
#pragma unroll
        for (int k = 0; k < 16; ++k) q[k] = p[(size_t)k * RSLD];
        const float s = (((q[0] + q[1]) + (q[2] + q[3])) + ((q[4] + q[5]) + (q[6] + q[7]))) + (((q[8] + q[9]) + (q[10] + q[11])) + ((q[12] + q[13]) + (q[14] + q[15])));
        rsl[i * 256 + r] = rsqrtf(s * (1.0f / 1024.f) + 1e-6f); }
    __syncthreads();
}
__device__ __forceinline__ float row_rs(PG8_LAS unsigned char* lds, const Unit& u, int rloc) { return ((const PG8_LAS float*)(lds + RSL_OFF))[u.seq * 256 + rloc]; }
typedef unsigned u32x4v __attribute__((ext_vector_type(4)));
struct EpiGU {
    static constexpr bool PERM = true, AFTER_DRAIN = false;
    bf16_t* O; int ldo; PG8_LAS unsigned char* lds;
    __device__ __forceinline__ void operator()(const f32x4 (&acc)[2][2][4][2], const Unit& u, int wr, int wc, int fr, int fq) const {
        const int row0 = u.pm * BM + wr * 64 + fr, col0 = u.pn * HALF + wc * 32 + 8 * fq;
#pragma unroll
        for (int ai = 0; ai < 2; ++ai)
#pragma unroll
            for (int m = 0; m < 4; ++m) { const int row = row0 + ai * HALF + m * 16; const float rs = row_rs(lds, u, wr * 64 + ai * HALF + m * 16 + fr);
                const f32x4 g0 = acc[ai][0][m][0] * rs, g1 = acc[ai][0][m][1] * rs, v0 = acc[ai][1][m][0] * rs, v1 = acc[ai][1][m][1] * rs;
                u32x4v w; w.x = cvt_pk_bf16(silu_f(g0[0]) * v0[0], silu_f(g0[1]) * v0[1]); w.y = cvt_pk_bf16(silu_f(g0[2]) * v0[2], silu_f(g0[3]) * v0[3]);
                w.z = cvt_pk_bf16(silu_f(g1[0]) * v1[0], silu_f(g1[1]) * v1[1]); w.w = cvt_pk_bf16(silu_f(g1[2]) * v1[2], silu_f(g1[3]) * v1[3]);
                *(u32x4v*)(O + (size_t)row * ldo + col0) = w; }
    }
};
struct EpiRes {
    static constexpr bool PERM = true, AFTER_DRAIN = false;
    static constexpr int ldc = 1024;
    bf16_t* XB; bf16_t* XO; float scale; float* RS;
    __device__ __forceinline__ void operator()(const f32x4 (&acc)[2][2][4][2], const Unit& u, int wr, int wc, int fr, int fq) const {
        const int row0 = u.pm * BM + wr * 64 + fr, col0 = u.pn * BM + wc * 32 + 8 * fq;
#pragma unroll
        for (int ai = 0; ai < 2; ++ai) {
            u32x4v xi[4][2];
#pragma unroll
            for (int m = 0; m < 4; ++m)
#pragma unroll
                for (int bj = 0; bj < 2; ++bj) xi[m][bj] = *(const u32x4v*)(XB + (size_t)(row0 + ai * HALF + m * 16) * ldc + col0 + bj * HALF);
#pragma unroll
            for (int m = 0; m < 4; ++m) { const int row = row0 + ai * HALF + m * 16; float ss = 0.f;
#pragma unroll
                for (int bj = 0; bj < 2; ++bj) { const u32x4v x = xi[m][bj];
                    f32x4 o0 = {__uint_as_float(x.x << 16), __uint_as_float(x.x & 0xffff0000u), __uint_as_float(x.y << 16), __uint_as_float(x.y & 0xffff0000u)};
                    f32x4 o1 = {__uint_as_float(x.z << 16), __uint_as_float(x.z & 0xffff0000u), __uint_as_float(x.w << 16), __uint_as_float(x.w & 0xffff0000u)};
                    o0 += scale * acc[ai][bj][m][0]; o1 += scale * acc[ai][bj][m][1];
                    { u32x4v w; w.x = cvt_pk_bf16(o0[0], o0[1]); w.y = cvt_pk_bf16(o0[2], o0[3]); w.z = cvt_pk_bf16(o1[0], o1[1]); w.w = cvt_pk_bf16(o1[2], o1[3]);
                        *(u32x4v*)(XO + (size_t)row * ldc + col0 + bj * HALF) = w;
                        const float r0 = __uint_as_float(w.x << 16), r1 = __uint_as_float(w.x & 0xffff0000u), r2 = __uint_as_float(w.y << 16), r3 = __uint_as_float(w.y & 0xffff0000u),
                                    r4 = __uint_as_float(w.z << 16), r5 = __uint_as_float(w.z & 0xffff0000u), r6 = __uint_as_float(w.w << 16), r7 = __uint_as_float(w.w & 0xffff0000u);
                        ss += (r0 * r0 + r1 * r1 + r2 * r2 + r3 * r3) + (r4 * r4 + r5 * r5 + r6 * r6 + r7 * r7); } }
                { ss += __shfl_xor(ss, 16); ss += __shfl_xor(ss, 32); if (fq == 0) RS[(size_t)(u.pn * 4 + wc) * RSLD + row] = ss; } }
        }
    }
};
struct EpiP {
    static constexpr bool PERM = true, AFTER_DRAIN = false;
    bf16_t* O; int ldo; int ncols; PG8_LAS unsigned char* lds;
    __device__ __forceinline__ void operator()(const f32x4 (&acc)[2][2][4][2], const Unit& u, int wr, int wc, int fr, int fq) const {
        const int row0 = u.pm * BM + wr * 64 + fr, col0 = u.pn * BM + wc * 32 + 8 * fq;
#pragma unroll
        for (int ai = 0; ai < 2; ++ai)
#pragma unroll
            for (int m = 0; m < 4; ++m) { const int row = row0 + ai * HALF + m * 16; bf16_t* rowp = O + (size_t)row * ldo; const float rs = row_rs(lds, u, wr * 64 + ai * HALF + m * 16 + fr);
#pragma unroll
                for (int bj = 0; bj < 2; ++bj) { const int c = col0 + bj * HALF; const f32x4 v0 = acc[ai][bj][m][0] * rs, v1 = acc[ai][bj][m][1] * rs;
                    if (c < ncols) { u32x4v w; w.x = cvt_pk_bf16(v0[0], v0[1]); w.y = cvt_pk_bf16(v0[2], v0[3]); w.z = cvt_pk_bf16(v1[0], v1[1]); w.w = cvt_pk_bf16(v1[2], v1[3]); *(u32x4v*)(rowp + c) = w; } } }
    }
};

struct SplitKOrder {
    int nM, nN, nK, kslice, G, c;
    __device__ bool next(int i, Unit& u) const { const int L = i * G + c; if (L >= nM * nN * nK) return false; u.pn = L % nN; u.pm = (L / nN) % nM; u.k0 = (L / (nN * nM)) * kslice; u.seq = i; return true; }
    __device__ __forceinline__ void a_ready(const Unit&) const {}
    __device__ __forceinline__ void done(const Unit&) const {}
};
struct EpiSlab {
    static constexpr bool PERM = false, AFTER_DRAIN = false;
    float* S; int ldc; int kslice; size_t slab;
    __device__ __forceinline__ void operator()(const f32x4 (&acc)[2][2][4][2], const Unit& u, int wr, int wc, int fr, int fq) const {
        const int row0 = u.pm * BM + wr * 64 + fr, col0 = u.pn * BM + wc * 32 + 4 * fq; float* base = S + (size_t)(u.k0 / kslice) * slab;
#pragma unroll
        for (int ai = 0; ai < 2; ++ai)
#pragma unroll
            for (int m = 0; m < 4; ++m) { float* rowp = base + (size_t)(row0 + ai * HALF + m * 16) * ldc + col0;
#pragma unroll
                for (int bj = 0; bj < 2; ++bj)
#pragma unroll
                    for (int n = 0; n < 2; ++n) *(f32x4*)(rowp + bj * HALF + n * 16) = acc[ai][bj][m][n]; }
    }
};
template <class Epi, class Sched, bool ALIGN_EPI = false, bool SP2 = false>
__device__ __forceinline__ void gemm_phase(PG8_LAS unsigned char* lds, const Gemm g, const Sched& S, const Epi& E) {
    int tid_ = threadIdx.x; asm volatile("" : "+v"(tid_));
    const int tid = tid_, wid = __builtin_amdgcn_readfirstlane(tid >> 6), lane = tid & 63, wr = wid >> 2, wc = wid & 3, fr = lane & 15, fq = lane >> 4;
    const int K = g.K, nt = K / BK, LD = g.ld ? g.ld : g.K;
    unsigned voffA[2], voffB[2];
#pragma unroll
    for (int i = 0; i < 2; ++i) { int R, C; stage_rc(tid * 16 + i * 8192, R, C); const int Rb = Epi::PERM ? ((R & ~31) + perm32(R & 31)) : R;
        voffA[i] = (unsigned)(R * LD + C) * 2u; voffB[i] = (unsigned)(Rb * LD + C) * 2u; }
    const size_t kstep = (size_t)(BK * 2);
    const size_t hstep = (size_t)HALF * LD * 2;
    const size_t tstep = 2 * hstep;
    const unsigned ldsw = (unsigned)wid * 1024u;
    const int aoff = lds_byte(wr * 64 + fr, fq * 8), boff = lds_byte(wc * 32 + fr, fq * 8);
#define PG8_SA(b, h) (((b) * 2 + (h)) * HTB)
#define PG8_SB(b, h) ((4 + (b) * 2 + (h)) * HTB)
#define PG8_STAGE(bufoff, gbase, voff) do { _Pragma("unroll") for (int _i = 0; _i < 2; ++_i) \
        __builtin_amdgcn_global_load_lds((const unsigned*)((const char*)(gbase) + (voff)[_i]), (PG8_LAS unsigned*)(lds + (bufoff) + ldsw + _i * 8192), 16, 0, 0); } while (0)
#define PG8_LDA(dst, b, h) do { _Pragma("unroll") for (int m = 0; m < 4; ++m) _Pragma("unroll") for (int k = 0; k < 2; ++k) dst[m][k] = *(const PG8_LAS bf16x8*)(lds + PG8_SA(b, h) + aoff + m * 2048 + k * 1024); } while (0)
#define PG8_LDB(dst, b, h) do { _Pragma("unroll") for (int n = 0; n < 2; ++n) _Pragma("unroll") for (int k = 0; k < 2; ++k) dst[n][k] = *(const PG8_LAS bf16x8*)(lds + PG8_SB(b, h) + boff + n * 2048 + k * 1024); } while (0)
#define PG8_MMA(ai, bj, At, Bt) do { __builtin_amdgcn_s_setprio(1); _Pragma("unroll") for (int m = 0; m < 4; ++m) _Pragma("unroll") for (int n = 0; n < 2; ++n) _Pragma("unroll") for (int k = 0; k < 2; ++k) \
        acc[ai][bj][m][n] = __builtin_amdgcn_mfma_f32_16x16x32_bf16(Bt[n][k], At[m][k], acc[ai][bj][m][n], 0, 0, 0); __builtin_amdgcn_s_setprio(0); } while (0)
#define PG8_WAIT_V(n) asm volatile("s_waitcnt vmcnt(" #n ")" ::: "memory")
#define PG8_WAIT_L(n) asm volatile("s_waitcnt lgkmcnt(" #n ")" ::: "memory")
#define PG8_BAR __builtin_amdgcn_s_barrier()
#define PG8_SCHED __builtin_amdgcn_sched_barrier(0)
    Unit cur, nxt; int ui = 0;
    if (!S.next(0, cur)) return;
    f32x4 acc[2][2][4][2];
#pragma unroll
    for (int a = 0; a < 2; ++a)
#pragma unroll
        for (int b = 0; b < 2; ++b)
#pragma unroll
            for (int m = 0; m < 4; ++m)
#pragma unroll
                for (int n = 0; n < 2; ++n) acc[a][b][m][n] = (f32x4){0.f, 0.f, 0.f, 0.f};
    bf16x8 At[4][2], B0[2][2], B1[2][2];
    const char* cA = (const char*)g.A + (size_t)cur.pm * tstep + (size_t)cur.k0 * 2; const char* cB = (const char*)g.Bt + (size_t)cur.pn * tstep + (size_t)cur.k0 * 2;
    S.a_ready(cur);
    if constexpr (SP2) {
        PG8_STAGE(PG8_SB(0, 0), cB, voffB); PG8_STAGE(PG8_SB(0, 1), cB + hstep, voffB); PG8_STAGE(PG8_SA(0, 0), cA, voffA); PG8_STAGE(PG8_SA(0, 1), cA + hstep, voffA);
        if (wr == 1) PG8_BAR;
        PG8_WAIT_V(2); PG8_BAR;
        PG8_STAGE(PG8_SB(1, 0), cB + kstep, voffB); PG8_STAGE(PG8_SA(1, 0), cA + kstep, voffA); PG8_STAGE(PG8_SB(1, 1), cB + hstep + kstep, voffB);
        PG8_WAIT_V(6); PG8_BAR;
    } else {
        PG8_STAGE(PG8_SB(0, 0), cB, voffB); PG8_STAGE(PG8_SA(0, 0), cA, voffA); PG8_STAGE(PG8_SB(0, 1), cB + hstep, voffB); PG8_STAGE(PG8_SA(0, 1), cA + hstep, voffA);
        if (wr == 1) PG8_BAR;
        PG8_WAIT_V(4); PG8_BAR;
        PG8_STAGE(PG8_SB(1, 0), cB + kstep, voffB); PG8_STAGE(PG8_SA(1, 0), cA + kstep, voffA); PG8_STAGE(PG8_SB(1, 1), cB + hstep + kstep, voffB);
        PG8_WAIT_V(6); PG8_BAR;
    }
    for (;;) {
        const bool has_next = S.next(ui + 1, nxt);
        const char* nA = has_next ? (const char*)g.A + (size_t)nxt.pm * tstep + (size_t)nxt.k0 * 2 : cA; const char* nB = has_next ? (const char*)g.Bt + (size_t)nxt.pn * tstep + (size_t)nxt.k0 * 2 : cB;
        for (int t = 0; t < nt; t += 2) {
            const bool last = (t == nt - 2);
            const char* a1 = cA + (size_t)(t + 1) * kstep;
            const char* a2 = last ? nA : cA + (size_t)(t + 2) * kstep; const char* b2 = last ? nB : cB + (size_t)(t + 2) * kstep;
            const char* a3 = a2 + kstep; const char* b3 = b2 + kstep;
            if (last && has_next) S.a_ready(nxt);
            if constexpr (SP2) {
            PG8_LDB(B0, 0, 0); PG8_LDB(B1, 0, 1); PG8_SCHED; PG8_LDA(At, 0, 0); PG8_STAGE(PG8_SA(1, 1), a1 + hstep, voffA);
            PG8_WAIT_V(8); PG8_WAIT_L(0); PG8_BAR; PG8_MMA(0, 0, At, B0); PG8_MMA(0, 1, At, B1); PG8_BAR; PG8_SCHED;
            PG8_LDA(At, 0, 1); PG8_STAGE(PG8_SB(0, 0), b2, voffB); PG8_STAGE(PG8_SB(0, 1), b2 + hstep, voffB); PG8_STAGE(PG8_SA(0, 0), a2, voffA);
            PG8_WAIT_V(8); PG8_WAIT_L(0); PG8_BAR; PG8_MMA(1, 0, At, B0); PG8_MMA(1, 1, At, B1); PG8_BAR; PG8_SCHED;
            PG8_LDB(B0, 1, 0); PG8_LDB(B1, 1, 1); PG8_SCHED; PG8_LDA(At, 1, 0); PG8_STAGE(PG8_SA(0, 1), a2 + hstep, voffA);
            PG8_WAIT_V(8); PG8_WAIT_L(0); PG8_BAR; PG8_MMA(0, 0, At, B0); PG8_MMA(0, 1, At, B1); PG8_BAR; PG8_SCHED;
            PG8_LDA(At, 1, 1); PG8_STAGE(PG8_SB(1, 0), b3, voffB); PG8_STAGE(PG8_SB(1, 1), b3 + hstep, voffB); PG8_STAGE(PG8_SA(1, 0), a3, voffA);
            PG8_WAIT_V(8); PG8_WAIT_L(0); PG8_BAR; PG8_MMA(1, 0, At, B0); PG8_MMA(1, 1, At, B1); PG8_BAR; PG8_SCHED;
            } else {
            PG8_LDB(B0, 0, 0); PG8_SCHED; PG8_LDA(At, 0, 0); PG8_STAGE(PG8_SA(1, 1), a1 + hstep, voffA);
            PG8_WAIT_L(8); PG8_BAR; PG8_WAIT_L(0); PG8_MMA(0, 0, At, B0); PG8_BAR; PG8_SCHED;
            PG8_LDB(B1, 0, 1); PG8_STAGE(PG8_SB(0, 0), b2, voffB);
            PG8_BAR; PG8_WAIT_L(0); PG8_MMA(0, 1, At, B1); PG8_BAR;
            PG8_LDA(At, 0, 1); PG8_STAGE(PG8_SA(0, 0), a2, voffA);
            PG8_BAR; PG8_WAIT_L(0); PG8_MMA(1, 0, At, B0); PG8_BAR; PG8_SCHED;
            PG8_STAGE(PG8_SB(0, 1), b2 + hstep, voffB);
            PG8_WAIT_V(6); PG8_BAR; PG8_MMA(1, 1, At, B1); PG8_BAR;
            PG8_LDB(B0, 1, 0); PG8_SCHED; PG8_LDA(At, 1, 0); PG8_STAGE(PG8_SA(0, 1), a2 + hstep, voffA);
            PG8_WAIT_L(8); PG8_BAR; PG8_WAIT_L(0); PG8_MMA(0, 0, At, B0); PG8_BAR; PG8_SCHED;
            PG8_LDB(B1, 1, 1); PG8_STAGE(PG8_SB(1, 0), b3, voffB);
            PG8_BAR; PG8_WAIT_L(0); PG8_MMA(0, 1, At, B1); PG8_BAR;
            PG8_LDA(At, 1, 1); PG8_STAGE(PG8_SA(1, 0), a3, voffA);
            PG8_BAR; PG8_WAIT_L(0); PG8_MMA(1, 0, At, B0); PG8_BAR; PG8_SCHED;
            PG8_STAGE(PG8_SB(1, 1), b3 + hstep, voffB);
            PG8_WAIT_V(6); PG8_BAR; PG8_MMA(1, 1, At, B1); PG8_BAR;
            }
        }
        if constexpr (ALIGN_EPI) { if (wr == 0) PG8_BAR; }
        if constexpr (!Epi::AFTER_DRAIN) { E(acc, cur, wr, wc, fr, fq); S.done(cur); }
        if (!has_next) break;
#pragma unroll
        for (int a = 0; a < 2; ++a)
#pragma unroll
            for (int b = 0; b < 2; ++b)
#pragma unroll
                for (int m = 0; m < 4; ++m)
#pragma unroll
                    for (int n = 0; n < 2; ++n) acc[a][b][m][n] = (f32x4){0.f, 0.f, 0.f, 0.f};
        cur = nxt; cA = nA; cB = nB; ++ui;
        if constexpr (ALIGN_EPI) { if (wr == 1) PG8_BAR; }
    }
    PG8_WAIT_V(0);
    if constexpr (!ALIGN_EPI) { if (wr == 0) PG8_BAR; }
    PG8_BAR;
    if constexpr (Epi::AFTER_DRAIN) { E.fused(acc, cur, wr, wc, fr, fq, lds, wid, lane); S.done(cur); }
#undef PG8_SA
#undef PG8_SB
#undef PG8_STAGE
#undef PG8_LDA
#undef PG8_LDB
#undef PG8_MMA
#undef PG8_WAIT_V
#undef PG8_WAIT_L
#undef PG8_BAR
#undef PG8_SCHED
}
}
#define XB_TMO      128
#define XB_XCNT(j)  (256  + 64 * (j))
#define XB_XSUB(j)  (1280 + 64 * (j))
#define XB_XGEN(j)  (2304 + 64 * (j))
#define XB_TOP      3328
#define XB_TOPGEN   3392
#define XCD_BAR_WORDS 3456
#define XB_SPIN_CAP (1u << 24)
#define LAS __attribute__((address_space(3)))

__device__ __forceinline__ unsigned xb_ld(unsigned* p)              { return __hip_atomic_load(p, __ATOMIC_RELAXED, __HIP_MEMORY_SCOPE_AGENT); }
__device__ __forceinline__ unsigned xb_add(unsigned* p, unsigned v) { return __hip_atomic_fetch_add(p, v, __ATOMIC_RELAXED, __HIP_MEMORY_SCOPE_AGENT); }
__device__ __forceinline__ unsigned xb_xcc_id() { return (unsigned)__builtin_amdgcn_s_getreg((3 << 11) | 20) & 0xFu; }
#define XB_SPIN(cond, bar) do { unsigned _sp = 0; while (cond) { __builtin_amdgcn_s_sleep(1); \
    if ((++_sp & 255u) == 0u) { if (xb_ld(&(bar)[XB_TMO])) break; if (_sp > XB_SPIN_CAP) { atomicAdd(&(bar)[XB_TMO], 1u); break; } } } } while (0)

struct XcdBarrier {
    unsigned* bar; unsigned x;
    volatile LAS unsigned* st;
};

__device__ __forceinline__ XcdBarrier xcd_barrier_post(unsigned* bar, volatile LAS unsigned* st) {
    XcdBarrier b; b.bar = bar; b.x = xb_xcc_id(); b.st = st;
    if (threadIdx.x == 0) (void)xb_add(&bar[XB_XCNT(b.x)], 1u);
    return b;
}
__device__ __forceinline__ void xcd_barrier_complete(unsigned* bar, unsigned x, unsigned& nloc, unsigned& nx) {
    const unsigned G = gridDim.x * gridDim.y * gridDim.z;
    unsigned sum, cnt, mine, sp = 0u;
    for (;;) {
        sum = 0u; cnt = 0u; mine = 0u;
#pragma unroll
        for (unsigned j = 0; j < 16; ++j) { const unsigned c = xb_ld(&bar[XB_XCNT(j)]); sum += c; cnt += (c > 0u) ? 1u : 0u; mine = (j == x) ? c : mine; }
        if (sum == G) break;
        __builtin_amdgcn_s_sleep(1);
        if ((++sp & 255u) == 0u) { if (xb_ld(&bar[XB_TMO])) break; if (sp > XB_SPIN_CAP) { atomicAdd(&bar[XB_TMO], 1u); break; } }
    }
    nloc = mine > 0u ? mine : 1u; nx = cnt > 0u ? cnt : 1u;
}

__device__ __forceinline__ void xcd_barrier(const XcdBarrier& b) {
    asm volatile("s_waitcnt vmcnt(0)" ::: "memory");
    __syncthreads();
    if (threadIdx.x == 0) {
        unsigned* bar = b.bar;
        __builtin_amdgcn_s_waitcnt(0);
        unsigned nloc = b.st[0], nx = b.st[1];
        if (nloc == 0u) { xcd_barrier_complete(bar, b.x, nloc, nx); b.st[0] = nloc; b.st[1] = nx; }
        const unsigned old = xb_add(&bar[XB_XSUB(b.x)], 1u);
        const unsigned gen = old / nloc;
        if (old + 1u == (gen + 1u) * nloc) {
            __builtin_amdgcn_fence(__ATOMIC_RELEASE, "agent");
            asm volatile("s_waitcnt vmcnt(0)" ::: "memory");
            const unsigned og = xb_add(&bar[XB_TOP], 1u);
            const unsigned tg = og / nx;
            if (og + 1u == (tg + 1u) * nx) xb_add(&bar[XB_TOPGEN], 1u);
            else XB_SPIN(xb_ld(&bar[XB_TOPGEN]) == tg, bar);
            __builtin_amdgcn_fence(__ATOMIC_ACQUIRE, "agent");
            xb_add(&bar[XB_XGEN(b.x)], 1u);
            asm volatile("s_waitcnt vmcnt(0)" ::: "memory");
        } else {
            XB_SPIN(xb_ld(&bar[XB_XGEN(b.x)]) == gen, bar);
            __builtin_amdgcn_fence(__ATOMIC_ACQUIRE, "agent");
            asm volatile("s_waitcnt vmcnt(0)" ::: "memory");
        }
    }
    __syncthreads();
}


typedef unsigned short bf16_t;
typedef float f32x4 __attribute__((ext_vector_type(4)));
typedef unsigned u32x2 __attribute__((ext_vector_type(2)));
typedef unsigned u32x4 __attribute__((ext_vector_type(4)));
constexpr int TP = 32768, TS = 1024, T = 33792, D = 1024, FF = 2816, NGU = 5632, PSTR = 3104, NPIN = 3328;
constexpr int PQ = 0, PK = 384, PV = 768, PZA = 1152, PZB = 1536, PXBC = 1920, PGC = 2560, PXC = 2816, PBA = 3072, PAA = 3078, PDT = 3084;
constexpr size_t SZ_WGU = (size_t)NGU * D * 2, SZ_WDN = (size_t)D * FF * 2, SZ_WIN = (size_t)NPIN * D * 2, SZ_WOUT = (size_t)D * D * 2;
constexpr size_t WS_CTL = 0, WS_WGU = 65536, WS_WDN = WS_WGU + 4 * SZ_WGU, WS_WIN = WS_WDN + 4 * SZ_WDN, WS_WOUT = WS_WIN + 2 * SZ_WIN,
                 WS_H = WS_WOUT + 2 * SZ_WOUT, WS_P = WS_H + (size_t)T * D * 2, WS_M = WS_P + (size_t)T * PSTR * 2;
constexpr size_t WS_END = WS_M + (size_t)160 * 1024 * 1024;
constexpr size_t O_PDS = (size_t)T * D, O_PDC = O_PDS + 2 * 2 * 6 * 4096, O_PSH = O_PDC + 2 * 2 * 3 * 1152, O_PSC = O_PSH + 2 * 2 * 6 * 4096, O_PLH = O_PSC + 2 * 2 * 3 * 640,
                 O_PLC = O_PLH + 2 * 2 * 256, O_SDS = O_PLC + 2 * 2 * 3 * 256, O_SDC = O_SDS + 2 * 16 * 6 * 4096, O_SSH = O_SDC + 2 * 16 * 3 * 1152, O_SSC = O_SSH + 2 * 16 * 6 * 4096,
                 O_SLH = O_SSC + 2 * 16 * 3 * 640, O_SLC = O_SLH + 2 * 16 * 256, O_END = O_SLC + 2 * 16 * 3 * 256;
constexpr int LDS_BYTES = 148 * 1024;
constexpr int MISC_OFF = 144 * 1024;

__device__ __forceinline__ int tidx() { int t = threadIdx.x; asm volatile("" : "+v"(t)); return t; }
struct Args { const float* in[37]; float* out; unsigned char* ws; int ph_lo, ph_hi; };
typedef __attribute__((address_space(4))) Args CArgs;
#define INP(a, k) ((a).in[k])
#define OUTP(a) ((a).out)
#define WSP(a) ((a).ws)

__device__ __forceinline__ float bf2f(bf16_t b) { return __uint_as_float(((unsigned)b) << 16); }
__device__ __forceinline__ bf16_t f2bf(float f) { unsigned u = __float_as_uint(f); u += 0x7FFFu + ((u >> 16) & 1u); return (bf16_t)(u >> 16); }
__device__ __forceinline__ unsigned pk_bf16(float lo, float hi) { return (unsigned)f2bf(lo) | ((unsigned)f2bf(hi) << 16); }
__device__ __forceinline__ float sigmoid_f(float x) { return __builtin_amdgcn_rcpf(1.0f + __expf(-x)); }
__device__ __forceinline__ float softplus_f(float x) { return fmaxf(x, 0.f) + log1pf(__expf(-fabsf(x))); }
__device__ __forceinline__ float siluf(float x) { return x * __builtin_amdgcn_rcpf(1.0f + __expf(-x)); }
__device__ __forceinline__ float gelu_tanh(float x) { const float u = 0.7978845608028654f * (x + 0.044715f * x * x * x); return 0.5f * x * (1.0f + tanhf(u)); }
__device__ __forceinline__ float one_minus_exp(float t) { const float p = -t * (1.0f + t * (0.5f + t * (0.16666667f + t * 0.041666668f))); return t > -0.03125f ? p : 1.0f - __expf(t); }
__device__ __forceinline__ float wave_sum(float v) {
#pragma unroll
    for (int o = 32; o >= 1; o >>= 1) v += __shfl_xor(v, o);
    return v; }
__device__ __forceinline__ float rdlane(float v, int l) { return __int_as_float(__builtin_amdgcn_readlane(__float_as_int(v), l)); }
__device__ __forceinline__ float* state_out(float* out, size_t base_p, size_t base_s, int l, int s, size_t sz) { return s < 2 ? out + base_p + ((size_t)l * 2 + s) * sz : out + base_s + ((size_t)l * 16 + (s - 2)) * sz; }
__device__ __forceinline__ int seq_len(int s) { return s < 2 ? 16384 : 64; }
__device__ __forceinline__ size_t seq_row0(int s) { return s < 2 ? (size_t)s * 16384 : (size_t)TP + (size_t)(s - 2) * 64; }

__device__ __forceinline__ int win_refcol(int c) {
    if (c < 1536) return c;
    if (c < 1920) return 1548 + (c - 1536);
    if (c < 2560) return 1932 + (c - 1920);
    if (c < 2816) return 2578 + (c - 2560);
    if (c < 3072) return 2834 + (c - 2816);
    if (c < 3078) return 1536 + (c - 3072);
    if (c < 3084) return 1542 + (c - 3078);
    if (c < 3090) return 2572 + (c - 3084);
    return -1; }
struct WTile { const float* src; const float* gain; bf16_t* dst; int K, ldw, rho0, k0, col; };
__device__ __forceinline__ void wprep_decode(const CArgs& a, int id, int tid, WTile& t) {
    constexpr int PER_LAYER = 1408 * 2 + 704 * 2 + 832 + 256;
    const int l = id / PER_LAYER; int r = id % PER_LAYER; int kind; const float* w0; const float* w1 = nullptr; t.gain = nullptr;
    if (r < 2816) { const int f = r / 1408; r %= 1408; kind = 0; t.K = D; t.ldw = FF; w0 = INP(a, f ? 33 : 9) + (size_t)l * D * FF; w1 = INP(a, f ? 34 : 10) + (size_t)l * D * FF; t.gain = INP(a, f ? 32 : 8) + (size_t)l * D; t.dst = (bf16_t*)(WSP(a) + WS_WGU + (size_t)(l * 2 + f) * SZ_WGU); }
    else if (r < 4224) { r -= 2816; const int f = r / 704; r %= 704; kind = 1; t.K = FF; t.ldw = D; w0 = INP(a, f ? 35 : 11) + (size_t)l * FF * D; t.dst = (bf16_t*)(WSP(a) + WS_WDN + (size_t)(l * 2 + f) * SZ_WDN); }
    else if (r < 5056) { r -= 4224; kind = 2; t.K = D; t.ldw = 3090; w0 = INP(a, 13) + (size_t)l * D * 3090; t.gain = INP(a, 12) + (size_t)l * D; t.dst = (bf16_t*)(WSP(a) + WS_WIN + (size_t)l * SZ_WIN); }
    else { r -= 5056; kind = 1; t.K = D; t.ldw = D; w0 = INP(a, 31) + (size_t)l * D * D; t.dst = (bf16_t*)(WSP(a) + WS_WOUT + (size_t)l * SZ_WOUT); }
    const int ktiles = t.K / 64; t.rho0 = (r / ktiles) * 64; t.k0 = (r % ktiles) * 64;
    const int rho = t.rho0 + (tid & 63); t.src = w0; t.col = rho;
    if (kind == 0) { const int U = rho >> 8, uu = (rho >> 7) & 1, i = rho & 127; t.src = uu ? w1 : w0; t.col = 128 * U + i; }
    else if (kind == 2) t.col = win_refcol(rho);
}
__device__ __forceinline__ void wprep_load(const WTile& t, int tid, float (&v)[8]) {
    const int kk0 = tid >> 6;
#pragma unroll
    for (int j = 0; j < 8; ++j) { const int kk = kk0 + 8 * j; v[j] = t.col >= 0 ? t.src[(size_t)(t.k0 + kk) * t.ldw + t.col] * (t.gain ? t.gain[t.k0 + kk] : 1.0f) : 0.f; }
}
__device__ void wprep_phase(const CArgs& a, LAS unsigned char* lds) {
    LAS float* tile = (LAS float*)lds;
    const int tid = tidx(); constexpr int NT = 2 * (1408 * 2 + 704 * 2 + 832 + 256);
    int id = blockIdx.x; if (id >= NT) return;
    WTile cur, nxt; float v[8];
    wprep_decode(a, id, tid, cur); wprep_load(cur, tid, v);
    for (; id < NT; id += gridDim.x) {
        {   const int rr = tid & 63, kk0 = tid >> 6;
#pragma unroll
            for (int j = 0; j < 8; ++j) tile[(kk0 + 8 * j) * 65 + rr] = v[j]; }
        __syncthreads();
        const bool more = id + (int)gridDim.x < NT;
        if (more) { wprep_decode(a, id + gridDim.x, tid, nxt); wprep_load(nxt, tid, v); }
        {   const int rr = tid >> 3, ks = tid & 7; float o[8];
#pragma unroll
            for (int e = 0; e < 8; ++e) o[e] = tile[(ks * 8 + e) * 65 + rr];
            u32x4 w; w.x = pk_bf16(o[0], o[1]); w.y = pk_bf16(o[2], o[3]); w.z = pk_bf16(o[4], o[5]); w.w = pk_bf16(o[6], o[7]);
            *(u32x4*)(cur.dst + (size_t)(cur.rho0 + rr) * cur.K + cur.k0 + ks * 8) = w; }
        __syncthreads();
        cur = nxt;
    }
}

constexpr int XSPLIT = T / 2;
constexpr size_t WS_RS = WS_M + (size_t)70 * 1024 * 1024;
__device__ void norm_phase(const CArgs& a, const float* gain, int mode) {
    float* Y = OUTP(a); bf16_t* XB = (bf16_t*)OUTP(a); float* RS = (float*)(WSP(a) + WS_RS); const bf16_t* XF = (const bf16_t*)(WSP(a) + WS_H);
    const int lane = tidx() & 63, gw = blockIdx.x * 8 + (tidx() >> 6), nw = gridDim.x * 8;
    f32x4 g[4];
#pragma unroll
    for (int j = 0; j < 4; ++j) g[j] = mode == 2 ? *(const f32x4*)(gain + j * 256 + lane * 4) : (f32x4){1.f, 1.f, 1.f, 1.f};
    for (int row0 = gw; row0 < T; row0 += 2 * nw) {
        f32x4 v[2][4]; float ss[2] = {0.f, 0.f};
#pragma unroll
        for (int q = 0; q < 2; ++q) { const int row = row0 + q * nw; if (row < T) {
            if (mode == 0) { const float* src = row < TP ? INP(a, 0) + (size_t)row * D : INP(a, 1) + (size_t)(row - TP) * D;
#pragma unroll
                for (int j = 0; j < 4; ++j) v[q][j] = *(const f32x4*)(src + j * 256 + lane * 4); }
            else {
#pragma unroll
                for (int j = 0; j < 4; ++j) { const u32x2 x = *(const u32x2*)(XF + (size_t)row * D + j * 256 + lane * 4);
                    v[q][j] = (f32x4){__uint_as_float(x.x << 16), __uint_as_float(x.x & 0xffff0000u), __uint_as_float(x.y << 16), __uint_as_float(x.y & 0xffff0000u)}; } } } }
#pragma unroll
        for (int q = 0; q < 2; ++q) { const int row = row0 + q * nw; if (row < T) {
#pragma unroll
            for (int j = 0; j < 4; ++j) ss[q] += v[q][j][0] * v[q][j][0] + v[q][j][1] * v[q][j][1] + v[q][j][2] * v[q][j][2] + v[q][j][3] * v[q][j][3];
            ss[q] = wave_sum(ss[q]);
            if (mode == 0) { if (lane < 16) RS[(size_t)lane * T + row] = lane == 0 ? ss[q] : 0.f; }
            const float r = rsqrtf(ss[q] * (1.0f / D) + 1e-6f);
#pragma unroll
            for (int j = 0; j < 4; ++j) {
                if (mode == 0) { u32x2 w; w.x = pk_bf16(v[q][j][0], v[q][j][1]); w.y = pk_bf16(v[q][j][2], v[q][j][3]); *(u32x2*)(XB + (size_t)row * D + j * 256 + lane * 4) = w; }
                else *(f32x4*)(Y + (size_t)row * D + j * 256 + lane * 4) = v[q][j] * r * g[j];
            } } }
    }
}

constexpr size_t WS_SLAB = WS_M + (size_t)80 * 1024 * 1024;
template <int NSL> __device__ __forceinline__ void sample_reduce_phase(const CArgs& a, float scale, bool last, float* RS) {
    bf16_t* XB = (bf16_t*)OUTP(a); bf16_t* XO = last ? (bf16_t*)(WSP(a) + WS_H) : XB; const float* SL = (const float*)(WSP(a) + WS_SLAB);
    const int lane = tidx() & 63, gw = blockIdx.x * 8 + (tidx() >> 6);
    if (gw >= TS) return;
    const size_t row = (size_t)TP + gw; float ss = 0.f;
#pragma unroll
    for (int jh = 0; jh < 2; ++jh) { f32x4 v[2][NSL]; u32x2 xb[2];
#pragma unroll
        for (int jj = 0; jj < 2; ++jj) { const int c = (2 * jh + jj) * 256 + lane * 4; xb[jj] = *(const u32x2*)(XB + row * D + c);
#pragma unroll
            for (int k = 0; k < NSL; ++k) v[jj][k] = *(const f32x4*)(SL + ((size_t)k * TS + gw) * D + c); }
#pragma unroll
        for (int jj = 0; jj < 2; ++jj) { const int c = (2 * jh + jj) * 256 + lane * 4; f32x4 s = v[jj][0];
#pragma unroll
            for (int k = 1; k < NSL; ++k) s += v[jj][k];
            const f32x4 x = {__uint_as_float(xb[jj].x << 16), __uint_as_float(xb[jj].x & 0xffff0000u), __uint_as_float(xb[jj].y << 16), __uint_as_float(xb[jj].y & 0xffff0000u)};
            const f32x4 o = x + scale * s;
            { u32x2 w; w.x = pk_bf16(o[0], o[1]); w.y = pk_bf16(o[2], o[3]); *(u32x2*)(XO + row * D + c) = w;
                const float r0 = __uint_as_float(w.x << 16), r1 = __uint_as_float(w.x & 0xffff0000u), r2 = __uint_as_float(w.y << 16), r3 = __uint_as_float(w.y & 0xffff0000u);
                ss += r0 * r0 + r1 * r1 + r2 * r2 + r3 * r3; } } }
    ss = wave_sum(ss);
    if (lane < 16) RS[(size_t)lane * T + row] = lane == 0 ? ss : 0.f;
}

__device__ __forceinline__ float ldp(const bf16_t* P, size_t row, int col) { return bf2f(P[row * PSTR + col]); }

__device__ void naive_delta_chain(const CArgs& a, int l, int s, int h, int lane) {
    const bf16_t* P = (const bf16_t*)(WSP(a) + WS_P); bf16_t* MIX = (bf16_t*)(WSP(a) + WS_H);
    const int L = seq_len(s); const size_t row0 = seq_row0(s);
    float S[64]; float hq[3], hk[3], hv[3];
    if (s < 2) {
#pragma unroll
        for (int i = 0; i < 64; ++i) S[i] = 0.f;
#pragma unroll
        for (int j = 0; j < 3; ++j) { hq[j] = 0.f; hk[j] = 0.f; hv[j] = 0.f; }
    } else {
        const int sb = s - 2; const float* s0 = INP(a, 2) + (((size_t)l * 16 + sb) * 6 + h) * 4096;
#pragma unroll
        for (int i = 0; i < 64; ++i) S[i] = s0[i * 64 + lane];
        const float* cb = INP(a, 3) + ((size_t)l * 16 + sb) * 3 * 1152;
#pragma unroll
        for (int j = 0; j < 3; ++j) { hq[j] = cb[j * 1152 + PQ + h * 64 + lane]; hk[j] = cb[j * 1152 + PK + h * 64 + lane]; hv[j] = cb[j * 1152 + PV + h * 64 + lane]; }
    }
    const float* cw = INP(a, 14) + (size_t)l * 4 * 1152;
    float wq[4], wk[4], wv[4];
#pragma unroll
    for (int k = 0; k < 4; ++k) { wq[k] = cw[k * 1152 + PQ + h * 64 + lane]; wk[k] = cw[k * 1152 + PK + h * 64 + lane]; wv[k] = cw[k * 1152 + PV + h * 64 + lane]; }
    const float Aexp = __expf(INP(a, 15)[l * 6 + h]), dtb = INP(a, 16)[l * 6 + h], nw = INP(a, 17)[l * 64 + lane];
    float nq = ldp(P, row0, PQ + h * 64 + lane), nk = ldp(P, row0, PK + h * 64 + lane), nv = ldp(P, row0, PV + h * 64 + lane);
    float nb = ldp(P, row0, PBA + h), na = ldp(P, row0, PAA + h), nz = ldp(P, row0, PZA + h * 64 + lane);
    for (int t = 0; t < L; ++t) {
        const size_t row = row0 + t;
        const float xq = nq, xk = nk, xv = nv, xb = nb, xa = na, xz = nz;
        { const size_t rn = row0 + (t + 1 < L ? t + 1 : t);
          nq = ldp(P, rn, PQ + h * 64 + lane); nk = ldp(P, rn, PK + h * 64 + lane); nv = ldp(P, rn, PV + h * 64 + lane);
          nb = ldp(P, rn, PBA + h); na = ldp(P, rn, PAA + h); nz = ldp(P, rn, PZA + h * 64 + lane); }
        float q = siluf(wq[0] * hq[0] + wq[1] * hq[1] + wq[2] * hq[2] + wq[3] * xq);
        float k = siluf(wk[0] * hk[0] + wk[1] * hk[1] + wk[2] * hk[2] + wk[3] * xk);
        const float v = siluf(wv[0] * hv[0] + wv[1] * hv[1] + wv[2] * hv[2] + wv[3] * xv);
        hq[0] = hq[1]; hq[1] = hq[2]; hq[2] = xq; hk[0] = hk[1]; hk[1] = hk[2]; hk[2] = xk; hv[0] = hv[1]; hv[1] = hv[2]; hv[2] = xv;
        q *= rsqrtf(wave_sum(q * q) + 1e-6f) * 0.125f;
        k *= rsqrtf(wave_sum(k * k) + 1e-6f);
        const float beta = sigmoid_f(xb), alpha = __expf(-Aexp * softplus_f(xa + dtb));
        float kS = 0.f;
#pragma unroll
        for (int i = 0; i < 64; ++i) kS += rdlane(k, i) * S[i];
        const float dl = beta * (v - alpha * kS);
        float o = 0.f;
#pragma unroll
        for (int i = 0; i < 64; ++i) { S[i] = alpha * S[i] + rdlane(k, i) * dl; o += rdlane(q, i) * S[i]; }
        const float ms = wave_sum(o * o) * (1.0f / 64.f);
        MIX[row * D + h * 64 + lane] = f2bf(o * rsqrtf(ms + 1e-6f) * nw * siluf(xz));
    }
    float* so = state_out(OUTP(a), O_PDS, O_SDS, l, s, 6 * 4096) + (size_t)h * 4096;
#pragma unroll
    for (int i = 0; i < 64; ++i) so[i * 64 + lane] = S[i];
    float* co = state_out(OUTP(a), O_PDC, O_SDC, l, s, 3 * 1152);
#pragma unroll
    for (int j = 0; j < 3; ++j) { co[j * 1152 + PQ + h * 64 + lane] = hq[j]; co[j * 1152 + PK + h * 64 + lane] = hk[j]; co[j * 1152 + PV + h * 64 + lane] = hv[j]; }
}

__device__ void naive_ssd_block(const CArgs& a, int l, int s, int g, LAS float* red) {
    const bf16_t* P = (const bf16_t*)(WSP(a) + WS_P); bf16_t* MIX = (bf16_t*)(WSP(a) + WS_H);
    const int tid = tidx(), hh = tid >> 6, p = tid & 63, head = g * 3 + (hh < 3 ? hh : 0); const bool act = tid < 192;
    const int L = seq_len(s); const size_t row0 = seq_row0(s);
    const int cx = head * 64 + p, cB = 384 + g * 64 + p, cC = 512 + g * 64 + p;
    float hst[64]; float hx[3], hB[3], hC[3];
    if (s < 2 || !act) {
#pragma unroll
        for (int i = 0; i < 64; ++i) hst[i] = 0.f;
#pragma unroll
        for (int j = 0; j < 3; ++j) { hx[j] = 0.f; hB[j] = 0.f; hC[j] = 0.f; }
    } else {
        const int sb = s - 2; const float* s0 = INP(a, 4) + (((size_t)l * 16 + sb) * 6 + head) * 4096;
#pragma unroll
        for (int i = 0; i < 64; ++i) hst[i] = s0[i * 64 + p];
        const float* cb = INP(a, 5) + ((size_t)l * 16 + sb) * 3 * 640;
#pragma unroll
        for (int j = 0; j < 3; ++j) { hx[j] = cb[j * 640 + cx]; hB[j] = cb[j * 640 + cB]; hC[j] = cb[j * 640 + cC]; }
    }
    const float* cw = INP(a, 18) + (size_t)l * 4 * 640; const float* cbias = INP(a, 19) + (size_t)l * 640;
    float wx[4], wB[4], wC[4];
#pragma unroll
    for (int k = 0; k < 4; ++k) { wx[k] = cw[k * 640 + cx]; wB[k] = cw[k * 640 + cB]; wC[k] = cw[k * 640 + cC]; }
    const float bx = cbias[cx], bB = cbias[cB], bC = cbias[cC];
    const float Aneg = -__expf(INP(a, 20)[l * 6 + head]), dtb = INP(a, 21)[l * 6 + head], dsk = INP(a, 22)[l * 6 + head], nw = INP(a, 23)[l * 384 + g * 192 + (hh < 3 ? hh : 0) * 64 + p];
    for (int t = 0; t < L; ++t) {
        const size_t row = row0 + t;
        float y = 0.f, xs = 0.f;
        if (act) {
            const float rx = ldp(P, row, PXBC + cx), rB = ldp(P, row, PXBC + cB), rC = ldp(P, row, PXBC + cC);
            xs = siluf(wx[0] * hx[0] + wx[1] * hx[1] + wx[2] * hx[2] + wx[3] * rx + bx);
            const float Bn = siluf(wB[0] * hB[0] + wB[1] * hB[1] + wB[2] * hB[2] + wB[3] * rB + bB);
            const float Cn = siluf(wC[0] * hC[0] + wC[1] * hC[1] + wC[2] * hC[2] + wC[3] * rC + bC);
            hx[0] = hx[1]; hx[1] = hx[2]; hx[2] = rx; hB[0] = hB[1]; hB[1] = hB[2]; hB[2] = rB; hC[0] = hC[1]; hC[1] = hC[2]; hC[2] = rC;
            const float dt = softplus_f(ldp(P, row, PDT + head) + dtb), dA = __expf(dt * Aneg), dx = dt * xs;
#pragma unroll
            for (int i = 0; i < 64; ++i) { hst[i] = dA * hst[i] + rdlane(Bn, i) * dx; y += rdlane(Cn, i) * hst[i]; }
            y += dsk * xs;
            y *= siluf(ldp(P, row, PZB + head * 64 + p));
            const float sq = wave_sum(y * y);
            if (p == 0) red[hh] = sq;
        }
        __syncthreads();
        if (act) {
            const float ms = (red[0] + red[1] + red[2]) * (1.0f / 192.f);
            MIX[row * D + 384 + g * 192 + hh * 64 + p] = f2bf(y * rsqrtf(ms + 1e-6f) * nw);
        }
        __syncthreads();
    }
    if (act) {
        float* so = state_out(OUTP(a), O_PSH, O_SSH, l, s, 6 * 4096) + (size_t)head * 4096;
#pragma unroll
        for (int i = 0; i < 64; ++i) so[i * 64 + p] = hst[i];
        float* co = state_out(OUTP(a), O_PSC, O_SSC, l, s, 3 * 640);
#pragma unroll
        for (int j = 0; j < 3; ++j) { co[j * 640 + cx] = hx[j]; if (hh == 0) { co[j * 640 + cB] = hB[j]; co[j * 640 + cC] = hC[j]; } }
    }
}

__device__ void naive_lru_block(const CArgs& a, int l, int s, LAS float* xsh) {
    const bf16_t* P = (const bf16_t*)(WSP(a) + WS_P); bf16_t* MIX = (bf16_t*)(WSP(a) + WS_H);
    const int tid = tidx(), ch = tid & 255; const bool act = tid < 256;
    const int L = seq_len(s); const size_t row0 = seq_row0(s);
    float hx[3] = {0.f, 0.f, 0.f}, h = 0.f;
    if (s >= 2) { const int sb = s - 2; h = INP(a, 6)[((size_t)l * 16 + sb) * 256 + ch]; const float* cb = INP(a, 7) + ((size_t)l * 16 + sb) * 3 * 256;
#pragma unroll
        for (int j = 0; j < 3; ++j) hx[j] = cb[j * 256 + ch]; }
    const float* cw = INP(a, 24) + (size_t)l * 4 * 256; float w[4];
#pragma unroll
    for (int k = 0; k < 4; ++k) w[k] = cw[k * 256 + ch];
    const float cb0 = INP(a, 25)[l * 256 + ch], br = INP(a, 27)[l * 256 + ch], bi = INP(a, 29)[l * 256 + ch];
    const float spl = softplus_f(-INP(a, 30)[l * 256 + ch]);
    const int blk = ch >> 5, d = ch & 31;
    const float* wr = INP(a, 26) + ((size_t)l * 8 + blk) * 1024 + d; const float* wi = INP(a, 28) + ((size_t)l * 8 + blk) * 1024 + d;
    for (int t = 0; t < L; ++t) {
        const size_t row = row0 + t; float xc = 0.f;
        if (act) { const float rx = ldp(P, row, PXC + ch); xc = w[0] * hx[0] + w[1] * hx[1] + w[2] * hx[2] + w[3] * rx + cb0; hx[0] = hx[1]; hx[1] = hx[2]; hx[2] = rx; xsh[ch] = xc; }
        __syncthreads();
        if (act) {
            float r = br, ig = bi;
#pragma unroll 8
            for (int c = 0; c < 32; ++c) { const float xv = xsh[blk * 32 + c]; r += xv * wr[c * 32]; ig += xv * wi[c * 32]; }
            const float log_a = -8.0f * sigmoid_f(r) * spl, av = __expf(log_a), bv = sqrtf(-expm1f(2.0f * log_a)) * (sigmoid_f(ig) * xc);
            h = av * h + bv;
            MIX[row * D + 768 + ch] = f2bf(h * gelu_tanh(ldp(P, row, PGC + ch)));
        }
        __syncthreads();
    }
    if (act) {
        state_out(OUTP(a), O_PLH, O_SLH, l, s, 256)[ch] = h;
        float* co = state_out(OUTP(a), O_PLC, O_SLC, l, s, 3 * 256);
#pragma unroll
        for (int j = 0; j < 3; ++j) co[j * 256 + ch] = hx[j];
    }
}

__device__ void naive_mixer_phase(const CArgs& a, int l, LAS unsigned char* lds) {
    const int b = blockIdx.x, tid = tidx();
    if (b < 108) { if (tid < 64) naive_delta_chain(a, l, b / 6, b % 6, tid); }
    else if (b < 144) { const int u = b - 108; naive_ssd_block(a, l, u / 2, u % 2, (LAS float*)lds); }
    else if (b < 162) naive_lru_block(a, l, b - 144, (LAS float*)lds);
}

typedef short bf16x8 __attribute__((ext_vector_type(8)));
constexpr int NCH = 528, NDU = NCH * 6, LDT = 72;
constexpr size_t WS_DW = WS_H, WS_DQK = WS_H + (size_t)NDU * 8192;
constexpr size_t WS_DQD = WS_M, WS_DKD = WS_DQD + (size_t)NDU * 8192, WS_DU = WS_DKD + (size_t)NDU * 8192, WS_SH = WS_DU + (size_t)NDU * 16384,
                 WS_GTD = WS_SH + (size_t)NDU * 16384, WS_GTS = WS_GTD + 16384, WS_LA = WS_GTS + 16384, WS_LB = WS_LA + (size_t)NCH * 1024, WS_LA0 = WS_LB + (size_t)NCH * 1024, WS_LB0 = WS_LA0 + (size_t)NCH * 1024, WS_GP = WS_LB0 + (size_t)NCH * 1024, WS_HH = WS_GP + (size_t)192 * 8192, WS_SST = WS_HH + (size_t)192 * 16384, WS_MEND = WS_SST + (size_t)192 * 16384;
static_assert(WS_MEND <= WS_END && WS_RS >= WS_DU && WS_RS + (size_t)16 * T * 4 <= WS_SH, "mixer workspace");
static_assert(WS_DQK + (size_t)NDU * 8192 <= WS_P, "DW/DQK must fit the H region");

__device__ __forceinline__ int kinv(int k) { return (k & 32) | ((k & 12) << 1) | ((k & 16) >> 2) | (k & 3); }
__device__ __forceinline__ unsigned cvtpk(float lo, float hi) { unsigned r; asm volatile("v_cvt_pk_bf16_f32 %0, %1, %2" : "=v"(r) : "v"(lo), "v"(hi)); return r; }
__device__ __forceinline__ bf16x8 pack8(const f32x4& x, const f32x4& y) { u32x4 w; w.x = cvtpk(x[0], x[1]); w.y = cvtpk(x[2], x[3]); w.z = cvtpk(y[0], y[1]); w.w = cvtpk(y[2], y[3]); return __builtin_bit_cast(bf16x8, w); }
__device__ __forceinline__ f32x4 mfma16(const bf16x8& a, const bf16x8& b, const f32x4& c) { return __builtin_amdgcn_mfma_f32_16x16x32_bf16(a, b, c, 0, 0, 0); }
__device__ __forceinline__ bf16x8 ldfrag(const LAS bf16_t* tile, int row, int s, int fq) { return *(const LAS bf16x8*)(tile + row * LDT + 32 * s + 8 * fq); }
__device__ __forceinline__ void chunk_seq(int c, int& s, bool& first) { if (c < 256) { s = 0; first = c == 0; } else if (c < 512) { s = 1; first = c == 256; } else { s = 2 + (c - 512); first = true; } }
__device__ __forceinline__ float wave_scan_incl(float v, int lane) {
#pragma unroll
    for (int o = 1; o < 64; o <<= 1) { const float t = __shfl_up(v, o); if (lane >= o) v += t; }
    return v; }
template <int NSEG> struct StageRegs { static constexpr int PPR = NSEG * 8, TOTAL = 67 * PPR, NP = (TOTAL + 511) / 512; u32x4 w[NP]; };
template <int NSEG> __device__ __forceinline__ void stage_load(StageRegs<NSEG>& R, const bf16_t* P, int c, int c0, int c1, int c2, int c3, const float* st, int CS, int stbase, bool first) {
    constexpr int PPR = StageRegs<NSEG>::PPR, TOTAL = StageRegs<NSEG>::TOTAL, NP = StageRegs<NSEG>::NP;
    const int tid = tidx();
#pragma unroll
    for (int k = 0; k < NP; ++k) { const int idx = tid + 512 * k < TOTAL ? tid + 512 * k : TOTAL - 1;
        const int r = idx / PPR, pc = idx - r * PPR, seg = pc >> 3, col = (seg == 0 ? c0 : (seg == 1 ? c1 : (seg == 2 ? c2 : c3))) + (pc & 7) * 8, rr = (r >= 3 || !first) ? r : 3;
        R.w[k] = *(const u32x4*)(P + ((size_t)c * 64 + rr - 3) * PSTR + col); }
    if (first) {
#pragma unroll
        for (int k = 0; k < NP; ++k) { const int idx = tid + 512 * k < TOTAL ? tid + 512 * k : TOTAL - 1;
            const int r = idx / PPR, pc = idx - r * PPR, seg = pc >> 3, col = (seg == 0 ? c0 : (seg == 1 ? c1 : (seg == 2 ? c2 : c3))) + (pc & 7) * 8;
            if (r < 3) {
                if (st) { const float* sp = st + r * CS + (col - stbase); R.w[k].x = pk_bf16(sp[0], sp[1]); R.w[k].y = pk_bf16(sp[2], sp[3]); R.w[k].z = pk_bf16(sp[4], sp[5]); R.w[k].w = pk_bf16(sp[6], sp[7]); }
                else { R.w[k].x = 0u; R.w[k].y = 0u; R.w[k].z = 0u; R.w[k].w = 0u; } } }
    }
}
template <int NSEG> __device__ __forceinline__ void stage_store(LAS bf16_t* dst, const StageRegs<NSEG>& R) {
    constexpr int PPR = StageRegs<NSEG>::PPR, TOTAL = StageRegs<NSEG>::TOTAL, NP = StageRegs<NSEG>::NP;
    const int tid = tidx();
#pragma unroll
    for (int k = 0; k < NP; ++k) { const int idx = tid + 512 * k;
        if (idx < TOTAL) { const int r = idx / PPR, pc = idx - r * PPR; *(LAS u32x4*)(dst + r * (NSEG * 64) + pc * 8) = R.w[k]; } }
}
template <int NSEG> __device__ __forceinline__ void stage_raw_n(LAS bf16_t* dst, const bf16_t* P, int c, int c0, int c1, int c2, int c3, const float* st, int CS, int stbase, bool first) {
    StageRegs<NSEG> R; stage_load<NSEG>(R, P, c, c0, c1, c2, c3, st, CS, stbase, first); stage_store<NSEG>(dst, R);
}
__device__ __forceinline__ f32x4 mfma4(float a, float b, const f32x4& c) { return __builtin_amdgcn_mfma_f32_16x16x4f32(a, b, c, 0, 0, 0); }

__device__ __forceinline__ void m1_delta_prefetch(const CArgs& a, int l, int c, int h, StageRegs<3>& R, float& xb_, float& xa_, float (&cwp)[4]) {
    const bf16_t* P = (const bf16_t*)(WSP(a) + WS_P); int s; bool first; chunk_seq(c, s, first);
    { const int t_ = tidx() < 384 ? tidx() : 0, ch = t_ % 192, seg = ch >> 6, cc = ch & 63; const float* cw = INP(a, 14) + (size_t)l * 4 * 1152 + seg * 384 + h * 64 + cc; cwp[0] = cw[0]; cwp[1] = cw[1152]; cwp[2] = cw[2304]; cwp[3] = cw[3456]; }
    if ((tidx() >> 6) == 0) { const size_t row = (size_t)c * 64 + (tidx() & 63); xb_ = ldp(P, row, PBA + h); xa_ = ldp(P, row, PAA + h); }
    stage_load<3>(R, P, c, PQ + h * 64, PK + h * 64, PV + h * 64, 0, (first && s >= 2) ? INP(a, 3) + ((size_t)l * 16 + (s - 2)) * 3 * 1152 : nullptr, 1152, 0, first);
}
__device__ __forceinline__ void m1_delta_unit(const CArgs& a, int l, int c, int h, LAS unsigned char* lds, StageRegs<3>& R, float& xb_, float& xa_, float (&cwp)[4], int cn, int hn, bool has_next) {
    const int tid = tidx(), lane = tid & 63, wid = __builtin_amdgcn_readfirstlane(tid >> 6), fr = lane & 15, fq = lane >> 4;
    const bf16_t* P = (const bf16_t*)(WSP(a) + WS_P);
    LAS bf16_t* RAW = (LAS bf16_t*)lds;
    LAS bf16_t* OUTT = (LAS bf16_t*)lds;
    LAS float* QF = (LAS float*)(lds + 36864);
    LAS float* AT = QF;
    LAS float* KF = (LAS float*)(lds + 36864 + 17408);
    LAS float* VF = KF + 4096;
    LAS bf16_t* KN = (LAS bf16_t*)(VF + 4096);
    LAS bf16_t* QN = KN + 64 * LDT;
    LAS float* SM = (LAS float*)(QN + 64 * LDT);
    int s; bool first; chunk_seq(c, s, first);
    const int u = c * 6 + h;
    stage_store<3>(RAW, R);
    if (wid == 0) {
        const float beta = sigmoid_f(xb_);
        const float la = -__expf(INP(a, 15)[l * 6 + h]) * softplus_f(xa_ + INP(a, 16)[l * 6 + h]);
        SM[lane] = wave_scan_incl(la, lane); SM[64 + lane] = beta;
    }
    const float w0 = cwp[0], w1 = cwp[1], w2 = cwp[2], w3 = cwp[3];
    __syncthreads();
    if (has_next) m1_delta_prefetch(a, l, cn, hn, R, xb_, xa_, cwp);
    if (tid < 384) {
        const int ch = tid % 192, par = tid / 192, seg = ch >> 6, cc = ch & 63;
        LAS float* dst = seg == 0 ? QF : (seg == 1 ? KF : VF);
        float x0 = bf2f(RAW[(par * 32) * 192 + ch]), x1 = bf2f(RAW[(par * 32 + 1) * 192 + ch]), x2 = bf2f(RAW[(par * 32 + 2) * 192 + ch]);
#pragma unroll 8
        for (int j = 0; j < 32; ++j) { const int i = par * 32 + j; const float x3 = bf2f(RAW[(i + 3) * 192 + ch]);
            dst[i * 64 + cc] = siluf(w0 * x0 + w1 * x1 + w2 * x2 + w3 * x3); x0 = x1; x1 = x2; x2 = x3; }
    }
    __syncthreads();
    {   const int i = tid >> 3, part = tid & 7; float q[8], k[8], sq = 0.f, sk = 0.f;
        {   const f32x4 qa = *(const LAS f32x4*)(QF + i * 64 + part * 8), qb = *(const LAS f32x4*)(QF + i * 64 + part * 8 + 4), ka = *(const LAS f32x4*)(KF + i * 64 + part * 8), kb = *(const LAS f32x4*)(KF + i * 64 + part * 8 + 4);
#pragma unroll
            for (int e = 0; e < 4; ++e) { q[e] = qa[e]; q[4 + e] = qb[e]; k[e] = ka[e]; k[4 + e] = kb[e]; } }
#pragma unroll
        for (int e = 0; e < 8; ++e) { sq += q[e] * q[e]; sk += k[e] * k[e]; }
        sq += __shfl_xor(sq, 1); sq += __shfl_xor(sq, 2); sq += __shfl_xor(sq, 4);
        sk += __shfl_xor(sk, 1); sk += __shfl_xor(sk, 2); sk += __shfl_xor(sk, 4);
        const float rq = rsqrtf(sq + 1e-6f) * 0.125f, rk = rsqrtf(sk + 1e-6f);
#pragma unroll
        for (int e = 0; e < 8; ++e) { q[e] *= rq; k[e] *= rk; }
        *(LAS f32x4*)(KF + i * 64 + part * 8) = (f32x4){k[0], k[1], k[2], k[3]}; *(LAS f32x4*)(KF + i * 64 + part * 8 + 4) = (f32x4){k[4], k[5], k[6], k[7]};
        u32x4 wq, wk; wq.x = cvtpk(q[0], q[1]); wq.y = cvtpk(q[2], q[3]); wq.z = cvtpk(q[4], q[5]); wq.w = cvtpk(q[6], q[7]);
        wk.x = cvtpk(k[0], k[1]); wk.y = cvtpk(k[2], k[3]); wk.z = cvtpk(k[4], k[5]); wk.w = cvtpk(k[6], k[7]);
        *(LAS u32x4*)(QN + i * LDT + part * 8) = wq; *(LAS u32x4*)(KN + i * LDT + part * 8) = wk; }
    __syncthreads();
    {
        const int mb = wid & 3, which = wid >> 2; const LAS bf16_t* Asrc = which ? QN : KN;
        const bf16x8 a0 = ldfrag(Asrc, 16 * mb + fr, 0, fq), a1 = ldfrag(Asrc, 16 * mb + fr, 1, fq);
        float gi[4], bi[4];
#pragma unroll
        for (int r = 0; r < 4; ++r) { gi[r] = SM[16 * mb + 4 * fq + r]; bi[r] = SM[64 + 16 * mb + 4 * fq + r]; }
#pragma unroll
        for (int nb = 0; nb < 4; ++nb) {
            const bf16x8 b0 = ldfrag(KN, 16 * nb + fr, 0, fq), b1 = ldfrag(KN, 16 * nb + fr, 1, fq);
            f32x4 acc = {0.f, 0.f, 0.f, 0.f}; acc = mfma16(a0, b0, acc); acc = mfma16(a1, b1, acc);
            const int j = 16 * nb + fr; const float gj = SM[j];
            if (which == 0) { f32x4 o;
#pragma unroll
                for (int r = 0; r < 4; ++r) { const int i = 16 * mb + 4 * fq + r; o[r] = i > j ? bi[r] * acc[r] * __expf(gi[r] - gj) : 0.f; }
                *(LAS f32x4*)(AT + j * 68 + 16 * mb + 4 * fq) = o;
            } else {
#pragma unroll
                for (int r = 0; r < 4; ++r) { const int i = 16 * mb + 4 * fq + r; OUTT[1 * 64 * LDT + i * LDT + kinv(j)] = f2bf(i >= j ? acc[r] * __expf(gi[r] - gj) : 0.f); }
            }
        }
    }
    __syncthreads();
    LAS float* TB = SM + 128;
    if (wid < 4 && lane < 16) {
        float x[16];
#pragma unroll
        for (int i = 0; i < 16; ++i) x[i] = i == lane ? 1.f : 0.f;
#pragma unroll
        for (int j = 0; j < 15; ++j) { const float xj = x[j];
#pragma unroll
            for (int i4 = ((j + 1) & ~3); i4 < 16; i4 += 4) { const f32x4 av = *(const LAS f32x4*)(AT + (16 * wid + j) * 68 + 16 * wid + i4);
#pragma unroll
                for (int e = 0; e < 4; ++e) if (i4 + e > j) x[i4 + e] -= av[e] * xj; } }
#pragma unroll
        for (int i = 0; i < 16; ++i) TB[wid * 272 + i * 17 + lane] = x[i];
    }
    {   const float glast = SM[63];
        for (int idx = tid; idx < 1024; idx += 512) {
            const int d4 = (idx & 15) * 4, i = idx >> 4; const float eg = __expf(SM[i]);
            const u32x2 qv = *(const LAS u32x2*)(QN + i * LDT + d4);
            u32x2 w; w.x = cvtpk(__uint_as_float(qv.x << 16) * eg, __uint_as_float(qv.x & 0xffff0000u) * eg); w.y = cvtpk(__uint_as_float(qv.y << 16) * eg, __uint_as_float(qv.y & 0xffff0000u) * eg);
            *(LAS u32x2*)(OUTT + 2 * 64 * LDT + i * LDT + kinv(d4)) = w; }
        for (int idx = tid; idx < 1024; idx += 512) {
            const int m = idx & 63, j4 = (idx >> 6) * 4; float v[4];
#pragma unroll
            for (int e = 0; e < 4; ++e) v[e] = KF[(j4 + e) * 64 + m] * __expf(glast - SM[j4 + e]);
            u32x2 w; w.x = cvtpk(v[0], v[1]); w.y = cvtpk(v[2], v[3]);
            *(LAS u32x2*)(OUTT + 3 * 64 * LDT + m * LDT + kinv(j4)) = w; } }
    __syncthreads();
    {
        const int ct = wid & 3, isw = wid >> 2; f32x4 X[4];
#pragma unroll
        for (int b = 0; b < 4; ++b) { f32x4 acc;
#pragma unroll
            for (int r = 0; r < 4; ++r) { const int i = 16 * b + 4 * fq + r; acc[r] = isw ? SM[64 + i] * __expf(SM[i]) * KF[i * 64 + 16 * ct + fr] : SM[64 + i] * VF[i * 64 + 16 * ct + fr]; }
#pragma unroll
            for (int bp = 0; bp < 4; ++bp) if (bp < b) {
#pragma unroll
                for (int r = 0; r < 4; ++r) acc = mfma4(-AT[(16 * bp + 4 * fq + r) * 68 + 16 * b + fr], X[bp][r], acc); }
            f32x4 xb = {0.f, 0.f, 0.f, 0.f};
#pragma unroll
            for (int r = 0; r < 4; ++r) xb = mfma4(TB[b * 272 + fr * 17 + 4 * fq + r], acc[r], xb);
            X[b] = xb; }
        if (isw == 0) { float* U = (float*)(WSP(a) + WS_DU) + (size_t)u * 4096;
#pragma unroll
            for (int b = 0; b < 4; ++b)
#pragma unroll
                for (int r = 0; r < 4; ++r) U[(16 * b + 4 * fq + r) * 64 + 16 * ct + fr] = X[b][r];
        } else { const int kp = kinv(16 * ct + fr);
#pragma unroll
            for (int b = 0; b < 4; ++b)
#pragma unroll
                for (int r = 0; r < 4; ++r) OUTT[(16 * b + 4 * fq + r) * LDT + kp] = f2bf(X[b][r]); }
    }
    __syncthreads();
    {   const int row = tid >> 3, c8 = tid & 7;
        bf16_t* g0 = (bf16_t*)(WSP(a) + WS_DW) + (size_t)u * 4096; bf16_t* g1 = (bf16_t*)(WSP(a) + WS_DQK) + (size_t)u * 4096;
        bf16_t* g2 = (bf16_t*)(WSP(a) + WS_DQD) + (size_t)u * 4096; bf16_t* g3 = (bf16_t*)(WSP(a) + WS_DKD) + (size_t)u * 4096;
        *(u32x4*)(g0 + tid * 8) = *(const LAS u32x4*)(OUTT + 0 * 64 * LDT + row * LDT + c8 * 8);
        *(u32x4*)(g1 + tid * 8) = *(const LAS u32x4*)(OUTT + 1 * 64 * LDT + row * LDT + c8 * 8);
        *(u32x4*)(g2 + tid * 8) = *(const LAS u32x4*)(OUTT + 2 * 64 * LDT + row * LDT + c8 * 8);
        *(u32x4*)(g3 + tid * 8) = *(const LAS u32x4*)(OUTT + 3 * 64 * LDT + row * LDT + c8 * 8);
        if (tid == 0) ((float*)(WSP(a) + WS_GTD))[u] = __expf(SM[63]); }
    __syncthreads();
}

__device__ __forceinline__ void m1_ssd_prefetch(const CArgs& a, int l, int c, int h, StageRegs<2>& R, float& xd_, float (&cwp)[5]) {
    const bf16_t* P = (const bf16_t*)(WSP(a) + WS_P); int s; bool first; chunk_seq(c, s, first); const int g = h / 3;
    { const int ch = tidx() & 127, wch = ch < 64 ? h * 64 + ch : 384 + g * 64 + (ch - 64); const float* cw = INP(a, 18) + (size_t)l * 4 * 640 + wch; cwp[0] = cw[0]; cwp[1] = cw[640]; cwp[2] = cw[1280]; cwp[3] = cw[1920]; cwp[4] = INP(a, 19)[l * 640 + wch]; }
    if ((tidx() >> 6) == 0) xd_ = ldp(P, (size_t)c * 64 + (tidx() & 63), PDT + h);
    stage_load<2>(R, P, c, PXBC + h * 64, PXBC + 384 + g * 64, 0, 0, (first && s >= 2) ? INP(a, 5) + ((size_t)l * 16 + (s - 2)) * 3 * 640 : nullptr, 640, PXBC, first);
}
__device__ __forceinline__ void m1_ssd_unit(const CArgs& a, int l, int c, int h, LAS unsigned char* lds, StageRegs<2>& R, float& xd_, float (&cwp)[5], int cn, int hn, bool has_next) {
    const int tid = tidx(), lane = tid & 63, wid = __builtin_amdgcn_readfirstlane(tid >> 6), fr = lane & 15, fq = lane >> 4, g = h / 3;
    const bf16_t* P = (const bf16_t*)(WSP(a) + WS_P);
    LAS bf16_t* RAW = (LAS bf16_t*)lds;
    LAS bf16_t* BDT = (LAS bf16_t*)(lds + 18432);
    LAS bf16_t* XT = BDT + 64 * LDT;
    LAS float* SM = (LAS float*)(XT + 64 * LDT);
    int s; bool first; chunk_seq(c, s, first);
    const int u = c * 6 + h;
    stage_store<2>(RAW, R);
    if (wid == 0) {
        const float dt = softplus_f(xd_ + INP(a, 21)[l * 6 + h]);
        SM[lane] = wave_scan_incl(-__expf(INP(a, 20)[l * 6 + h]) * dt, lane); SM[64 + lane] = dt;
    }
    const int ch = tid & 127, part = tid >> 7;
    const float w0 = cwp[0], w1 = cwp[1], w2 = cwp[2], w3 = cwp[3], bias = cwp[4];
    __syncthreads();
    if (has_next) m1_ssd_prefetch(a, l, cn, hn, R, xd_, cwp);
    {
        const float glast = SM[63];
        float x0 = bf2f(RAW[(part * 16) * 128 + ch]), x1 = bf2f(RAW[(part * 16 + 1) * 128 + ch]), x2 = bf2f(RAW[(part * 16 + 2) * 128 + ch]);
#pragma unroll 8
        for (int e = 0; e < 16; ++e) { const int j = part * 16 + e; const float x3 = bf2f(RAW[(j + 3) * 128 + ch]);
            const float y = siluf(w0 * x0 + w1 * x1 + w2 * x2 + w3 * x3 + bias); x0 = x1; x1 = x2; x2 = x3;
            if (ch < 64) XT[ch * LDT + j] = f2bf(y); else BDT[(ch - 64) * LDT + j] = f2bf(y * __expf(glast - SM[j]) * SM[64 + j]); } }
    __syncthreads();
    {   const int mb = wid & 3; float* SH = (float*)(WSP(a) + WS_SH) + (size_t)u * 4096;
        const bf16x8 a0 = ldfrag(BDT, 16 * mb + fr, 0, fq), a1 = ldfrag(BDT, 16 * mb + fr, 1, fq);
#pragma unroll
        for (int t = 0; t < 2; ++t) { const int nb = 2 * (wid >> 2) + t;
            const bf16x8 b0 = ldfrag(XT, 16 * nb + fr, 0, fq), b1 = ldfrag(XT, 16 * nb + fr, 1, fq);
            f32x4 acc = {0.f, 0.f, 0.f, 0.f}; acc = mfma16(b0, a0, acc); acc = mfma16(b1, a1, acc);
            *(f32x4*)(SH + (16 * mb + fr) * 64 + 16 * nb + 4 * fq) = acc; }
        if (tid == 0) ((float*)(WSP(a) + WS_GTS))[u] = __expf(SM[63]); }
    __syncthreads();
}

struct LruW { float wrc[32], wic[32], br, bi, spl; };
__device__ __forceinline__ void lru_load_w(const CArgs& a, int l, int ch, LruW& W) {
    const int blk = ch >> 5, d = ch & 31;
    const float* wr = INP(a, 26) + ((size_t)l * 8 + blk) * 1024 + d; const float* wi = INP(a, 28) + ((size_t)l * 8 + blk) * 1024 + d;
#pragma unroll
    for (int cI = 0; cI < 32; ++cI) { W.wrc[cI] = wr[cI * 32]; W.wic[cI] = wi[cI * 32]; }
    W.br = INP(a, 27)[l * 256 + ch]; W.bi = INP(a, 29)[l * 256 + ch]; W.spl = softplus_f(-INP(a, 30)[l * 256 + ch]);
}
template <class F> __device__ __forceinline__ void lru_gates(const LruW& W, const LAS float* XC, int ch, int half, F&& f) {
    const int blk = ch >> 5;
    const float br = W.br, bi = W.bi, spl = W.spl;
#pragma unroll
    for (int e = 0; e < 32; ++e) { const int t = half * 32 + e; float r = br, ig = bi;
#pragma unroll
        for (int c4 = 0; c4 < 8; ++c4) { const f32x4 xv = *(const LAS f32x4*)(XC + t * 256 + blk * 32 + c4 * 4);
#pragma unroll
            for (int k = 0; k < 4; ++k) { r += xv[k] * W.wrc[c4 * 4 + k]; ig += xv[k] * W.wic[c4 * 4 + k]; } }
        const float xc = XC[t * 256 + ch], log_a = -8.0f * sigmoid_f(r) * spl;
        f(e, __expf(log_a), sqrtf(-expm1f(2.0f * log_a)) * (sigmoid_f(ig) * xc)); }
}
__device__ __forceinline__ void lru_stage_conv(const CArgs& a, int l, int c, LAS unsigned char* lds) {
    const int tid = tidx(); const bf16_t* P = (const bf16_t*)(WSP(a) + WS_P);
    LAS bf16_t* RAW = (LAS bf16_t*)lds; LAS float* XC = (LAS float*)(lds + 34816);
    int s; bool first; chunk_seq(c, s, first);
    stage_raw_n<4>(RAW, P, c, PXC, PXC + 64, PXC + 128, PXC + 192, (first && s >= 2) ? INP(a, 7) + ((size_t)l * 16 + (s - 2)) * 3 * 256 : nullptr, 256, PXC, first);
    __syncthreads();
    {   const int ch = tid & 255, par = tid >> 8; const float* cw = INP(a, 24) + (size_t)l * 4 * 256 + ch; const float w0 = cw[0], w1 = cw[256], w2 = cw[512], w3 = cw[768], bias = INP(a, 25)[l * 256 + ch];
        float x0 = bf2f(RAW[(par * 32) * 256 + ch]), x1 = bf2f(RAW[(par * 32 + 1) * 256 + ch]), x2 = bf2f(RAW[(par * 32 + 2) * 256 + ch]);
#pragma unroll 8
        for (int e = 0; e < 32; ++e) { const int i = par * 32 + e; const float x3 = bf2f(RAW[(i + 3) * 256 + ch]);
            XC[i * 256 + ch] = w0 * x0 + w1 * x1 + w2 * x2 + w3 * x3 + bias; x0 = x1; x1 = x2; x2 = x3; } }
    __syncthreads();
}
__device__ __forceinline__ void m1_lru_unit(const CArgs& a, int l, int c, LAS unsigned char* lds, const LruW& W) {
    const int tid = tidx(), ch = tid & 255, half = tid >> 8;
    LAS float* XC = (LAS float*)(lds + 34816); LAS float* SM = (LAS float*)(lds + 34816 + 65536);
    lru_stage_conv(a, l, c, lds);
    float A = 1.f, B = 0.f;
    lru_gates(W, XC, ch, half, [&](int, float at, float bt) { A *= at; B = at * B + bt; });
    if (half == 1) { SM[ch] = A; SM[256 + ch] = B; }
    __syncthreads();
    if (half == 0) { const float A1 = SM[ch], B1 = SM[256 + ch];
        ((float*)(WSP(a) + WS_LA0))[c * 256 + ch] = A; ((float*)(WSP(a) + WS_LB0))[c * 256 + ch] = B;
        ((float*)(WSP(a) + WS_LA))[c * 256 + ch] = A1 * A; ((float*)(WSP(a) + WS_LB))[c * 256 + ch] = A1 * B + B1; }
    __syncthreads();
}

#define UNIT_LOOP(lo, hi) for (int id = (lo) + (((int)blockIdx.x - (lo)) % (int)gridDim.x + (int)gridDim.x) % (int)gridDim.x; id < (hi); id += (int)gridDim.x)
#define LAUNDER_ARGS() const CArgs* ap_ = (const CArgs*)__builtin_amdgcn_kernarg_segment_ptr(); asm volatile("" : "+s"(ap_)); const CArgs& a = *ap_
__device__ __forceinline__ void m1_phase(const CArgs& a0, int l, LAS unsigned char* lds) {
    { LAUNDER_ARGS(); const int G = (int)gridDim.x; int id = (int)blockIdx.x;
      if (id < NDU) { StageRegs<3> R; float xb_ = 0.f, xa_ = 0.f, cwp[4]; m1_delta_prefetch(a, l, id / 6, id % 6, R, xb_, xa_, cwp);
        for (; id < NDU; id += G) { const int idn = id + G; m1_delta_unit(a, l, id / 6, id % 6, lds, R, xb_, xa_, cwp, idn / 6, idn % 6, idn < NDU); } } }
    { LAUNDER_ARGS(); const int G = (int)gridDim.x; int id = NDU + (((int)blockIdx.x - NDU) % G + G) % G;
      if (id < 2 * NDU) { StageRegs<2> R; float xd_ = 0.f, cwp[5]; m1_ssd_prefetch(a, l, (id - NDU) / 6, (id - NDU) % 6, R, xd_, cwp);
        for (; id < 2 * NDU; id += G) { const int idn = id + G; m1_ssd_unit(a, l, (id - NDU) / 6, (id - NDU) % 6, lds, R, xd_, cwp, (idn - NDU) / 6, (idn - NDU) % 6, idn < 2 * NDU); } } }
    { LAUNDER_ARGS(); LruW W; lru_load_w(a, l, tidx() & 255, W); UNIT_LOOP(2 * NDU, 2 * NDU + NCH) m1_lru_unit(a, l, id - 2 * NDU, lds, W); }
}

constexpr int M2_UOFF = 4 * 64 * LDT * 2, M2_GOFF = M2_UOFF + 64 * 68 * 4, M2_BUFB = M2_GOFF + 16, M2_OB = 2 * M2_BUFB, M2_OBB = 64 * 68 * 4;
static_assert(M2_OB + 2 * M2_OBB <= 144 * 1024, "M2 LDS");
__device__ __forceinline__ void m2_delta_chain(const CArgs& a, int h, int c0, int nch, const float* init, bool ident, bool do_o, bool use_u, float* outf, bf16_t* outg, LAS unsigned char* lds) {
    const int tid = tidx(), lane = tid & 63, wid = __builtin_amdgcn_readfirstlane(tid >> 6), fr = lane & 15, fq = lane >> 4, vs = wid & 3;
    float* DU = (float*)(WSP(a) + WS_DU);
    if (wid >= 6) {
        const int ts = tid - 384;
        __syncthreads();
        for (int ci = 0; ci <= nch; ++ci) {
            if (ci > 0 && do_o) { const LAS float* ob = (const LAS float*)(lds + M2_OB + ((ci - 1) & 1) * M2_OBB); float* dst = DU + ((size_t)(c0 + ci - 1) * 6 + h) * 4096;
#pragma unroll
                for (int k = 0; k < 8; ++k) { const int q = ts + 128 * k; *(f32x4*)(dst + q * 4) = *(const LAS f32x4*)(ob + (q >> 4) * 68 + (q & 15) * 4); } }
            if (ci < nch) __syncthreads();
        }
        __syncthreads();
        return;
    }
    if (wid >= 4) {
        const int tl = tid - 256;
        const bf16_t* G0 = (const bf16_t*)(WSP(a) + WS_DW); const bf16_t* G1 = (const bf16_t*)(WSP(a) + WS_DQK); const bf16_t* G2 = (const bf16_t*)(WSP(a) + WS_DQD); const bf16_t* G3 = (const bf16_t*)(WSP(a) + WS_DKD);
        const float* GT = (const float*)(WSP(a) + WS_GTD);
        u32x4 p[16]; f32x4 pu[8]; float pg;
#define M2_LOAD(uu) do { _Pragma("unroll") for (int k = 0; k < 4; ++k) { const int q = tl + 128 * k; p[k] = *(const u32x4*)(G0 + (uu) * 4096 + q * 8); p[4 + k] = *(const u32x4*)(G1 + (uu) * 4096 + q * 8); \
            p[8 + k] = *(const u32x4*)(G2 + (uu) * 4096 + q * 8); p[12 + k] = *(const u32x4*)(G3 + (uu) * 4096 + q * 8); } \
        _Pragma("unroll") for (int k = 0; k < 8; ++k) { const int q = tl + 128 * k; pu[k] = *(const f32x4*)(DU + (uu) * 4096 + q * 4); } pg = GT[uu]; } while (0)
#define M2_WRITE(dstb) do { LAS bf16_t* d_ = (LAS bf16_t*)(dstb); LAS float* du_ = (LAS float*)((dstb) + M2_UOFF); \
        _Pragma("unroll") for (int k = 0; k < 4; ++k) { const int q = tl + 128 * k, o_ = (q >> 3) * LDT + (q & 7) * 8; *(LAS u32x4*)(d_ + o_) = p[k]; *(LAS u32x4*)(d_ + 64 * LDT + o_) = p[4 + k]; \
            *(LAS u32x4*)(d_ + 2 * 64 * LDT + o_) = p[8 + k]; *(LAS u32x4*)(d_ + 3 * 64 * LDT + o_) = p[12 + k]; } \
        _Pragma("unroll") for (int k = 0; k < 8; ++k) { const int q = tl + 128 * k; *(LAS f32x4*)(du_ + (q >> 4) * 68 + (q & 15) * 4) = pu[k]; } \
        if (tl == 0) *(LAS float*)((dstb) + M2_GOFF) = pg; } while (0)
        {   const size_t u = (size_t)c0 * 6 + h, u1 = nch > 1 ? u + 6 : u;
            M2_LOAD(u); M2_WRITE(lds);
            M2_LOAD(u1); }
        __syncthreads();
        for (int ci = 0; ci < nch; ++ci) {
            const size_t u = (size_t)(c0 + ci) * 6 + h; const size_t un2 = ci + 2 < nch ? u + 12 : u;
            LAS unsigned char* nxtb = lds + ((ci + 1) & 1) * M2_BUFB;
            if (ci + 1 < nch) M2_WRITE(nxtb);
            M2_LOAD(un2);
            __syncthreads();
        }
#undef M2_LOAD
#undef M2_WRITE
        __syncthreads();
        return;
    }
    f32x4 S[4];
#pragma unroll
    for (int mb = 0; mb < 4; ++mb) {
        if (init) {
#pragma unroll
            for (int r = 0; r < 4; ++r) S[mb][r] = init[(16 * mb + 4 * fq + r) * 64 + 16 * vs + fr]; }
        else {
#pragma unroll
            for (int r = 0; r < 4; ++r) S[mb][r] = (ident && (16 * mb + 4 * fq + r == 16 * vs + fr)) ? 1.f : 0.f; } }
    __syncthreads();
    for (int ci = 0; ci < nch; ++ci) {
        LAS unsigned char* curb = lds + (ci & 1) * M2_BUFB;
        const LAS bf16_t* cur = (const LAS bf16_t*)curb; const LAS float* UL = (const LAS float*)(curb + M2_UOFF); LAS float* OB = (LAS float*)(lds + M2_OB + (ci & 1) * M2_OBB);
        const float gt = *(const LAS float*)(curb + M2_GOFF);
        const bf16x8 Sb0 = pack8(S[0], S[1]), Sb1 = pack8(S[2], S[3]);
        f32x4 Dl[4], O[4];
#pragma unroll
        for (int mb = 0; mb < 4; ++mb) { f32x4 t = {0.f, 0.f, 0.f, 0.f}, uc;
#pragma unroll
            for (int r = 0; r < 4; ++r) uc[r] = use_u ? UL[(16 * mb + 4 * fq + r) * 68 + 16 * vs + fr] : 0.f;
            t = mfma16(ldfrag(cur + 0 * 64 * LDT, 16 * mb + fr, 0, fq), Sb0, t); t = mfma16(ldfrag(cur + 0 * 64 * LDT, 16 * mb + fr, 1, fq), Sb1, t);
            Dl[mb] = uc - t;
            f32x4 o = {0.f, 0.f, 0.f, 0.f};
            if (do_o) { o = mfma16(ldfrag(cur + 2 * 64 * LDT, 16 * mb + fr, 0, fq), Sb0, o); o = mfma16(ldfrag(cur + 2 * 64 * LDT, 16 * mb + fr, 1, fq), Sb1, o); }
            O[mb] = o; }
        const bf16x8 Db0 = pack8(Dl[0], Dl[1]), Db1 = pack8(Dl[2], Dl[3]);
#pragma unroll
        for (int mb = 0; mb < 4; ++mb) {
            f32x4 sn = S[mb] * gt;
            sn = mfma16(ldfrag(cur + 3 * 64 * LDT, 16 * mb + fr, 0, fq), Db0, sn); sn = mfma16(ldfrag(cur + 3 * 64 * LDT, 16 * mb + fr, 1, fq), Db1, sn);
            S[mb] = sn;
            if (do_o) { O[mb] = mfma16(ldfrag(cur + 1 * 64 * LDT, 16 * mb + fr, 0, fq), Db0, O[mb]); O[mb] = mfma16(ldfrag(cur + 1 * 64 * LDT, 16 * mb + fr, 1, fq), Db1, O[mb]);
#pragma unroll
                for (int r = 0; r < 4; ++r) OB[(16 * mb + 4 * fq + r) * 68 + 16 * vs + fr] = O[mb][r]; } }
        __syncthreads();
    }
    if (outf) {
#pragma unroll
        for (int mb = 0; mb < 4; ++mb)
#pragma unroll
            for (int r = 0; r < 4; ++r) outf[(16 * mb + 4 * fq + r) * 64 + 16 * vs + fr] = S[mb][r]; }
    if (outg) { const int kp = kinv(16 * vs + fr);
#pragma unroll
        for (int mb = 0; mb < 4; ++mb)
#pragma unroll
            for (int r = 0; r < 4; ++r) outg[(16 * mb + 4 * fq + r) * 64 + kp] = f2bf(S[mb][r]); }
    __syncthreads();
}
__device__ __forceinline__ void m2_level2(const CArgs& a, int q) {
    const int tid = tidx(), lane = tid & 63, wid = __builtin_amdgcn_readfirstlane(tid >> 6), fr = lane & 15, fq = lane >> 4, vs = wid & 3;
    if (wid >= 4) return;
    const bf16_t* GP = (const bf16_t*)(WSP(a) + WS_GP) + (size_t)q * 16 * 4096; const float* HH = (const float*)(WSP(a) + WS_HH) + (size_t)q * 16 * 4096; float* SST = (float*)(WSP(a) + WS_SST) + (size_t)q * 16 * 4096;
    f32x4 S[4], hn[4]; bf16x8 an[4][2];
#pragma unroll
    for (int mb = 0; mb < 4; ++mb) { S[mb] = (f32x4){0.f, 0.f, 0.f, 0.f};
#pragma unroll
        for (int r = 0; r < 4; ++r) hn[mb][r] = HH[(16 * mb + 4 * fq + r) * 64 + 16 * vs + fr];
        an[mb][0] = *(const bf16x8*)(GP + (16 * mb + fr) * 64 + 8 * fq); an[mb][1] = *(const bf16x8*)(GP + (16 * mb + fr) * 64 + 32 + 8 * fq); }
    for (int g = 0; g < 16; ++g) {
#pragma unroll
        for (int mb = 0; mb < 4; ++mb)
#pragma unroll
            for (int r = 0; r < 4; ++r) SST[(size_t)g * 4096 + (16 * mb + 4 * fq + r) * 64 + 16 * vs + fr] = S[mb][r];
        if (g == 15) break;
        f32x4 hc[4]; bf16x8 ac[4][2];
#pragma unroll
        for (int mb = 0; mb < 4; ++mb) { hc[mb] = hn[mb]; ac[mb][0] = an[mb][0]; ac[mb][1] = an[mb][1]; }
        const int gn = g + 1 < 15 ? g + 1 : g;
#pragma unroll
        for (int mb = 0; mb < 4; ++mb) {
#pragma unroll
            for (int r = 0; r < 4; ++r) hn[mb][r] = HH[(size_t)gn * 4096 + (16 * mb + 4 * fq + r) * 64 + 16 * vs + fr];
            an[mb][0] = *(const bf16x8*)(GP + (size_t)gn * 4096 + (16 * mb + fr) * 64 + 8 * fq); an[mb][1] = *(const bf16x8*)(GP + (size_t)gn * 4096 + (16 * mb + fr) * 64 + 32 + 8 * fq); }
        const bf16x8 Sb0 = pack8(S[0], S[1]), Sb1 = pack8(S[2], S[3]);
#pragma unroll
        for (int mb = 0; mb < 4; ++mb) { f32x4 t = mfma16(ac[mb][0], Sb0, hc[mb]); S[mb] = mfma16(ac[mb][1], Sb1, t); }
    }
}
__device__ __forceinline__ void m2_scan_unit(const CArgs& a, int l, int su) {
    const int tid = tidx();
    if (su < 864) {
        int s, h, e; const int gi = (su < 96 ? su : su - 96) * 512 + tid;
        if (su < 96) { s = gi / (6 * 4096); h = (gi / 4096) % 6; e = gi & 4095; } else { s = 2 + gi / (6 * 4096); h = (gi / 4096) % 6; e = gi & 4095; }
        const int nch = seq_len(s) / 64, c0 = s < 2 ? s * 256 : 512 + (s - 2);
        float hs = s < 2 ? 0.f : INP(a, 4)[(((size_t)l * 16 + (s - 2)) * 6 + h) * 4096 + e];
        float* SH = (float*)(WSP(a) + WS_SH); const float* GT = (const float*)(WSP(a) + WS_GTS);
        int ci = 0;
        for (; ci + 8 <= nch; ci += 8) { float hl[8], gt[8];
#pragma unroll
            for (int k = 0; k < 8; ++k) { const size_t u = (size_t)(c0 + ci + k) * 6 + h; hl[k] = SH[u * 4096 + e]; gt[k] = GT[u]; }
#pragma unroll
            for (int k = 0; k < 8; ++k) { const size_t u = (size_t)(c0 + ci + k) * 6 + h; SH[u * 4096 + e] = hs; hs = gt[k] * hs + hl[k]; } }
        for (; ci < nch; ++ci) { const size_t u = (size_t)(c0 + ci) * 6 + h; const float hl = SH[u * 4096 + e], gt = GT[u]; SH[u * 4096 + e] = hs; hs = gt * hs + hl; }
        state_out(OUTP(a), O_PSH, O_SSH, l, s, 6 * 4096)[(size_t)h * 4096 + e] = hs;
    } else {
        const int gi = (su == 864 ? 0 : su - 865) * 512 + tid; const int s = su == 864 ? gi / 256 : 2 + gi / 256, ch = gi & 255;
        const int nch = seq_len(s) / 64, c0 = s < 2 ? s * 256 : 512 + (s - 2);
        float hs = s < 2 ? 0.f : INP(a, 6)[((size_t)l * 16 + (s - 2)) * 256 + ch];
        const float* LA = (const float*)(WSP(a) + WS_LA); float* LB = (float*)(WSP(a) + WS_LB);
        int ci = 0;
        for (; ci + 8 <= nch; ci += 8) { float A[8], B[8];
#pragma unroll
            for (int k = 0; k < 8; ++k) { A[k] = LA[(c0 + ci + k) * 256 + ch]; B[k] = LB[(c0 + ci + k) * 256 + ch]; }
#pragma unroll
            for (int k = 0; k < 8; ++k) { LB[(c0 + ci + k) * 256 + ch] = hs; hs = A[k] * hs + B[k]; } }
        for (; ci < nch; ++ci) { const float A = LA[(c0 + ci) * 256 + ch], B = LB[(c0 + ci) * 256 + ch]; LB[(c0 + ci) * 256 + ch] = hs; hs = A * hs + B; }
        state_out(OUTP(a), O_PLH, O_SLH, l, s, 256)[ch] = hs;
    }
}
__device__ __forceinline__ void m2_scan2_unit(float* V, size_t vcs, const float* Dc, size_t dcs, int des, int e0, float* fin, LAS unsigned char* lds) {
    const int tid = tidx(), g = tid >> 5, el = tid & 31; LAS float* CG = (LAS float*)lds; LAS float* CH = CG + 512;
    float v[16], d[16];
#pragma unroll
    for (int k = 0; k < 16; ++k) { v[k] = V[(size_t)(16 * g + k) * vcs + e0 + el]; d[k] = Dc[(size_t)(16 * g + k) * dcs + (size_t)des * (e0 + el)]; }
    float hs = 0.f, gp = 1.f;
#pragma unroll
    for (int k = 0; k < 16; ++k) { const float t = v[k]; v[k] = hs; hs = d[k] * hs + t; gp *= d[k]; }
    CG[tid] = gp; CH[tid] = hs;
    __syncthreads();
    float S = 0.f;
    for (int j = 0; j < g; ++j) S = CG[j * 32 + el] * S + CH[j * 32 + el];
    float pk = 1.f;
#pragma unroll
    for (int k = 0; k < 16; ++k) { V[(size_t)(16 * g + k) * vcs + e0 + el] = v[k] + pk * S; pk *= d[k]; }
    if (g == 15) fin[e0 + el] = hs + gp * S;
    __syncthreads();
}
__device__ __forceinline__ void m2a_phase(const CArgs& a0, int l, LAS unsigned char* lds) {
    { LAUNDER_ARGS(); UNIT_LOOP(0, 1552) {
        if (id < 1536) { const int q = id >> 7, s = q / 6, h = q % 6, e0 = (id & 127) * 32;
            m2_scan2_unit((float*)(WSP(a) + WS_SH) + ((size_t)s * 256 * 6 + h) * 4096, (size_t)6 * 4096, (const float*)(WSP(a) + WS_GTS) + (size_t)s * 256 * 6 + h, 6, 0, e0,
                          state_out(OUTP(a), O_PSH, O_SSH, l, s, 6 * 4096) + (size_t)h * 4096, lds); }
        else { const int j = id - 1536, s = j >> 3, e0 = (j & 7) * 32;
            m2_scan2_unit((float*)(WSP(a) + WS_LB) + (size_t)s * 256 * 256, 256, (const float*)(WSP(a) + WS_LA) + (size_t)s * 256 * 256, 256, 1, e0, state_out(OUTP(a), O_PLH, O_SLH, l, s, 256), lds); } } }
    { LAUNDER_ARGS(); UNIT_LOOP(1552, 1552 + 360) { const int j = id - 1552, q = j / 30, g = (j >> 1) % 15, half = j & 1; const size_t qg = (size_t)q * 16 + g;
        m2_delta_chain(a, q % 6, (q / 6) * 256 + 16 * g, 16, nullptr, half == 1, false, half == 0, half == 0 ? (float*)(WSP(a) + WS_HH) + qg * 4096 : nullptr, half == 1 ? (bf16_t*)(WSP(a) + WS_GP) + qg * 4096 : nullptr, lds); } }
    { LAUNDER_ARGS(); const int b = (int)blockIdx.x;
      const int k = b >= 120 ? b - 120 : (b < 16 ? 136 + b : -1);
      if (k >= 0) for (int j = k; j < 776; j += 152) m2_scan_unit(a, l, j < 768 ? 96 + j : 865 + (j - 768)); }
}
__device__ __forceinline__ void m2b_phase(const CArgs& a0, int l) { LAUNDER_ARGS(); if (blockIdx.x < 12) m2_level2(a, blockIdx.x); }
__device__ __forceinline__ void m2c_phase(const CArgs& a0, int l, LAS unsigned char* lds) {
    LAUNDER_ARGS();
    const int b = (int)blockIdx.x;
    if (b < 192) { const int id = b, q = id >> 4, g = id & 15, s = q / 6, h = q % 6;
        m2_delta_chain(a, h, s * 256 + 16 * g, 16, (const float*)(WSP(a) + WS_SST) + (size_t)id * 4096, false, true, true, g == 15 ? state_out(OUTP(a), O_PDS, O_SDS, l, s, 6 * 4096) + (size_t)h * 4096 : nullptr, nullptr, lds); }
    else for (int j = b - 192; j < 96; j += (int)gridDim.x - 192) { const int sb = j / 6, h = j % 6;
        m2_delta_chain(a, h, 512 + sb, 1, INP(a, 2) + (((size_t)l * 16 + sb) * 6 + h) * 4096, false, true, true, state_out(OUTP(a), O_PDS, O_SDS, l, 2 + sb, 6 * 4096) + (size_t)h * 4096, nullptr, lds); }
}

__device__ __forceinline__ void m3_delta_unit(const CArgs& a, int l, int c) {
    const int tid = tidx(), i = tid >> 3, part = tid & 7; const size_t row = (size_t)c * 64 + i;
    const bf16_t* P = (const bf16_t*)(WSP(a) + WS_P); bf16_t* MIX = (bf16_t*)(WSP(a) + WS_H); const float* DU = (const float*)(WSP(a) + WS_DU);
    f32x4 nw0 = *(const f32x4*)(INP(a, 17) + l * 64 + part * 8), nw1 = *(const f32x4*)(INP(a, 17) + l * 64 + part * 8 + 4);
    f32x4 oo[6][2]; u32x4 zz[6];
#pragma unroll
    for (int h = 0; h < 6; ++h) { const float* o = DU + ((size_t)c * 6 + h) * 4096 + i * 64 + part * 8; oo[h][0] = *(const f32x4*)o; oo[h][1] = *(const f32x4*)(o + 4);
        zz[h] = *(const u32x4*)(P + row * PSTR + PZA + h * 64 + part * 8); }
#pragma unroll
    for (int h = 0; h < 6; ++h) {
        const f32x4 o0 = oo[h][0], o1 = oo[h][1];
        float ss = o0[0] * o0[0] + o0[1] * o0[1] + o0[2] * o0[2] + o0[3] * o0[3] + o1[0] * o1[0] + o1[1] * o1[1] + o1[2] * o1[2] + o1[3] * o1[3];
        ss += __shfl_xor(ss, 1); ss += __shfl_xor(ss, 2); ss += __shfl_xor(ss, 4);
        const float rs = rsqrtf(ss * (1.0f / 64.f) + 1e-6f);
        const u32x4 z = zz[h];
        float zf[8] = {__uint_as_float(z.x << 16), __uint_as_float(z.x & 0xffff0000u), __uint_as_float(z.y << 16), __uint_as_float(z.y & 0xffff0000u),
                       __uint_as_float(z.z << 16), __uint_as_float(z.z & 0xffff0000u), __uint_as_float(z.w << 16), __uint_as_float(z.w & 0xffff0000u)};
        u32x4 w;
        w.x = cvtpk(o0[0] * rs * nw0[0] * siluf(zf[0]), o0[1] * rs * nw0[1] * siluf(zf[1])); w.y = cvtpk(o0[2] * rs * nw0[2] * siluf(zf[2]), o0[3] * rs * nw0[3] * siluf(zf[3]));
        w.z = cvtpk(o1[0] * rs * nw1[0] * siluf(zf[4]), o1[1] * rs * nw1[1] * siluf(zf[5])); w.w = cvtpk(o1[2] * rs * nw1[2] * siluf(zf[6]), o1[3] * rs * nw1[3] * siluf(zf[7]));
        *(u32x4*)(MIX + row * D + h * 64 + part * 8) = w;
    }
}
__device__ __forceinline__ void m3_ssd_unit(const CArgs& a, int l, int c, int g, LAS unsigned char* lds) {
    const int tid = tidx(), lane = tid & 63, wid = __builtin_amdgcn_readfirstlane(tid >> 6), fr = lane & 15, fq = lane >> 4;
    const bf16_t* P = (const bf16_t*)(WSP(a) + WS_P); bf16_t* MIX = (bf16_t*)(WSP(a) + WS_H);
    LAS bf16_t* RAWBC = (LAS bf16_t*)lds;
    LAS bf16_t* SC = (LAS bf16_t*)lds; LAS bf16_t* HT = SC + 64 * LDT;
    LAS bf16_t* BN = (LAS bf16_t*)(lds + 18432); LAS bf16_t* CN = BN + 64 * LDT;
    LAS bf16_t* RAWX = (LAS bf16_t*)(lds + 36864);
    LAS bf16_t* XDT = (LAS bf16_t*)(lds + 46080);
    LAS float* XS = (LAS float*)(lds + 55296);
    LAS float* Y = (LAS float*)(lds + 71680);
    LAS float* SM = (LAS float*)(lds + 120832);
    int s; bool first; chunk_seq(c, s, first);
    const float* st = (first && s >= 2) ? INP(a, 5) + ((size_t)l * 16 + (s - 2)) * 3 * 640 : nullptr;
    stage_raw_n<2>(RAWBC, P, c, PXBC + 384 + g * 64, PXBC + 512 + g * 64, 0, 0, st, 640, PXBC, first);
    __syncthreads();
    {   const int ch = tid & 127, part = tid >> 7, wch = ch < 64 ? 384 + g * 64 + ch : 512 + g * 64 + (ch - 64);
        const float* cw = INP(a, 18) + (size_t)l * 4 * 640 + wch; const float w0 = cw[0], w1 = cw[640], w2 = cw[1280], w3 = cw[1920], bias = INP(a, 19)[l * 640 + wch];
        float x0 = bf2f(RAWBC[(part * 16) * 128 + ch]), x1 = bf2f(RAWBC[(part * 16 + 1) * 128 + ch]), x2 = bf2f(RAWBC[(part * 16 + 2) * 128 + ch]);
#pragma unroll 8
        for (int e = 0; e < 16; ++e) { const int j = part * 16 + e; const float x3 = bf2f(RAWBC[(j + 3) * 128 + ch]);
            const float y = siluf(w0 * x0 + w1 * x1 + w2 * x2 + w3 * x3 + bias); x0 = x1; x1 = x2; x2 = x3;
            if (ch < 64) BN[j * LDT + ch] = f2bf(y); else CN[j * LDT + ch - 64] = f2bf(y); } }
    __syncthreads();
    StageRegs<1> RX; float ht[8], zb[8], xd = 0.f, cwx[5];
#define M3_PREFETCH(hh_) do { const int head_ = 3 * g + (hh_); const size_t u_ = (size_t)c * 6 + head_; \
        if (wid == 0) xd = ldp(P, (size_t)c * 64 + lane, PDT + head_); \
        { const float* cw_ = INP(a, 18) + (size_t)l * 4 * 640 + head_ * 64 + (tid & 63); cwx[0] = cw_[0]; cwx[1] = cw_[640]; cwx[2] = cw_[1280]; cwx[3] = cw_[1920]; cwx[4] = INP(a, 19)[l * 640 + head_ * 64 + (tid & 63)]; } \
        stage_load<1>(RX, P, c, PXBC + head_ * 64, 0, 0, 0, st, 640, PXBC, first); \
        { const float* SH_ = (const float*)(WSP(a) + WS_SH) + u_ * 4096; _Pragma("unroll") for (int e = 0; e < 8; ++e) ht[e] = SH_[tid + 512 * e]; } \
        _Pragma("unroll") for (int t = 0; t < 2; ++t) _Pragma("unroll") for (int r = 0; r < 4; ++r) zb[t * 4 + r] = ldp(P, (size_t)c * 64 + 16 * (wid & 3) + 4 * fq + r, PZB + head_ * 64 + 16 * (2 * (wid >> 2) + t) + fr); } while (0)
    M3_PREFETCH(0);
    for (int hh = 0; hh < 3; ++hh) {
        const int head = 3 * g + hh;
        stage_store<1>(RAWX, RX);
        if (wid == 0) {
            const float dt = softplus_f(xd + INP(a, 21)[l * 6 + head]);
            SM[lane] = wave_scan_incl(-__expf(INP(a, 20)[l * 6 + head]) * dt, lane); SM[64 + lane] = dt;
        }
#pragma unroll
        for (int e = 0; e < 8; ++e) { const int idx = tid + 512 * e, n = idx >> 6, p = idx & 63; HT[p * LDT + n] = f2bf(ht[e]); }
        float zc[8]; const float w0 = cwx[0], w1 = cwx[1], w2 = cwx[2], w3 = cwx[3], bias = cwx[4];
#pragma unroll
        for (int e = 0; e < 8; ++e) zc[e] = zb[e];
        __syncthreads();
        if (hh < 2) M3_PREFETCH(hh + 1);
        {   const int p = tid & 63, part = tid >> 6;
            float x0 = bf2f(RAWX[(part * 8) * 64 + p]), x1 = bf2f(RAWX[(part * 8 + 1) * 64 + p]), x2 = bf2f(RAWX[(part * 8 + 2) * 64 + p]);
#pragma unroll
            for (int e = 0; e < 8; ++e) { const int j = part * 8 + e; const float x3 = bf2f(RAWX[(j + 3) * 64 + p]);
                const float y = siluf(w0 * x0 + w1 * x1 + w2 * x2 + w3 * x3 + bias); x0 = x1; x1 = x2; x2 = x3;
                XS[j * 64 + p] = y; XDT[p * LDT + j] = f2bf(y * SM[64 + j]); } }
        {   const int mb = wid & 3;
            const bf16x8 a0 = ldfrag(CN, 16 * mb + fr, 0, fq), a1 = ldfrag(CN, 16 * mb + fr, 1, fq);
            float gi[4];
#pragma unroll
            for (int r = 0; r < 4; ++r) gi[r] = SM[16 * mb + 4 * fq + r];
#pragma unroll
            for (int t = 0; t < 2; ++t) { const int nb = 2 * (wid >> 2) + t;
                const bf16x8 b0 = ldfrag(BN, 16 * nb + fr, 0, fq), b1 = ldfrag(BN, 16 * nb + fr, 1, fq);
                f32x4 acc = {0.f, 0.f, 0.f, 0.f}; acc = mfma16(a0, b0, acc); acc = mfma16(a1, b1, acc);
                const int j = 16 * nb + fr; const float gj = SM[j];
#pragma unroll
                for (int r = 0; r < 4; ++r) { const int i = 16 * mb + 4 * fq + r; SC[i * LDT + j] = f2bf(i >= j ? acc[r] * __expf(gi[r] - gj) : 0.f); } } }
        __syncthreads();
        {   const int mb = wid & 3; const float dsk = INP(a, 22)[l * 6 + head];
            const bf16x8 s0 = ldfrag(SC, 16 * mb + fr, 0, fq), s1 = ldfrag(SC, 16 * mb + fr, 1, fq), c0f = ldfrag(CN, 16 * mb + fr, 0, fq), c1f = ldfrag(CN, 16 * mb + fr, 1, fq);
#pragma unroll
            for (int t = 0; t < 2; ++t) { const int nb = 2 * (wid >> 2) + t;
                f32x4 y1 = {0.f, 0.f, 0.f, 0.f}, y2 = {0.f, 0.f, 0.f, 0.f};
                y1 = mfma16(s0, ldfrag(XDT, 16 * nb + fr, 0, fq), y1); y1 = mfma16(s1, ldfrag(XDT, 16 * nb + fr, 1, fq), y1);
                y2 = mfma16(c0f, ldfrag(HT, 16 * nb + fr, 0, fq), y2); y2 = mfma16(c1f, ldfrag(HT, 16 * nb + fr, 1, fq), y2);
                const int p = 16 * nb + fr;
#pragma unroll
                for (int r = 0; r < 4; ++r) { const int i = 16 * mb + 4 * fq + r;
                    float y = y1[r] + __expf(SM[i]) * y2[r] + dsk * XS[i * 64 + p];
                    y *= siluf(zc[t * 4 + r]);
                    Y[i * 192 + hh * 64 + p] = y; } } }
        __syncthreads();
    }
#undef M3_PREFETCH
    {   const int i = tid >> 3, part = tid & 7; float v[24], ss = 0.f;
#pragma unroll
        for (int e4 = 0; e4 < 6; ++e4) { const f32x4 t = *(const LAS f32x4*)(Y + i * 192 + part * 24 + e4 * 4); v[4 * e4] = t[0]; v[4 * e4 + 1] = t[1]; v[4 * e4 + 2] = t[2]; v[4 * e4 + 3] = t[3]; }
#pragma unroll
        for (int e = 0; e < 24; ++e) ss += v[e] * v[e];
        ss += __shfl_xor(ss, 1); ss += __shfl_xor(ss, 2); ss += __shfl_xor(ss, 4);
        const float rs = rsqrtf(ss * (1.0f / 192.f) + 1e-6f); const float* nw = INP(a, 23) + l * 384 + g * 192 + part * 24;
        bf16_t* dst = MIX + ((size_t)c * 64 + i) * D + 384 + g * 192 + part * 24;
#pragma unroll
        for (int q = 0; q < 3; ++q) { u32x4 w;
            w.x = cvtpk(v[8 * q + 0] * rs * nw[8 * q + 0], v[8 * q + 1] * rs * nw[8 * q + 1]); w.y = cvtpk(v[8 * q + 2] * rs * nw[8 * q + 2], v[8 * q + 3] * rs * nw[8 * q + 3]);
            w.z = cvtpk(v[8 * q + 4] * rs * nw[8 * q + 4], v[8 * q + 5] * rs * nw[8 * q + 5]); w.w = cvtpk(v[8 * q + 6] * rs * nw[8 * q + 6], v[8 * q + 7] * rs * nw[8 * q + 7]);
            *(u32x4*)(dst + 8 * q) = w; } }
    __syncthreads();
}
__device__ __forceinline__ void m3_lru_unit(const CArgs& a, int l, int c, LAS unsigned char* lds, const LruW& W) {
    const int tid = tidx(), ch = tid & 255, half = tid >> 8;
    const bf16_t* P = (const bf16_t*)(WSP(a) + WS_P); bf16_t* MIX = (bf16_t*)(WSP(a) + WS_H);
    LAS float* XC = (LAS float*)(lds + 34816);
    float gz[32];
#pragma unroll
    for (int e = 0; e < 32; ++e) gz[e] = ldp(P, (size_t)c * 64 + half * 32 + e, PGC + ch);
    float hcur = ((const float*)(WSP(a) + WS_LB))[c * 256 + ch];
    const float a0h = ((const float*)(WSP(a) + WS_LA0))[c * 256 + ch], b0h = ((const float*)(WSP(a) + WS_LB0))[c * 256 + ch];
    lru_stage_conv(a, l, c, lds);
    if (half == 1) hcur = a0h * hcur + b0h;
    lru_gates(W, XC, ch, half, [&](int e, float at, float bt) { hcur = at * hcur + bt;
        const size_t row = (size_t)c * 64 + half * 32 + e; MIX[row * D + 768 + ch] = f2bf(hcur * gelu_tanh(gz[e])); });
    __syncthreads();
}
__device__ __forceinline__ void m3_state_unit(const CArgs& a, int l, int s) {
    const bf16_t* P = (const bf16_t*)(WSP(a) + WS_P); const size_t r0 = seq_row0(s) + seq_len(s) - 3;
    float* oa = state_out(OUTP(a), O_PDC, O_SDC, l, s, 3 * 1152); float* ob = state_out(OUTP(a), O_PSC, O_SSC, l, s, 3 * 640); float* oc = state_out(OUTP(a), O_PLC, O_SLC, l, s, 3 * 256);
    for (int idx = tidx(); idx < 3 * 2048; idx += 512) { const int j = idx / 2048, e = idx % 2048;
        if (e < 1152) oa[j * 1152 + e] = ldp(P, r0 + j, e);
        else if (e < 1792) ob[j * 640 + e - 1152] = ldp(P, r0 + j, PXBC + e - 1152);
        else oc[j * 256 + e - 1792] = ldp(P, r0 + j, PXC + e - 1792); }
}
__device__ __forceinline__ void m3_phase(const CArgs& a0, int l, LAS unsigned char* lds) {
    { LAUNDER_ARGS(); UNIT_LOOP(0, 2 * NCH) m3_ssd_unit(a, l, id >> 1, id & 1, lds); }
    { LAUNDER_ARGS(); LruW W; lru_load_w(a, l, tidx() & 255, W); UNIT_LOOP(2 * NCH, 3 * NCH) m3_lru_unit(a, l, id - 2 * NCH, lds, W); }
    { LAUNDER_ARGS(); UNIT_LOOP(3 * NCH, 4 * NCH) m3_delta_unit(a, l, id - 3 * NCH); }
    { LAUNDER_ARGS(); UNIT_LOOP(4 * NCH, 4 * NCH + 18) m3_state_unit(a, l, id - 4 * NCH); }
}
namespace cg = cooperative_groups;
#define GEMM_GU(l, f) do { PH_BEGIN(); pg8::Gemm g{(const bf16_t*)OUTP(a), (const bf16_t*)(WSP(a) + WS_WGU + (size_t)((l) * 2 + (f)) * SZ_WGU), T, NGU, D}; pg8::StaticOrder S; S.init(T, NGU, gridDim.x, blockIdx.x); \
        pg8::rs_prepare(lds, S, (const float*)(WSP(a) + WS_RS), tidx()); pg8::EpiGU E{P, FF, lds}; pg8::gemm_phase<pg8::EpiGU, pg8::StaticOrder, true, true>(lds, g, S, E); } while (0)
#define SPLITK_TAIL(Aptr, Wptr, LDK, NSL) do { pg8::Gemm g2{(Aptr) + (size_t)TP * (LDK), (Wptr), TS, D, 256, (LDK)}; pg8::SplitKOrder S2{TS / 256, D / 256, (NSL), 256, (int)gridDim.x, (int)blockIdx.x}; \
        pg8::EpiSlab E2{(float*)(WSP(a) + WS_SLAB), D, 256, (size_t)TS * D}; pg8::gemm_phase<pg8::EpiSlab, pg8::SplitKOrder, true, true>(lds, g2, S2, E2); } while (0)
#define GEMM_DN(l, f) do { { PH_BEGIN(); const bf16_t* W = (const bf16_t*)(WSP(a) + WS_WDN + (size_t)((l) * 2 + (f)) * SZ_WDN); pg8::Gemm g{P, W, TP, D, FF}; pg8::StaticOrder S; S.init(TP, D, gridDim.x, blockIdx.x); \
        pg8::EpiRes E{(bf16_t*)OUTP(a), ((l) == 1 && (f) == 1) ? (bf16_t*)(WSP(a) + WS_H) : (bf16_t*)OUTP(a), 0.5f, (float*)(WSP(a) + WS_RS)}; pg8::gemm_phase<pg8::EpiRes, pg8::StaticOrder, true, true>(lds, g, S, E); \
        SPLITK_TAIL(P, W, FF, 11); } BAR(); \
        { PH_BEGIN(); sample_reduce_phase<11>(a, 0.5f, (l) == 1 && (f) == 1, (float*)(WSP(a) + WS_RS)); } } while (0)
#define GEMM_IN(l) do { PH_BEGIN(); pg8::Gemm g{(const bf16_t*)OUTP(a), (const bf16_t*)(WSP(a) + WS_WIN + (size_t)(l) * SZ_WIN), T, NPIN, D}; pg8::StaticOrder S; S.init(T, NPIN, gridDim.x, blockIdx.x); \
        pg8::rs_prepare(lds, S, (const float*)(WSP(a) + WS_RS), tidx()); pg8::EpiP E{P, PSTR, PSTR, lds}; pg8::gemm_phase<pg8::EpiP, pg8::StaticOrder, true, true>(lds, g, S, E); } while (0)
#define GEMM_OUT(l) do { { PH_BEGIN(); const bf16_t* W = (const bf16_t*)(WSP(a) + WS_WOUT + (size_t)(l) * SZ_WOUT); pg8::Gemm g{H, W, TP, D, D}; pg8::StaticOrder S; S.init(TP, D, gridDim.x, blockIdx.x); \
        pg8::EpiRes E{(bf16_t*)OUTP(a), (bf16_t*)OUTP(a), 1.0f, (float*)(WSP(a) + WS_RS)}; pg8::gemm_phase<pg8::EpiRes, pg8::StaticOrder, true, true>(lds, g, S, E); \
        SPLITK_TAIL(H, W, D, 4); } BAR(); \
        { PH_BEGIN(); sample_reduce_phase<4>(a, 1.0f, false, (float*)(WSP(a) + WS_RS)); } } while (0)

__global__ void __launch_bounds__(512, 2) mk_fwd(Args a_) {
#define PH_BEGIN() const CArgs* ap_ = (const CArgs*)__builtin_amdgcn_kernarg_segment_ptr(); asm volatile("" : "+s"(ap_)); const CArgs& a = *ap_; \
        bf16_t* H = (bf16_t*)(WSP(a) + WS_H); bf16_t* P = (bf16_t*)(WSP(a) + WS_P); (void)H; (void)P; LAS unsigned char* lds = (LAS unsigned char*)lds_raw
    extern __shared__ __attribute__((aligned(16))) unsigned char lds_raw[];
    LAS unsigned char* lds = (LAS unsigned char*)lds_raw;
    volatile LAS unsigned* misc = (volatile LAS unsigned*)(lds + MISC_OFF);
    if (threadIdx.x < 4) misc[threadIdx.x] = 0u;
    __syncthreads();
    XcdBarrier bar = xcd_barrier_post((unsigned*)(a_.ws + WS_CTL), misc);
    if (a_.ph_lo < 0) cg::this_grid().sync();
#define BAR() xcd_barrier(bar)
#define NORM(gi, goff, mode) do { PH_BEGIN(); norm_phase(a, INP(a, gi) + (goff), mode); } while (0)
#define MIXER(l) { PH_BEGIN(); m1_phase(a, l, lds); } BAR(); { PH_BEGIN(); m2a_phase(a, l, lds); } BAR(); { PH_BEGIN(); m2b_phase(a, l); } BAR(); { PH_BEGIN(); m2c_phase(a, l, lds); } BAR(); { PH_BEGIN(); m3_phase(a, l, lds); } BAR();
    { PH_BEGIN(); wprep_phase(a, lds); } NORM(8, 0, 0); BAR();
#define LAYER(l) \
        GEMM_GU(l, 0); BAR(); \
        GEMM_DN(l, 0); BAR(); \
        GEMM_IN(l); BAR(); \
        MIXER(l); \
        GEMM_OUT(l); BAR(); \
        GEMM_GU(l, 1); BAR(); \
        GEMM_DN(l, 1); BAR();
    LAYER(0)
    LAYER(1) NORM(36, 0, 2);
}

extern "C" void kernel_launch(void* const* d_in, const int* in_sizes, int n_in, void* d_out, int out_size, void* d_ws, size_t ws_size, hipStream_t stream) {
    static int grid = 0;
    if (grid == 0) {
        if (n_in != 37 || (size_t)out_size != O_END || ws_size < WS_END) { fprintf(stderr, "kernel_launch: unexpected shapes: n_in %d out %d (want %zu) ws %zu (want %zu)\n", n_in, out_size, (size_t)O_END, ws_size, (size_t)WS_END); grid = -1; return; }
        int dev = 0, cus = 0, per_cu = 0;
        if (hipGetDevice(&dev) != hipSuccess || hipDeviceGetAttribute(&cus, hipDeviceAttributeMultiprocessorCount, dev) != hipSuccess) { grid = -1; return; }
        if (hipFuncSetAttribute((const void*)mk_fwd, hipFuncAttributeMaxDynamicSharedMemorySize, LDS_BYTES) != hipSuccess) { fprintf(stderr, "kernel_launch: hipFuncSetAttribute failed\n"); grid = -1; return; }
        if (hipOccupancyMaxActiveBlocksPerMultiprocessor(&per_cu, (const void*)mk_fwd, 512, LDS_BYTES) != hipSuccess || per_cu < 1) { fprintf(stderr, "kernel_launch: occupancy query says %d\n", per_cu); (void)hipGetLastError(); }
        grid = cus;
    }
    if (grid < 0) return;
    (void)hipMemsetAsync((char*)d_ws + WS_CTL, 0, 65536, stream);
    Args a{};
    for (int i = 0; i < 37; ++i) a.in[i] = (const float*)d_in[i];
    a.out = (float*)d_out; a.ws = (unsigned char*)d_ws; a.ph_lo = 0; a.ph_hi = 0;
    void* args[] = {&a};
    hipError_t e = hipLaunchCooperativeKernel((const void*)mk_fwd, dim3(grid), dim3(512), args, LDS_BYTES, stream);
    if (e != hipSuccess) fprintf(stderr, "kernel_launch: cooperative launch failed: %s\n", hipGetErrorString(e));
}
```
